# Optimizing an MI355X kernel written in HIP

```python
import math
import jax
import jax.numpy as jnp
from jax import lax
import numpy as np

D_MODEL = 1024
BATCH = 2
SEQ = 8192
DEPTH = 1

NORM_EPS = 1e-6
DA_HEADS = 8
DA_HEAD_DIM = 64
DA_QK_DIM = DA_HEADS * 2 * DA_HEAD_DIM
DA_V_DIM = DA_HEADS * 2 * DA_HEAD_DIM
ROPE_THETA = 10000.0
Q_BLOCK = 128
GD_HEADS = 8
GD_HEAD_K = 128
GD_HEAD_V = 128
GD_QK_DIM = GD_HEADS * GD_HEAD_K
GD_V_DIM = GD_HEADS * GD_HEAD_V
CONV_WIDTH = 4
CHUNK = 64
IN_SPLITS = (DA_QK_DIM, DA_QK_DIM, DA_V_DIM, GD_QK_DIM, GD_QK_DIM, GD_V_DIM, GD_V_DIM, GD_HEADS, GD_HEADS, D_MODEL, D_MODEL)
IN_DIM = 2 * DA_QK_DIM + DA_V_DIM + 2 * GD_QK_DIM + 2 * GD_V_DIM + 2 * GD_HEADS + 2 * D_MODEL
N_EXPERTS = 32
TOP_K = 4
D_EXPERT = 1024
SWIGLU_ALPHA = 1.702
SWIGLU_LIMIT = 7.0
EXPERT_BLOCK = 128

kernel_name = 'hybrid_diffattn_gdn_moe_block'


def rms_norm(x, g):
    xf = x.astype(jnp.float32)
    y = xf * lax.rsqrt(jnp.mean(xf * xf, axis=-1, keepdims=True) + NORM_EPS)
    return y * g.astype(jnp.float32)


def l2_normalize(t):
    tf = t.astype(jnp.float32)
    return tf * lax.rsqrt(jnp.sum(tf * tf, axis=-1, keepdims=True) + NORM_EPS)


def rope_cos_sin(seq_len, dim):
    inv_freq = 1.0 / (ROPE_THETA ** (jnp.arange(0, dim, 2, dtype=jnp.float32) / dim))
    ang = jnp.arange(seq_len, dtype=jnp.float32)[:, None] * inv_freq[None, :]
    ang = jnp.concatenate([ang, ang], axis=-1)
    return jnp.cos(ang), jnp.sin(ang)


def apply_rope(t, cos, sin):
    tf = t.astype(jnp.float32)
    half = tf.shape[-1] // 2
    rot = jnp.concatenate([-tf[..., half:], tf[..., :half]], axis=-1)
    c = cos[None, :, None, None, :]
    s = sin[None, :, None, None, :]
    return (tf * c + rot * s).astype(t.dtype)


def differential_attention(q, k, v, lam):
    b, s, h, _, d = q.shape
    n_blocks = s // Q_BLOCK
    scale = 1.0 / math.sqrt(d)
    q_blocks = jnp.moveaxis(q.reshape(b, n_blocks, Q_BLOCK, h, 2, d), 1, 0)
    vf = v.astype(jnp.float32)
    key_pos = jnp.arange(s)

    def one_block(args):
        q_blk, blk = args
        scores = jnp.einsum('bqhcd,bkhcd->bhcqk', q_blk, k).astype(jnp.float32) * scale
        q_pos = blk * Q_BLOCK + jnp.arange(Q_BLOCK)
        causal = key_pos[None, :] <= q_pos[:, None]
        probs = jax.nn.softmax(jnp.where(causal, scores, -jnp.inf), axis=-1)
        weights = probs[:, :, 0] - lam * probs[:, :, 1]
        return jnp.einsum('bhqk,bkhe->bqhe', weights, vf)

    out = lax.map(one_block, (q_blocks, jnp.arange(n_blocks)))
    return jnp.moveaxis(out, 0, 1).reshape(b, s, h, 2 * d)


def causal_depthwise_conv(x, w):
    c = x.shape[-1]
    return lax.conv_general_dilated(x, w[:, None, :].astype(x.dtype), window_strides=(1,), padding=[(CONV_WIDTH - 1, 0)], dimension_numbers=('NWC', 'WIO', 'NWC'), feature_group_count=c)


def gated_delta_rule_chunked(q, k, v, g, beta):
    b, s, h, dk = q.shape
    dv = v.shape[-1]
    n = s // CHUNK

    def chunks(t):
        return jnp.moveaxis(t.reshape(b, n, CHUNK, h, -1), 3, 1)

    q, k, v = chunks(q), chunks(k), chunks(v)
    g = jnp.moveaxis(g.reshape(b, n, CHUNK, h), 3, 1)
    beta = jnp.moveaxis(beta.reshape(b, n, CHUNK, h), 3, 1)
    cum_g = jnp.cumsum(g, axis=-1)
    incl = jnp.tril(jnp.ones((CHUNK, CHUNK), dtype=bool))
    strict = jnp.tril(jnp.ones((CHUNK, CHUNK), dtype=bool), -1)
    decay = jnp.exp(jnp.where(incl, cum_g[..., :, None] - cum_g[..., None, :], -jnp.inf))
    k_beta = k * beta[..., None]
    a_kk = jnp.where(strict, jnp.einsum('bhnid,bhnjd->bhnij', k_beta, k) * decay, 0.0)
    eye = jnp.eye(CHUNK, dtype=jnp.float32)
    t_inv = lax.linalg.triangular_solve(eye + a_kk, jnp.broadcast_to(eye, a_kk.shape), left_side=True, lower=True, unit_diagonal=True)
    u = jnp.einsum('bhnij,bhnjv->bhniv', t_inv, v * beta[..., None])
    w = jnp.einsum('bhnij,bhnjd->bhnid', t_inv, k_beta * jnp.exp(cum_g)[..., None])
    a_qk = jnp.einsum('bhnid,bhnjd->bhnij', q, k) * decay
    q_dec = q * jnp.exp(cum_g)[..., None]
    k_dec = k * jnp.exp(cum_g[..., -1:] - cum_g)[..., None]
    g_last = jnp.exp(cum_g[..., -1])

    def step(state, xs):
        u_c, w_c, qd_c, kd_c, aqk_c, gl_c = xs
        v_new = u_c - jnp.einsum('bhck,bhkv->bhcv', w_c, state)
        o_c = jnp.einsum('bhck,bhkv->bhcv', qd_c, state) + jnp.einsum('bhcj,bhjv->bhcv', aqk_c, v_new)
        state = state * gl_c[..., None, None] + jnp.einsum('bhck,bhcv->bhkv', kd_c, v_new)
        return state, o_c

    xs = (jnp.moveaxis(u, 2, 0), jnp.moveaxis(w, 2, 0), jnp.moveaxis(q_dec, 2, 0), jnp.moveaxis(k_dec, 2, 0), jnp.moveaxis(a_qk, 2, 0), jnp.moveaxis(g_last, 2, 0))
    state0 = jnp.zeros((b, h, dk, dv), jnp.float32)
    _, o = lax.scan(step, state0, xs)
    return o.transpose(1, 0, 3, 2, 4).reshape(b, s, h, dv)


def moe_ffn(h, router_w, router_b, w_gate, b_gate, w_up, b_up, w_down, b_down):
    b, s, d = h.shape
    n_tok = b * s
    xt = h.reshape(n_tok, d)
    logits = (xt @ router_w + router_b).astype(jnp.float32)
    top_val, top_idx = lax.top_k(logits, TOP_K)
    gates = jax.nn.softmax(top_val, axis=-1)
    n_assign = n_tok * TOP_K
    flat_e = top_idx.reshape(n_assign).astype(jnp.int32)
    flat_tok = jnp.arange(n_assign, dtype=jnp.int32) // TOP_K
    flat_w = gates.reshape(n_assign)
    e_sorted, order = lax.sort((flat_e, jnp.arange(n_assign, dtype=jnp.int32)), num_keys=1, is_stable=True)
    counts = jnp.zeros((N_EXPERTS,), jnp.int32).at[flat_e].add(1)
    padded = (counts + EXPERT_BLOCK - 1) // EXPERT_BLOCK * EXPERT_BLOCK
    pad_end = jnp.cumsum(padded)
    pad_start = pad_end - padded
    start = jnp.cumsum(counts) - counts
    dest = pad_start[e_sorted] + jnp.arange(n_assign, dtype=jnp.int32) - start[e_sorted]
    n_rows = (n_assign + EXPERT_BLOCK - 1) // EXPERT_BLOCK * EXPERT_BLOCK + N_EXPERTS * EXPERT_BLOCK
    row_tok = jnp.zeros((n_rows,), jnp.int32).at[dest].set(flat_tok[order])
    row_w = jnp.zeros((n_rows,), jnp.float32).at[dest].set(flat_w[order])
    n_blocks = n_rows // EXPERT_BLOCK
    block_e = jnp.minimum(jnp.searchsorted(pad_end, jnp.arange(n_blocks, dtype=jnp.int32) * EXPERT_BLOCK, side='right'), N_EXPERTS - 1)
    x_rows = xt[row_tok].reshape(n_blocks, EXPERT_BLOCK, d)

    def expert_block(args):
        xb, e = args
        gate = jnp.minimum(xb @ w_gate[e] + b_gate[e], SWIGLU_LIMIT)
        up = jnp.clip(xb @ w_up[e] + b_up[e], -SWIGLU_LIMIT, SWIGLU_LIMIT)
        act = (up + 1.0) * gate * jax.nn.sigmoid(SWIGLU_ALPHA * gate)
        return act @ w_down[e] + b_down[e]

    y_rows = lax.map(expert_block, (x_rows, block_e)).reshape(n_rows, d)
    out = jnp.zeros((n_tok, d), jnp.float32).at[row_tok].add(y_rows.astype(jnp.float32) * row_w[:, None])
    return out.reshape(b, s, d).astype(h.dtype)


def hybrid_layer(x, layer_idx, mix_norm_g, w_in, lambda_q1, lambda_k1, lambda_q2, lambda_k2, subln_g, conv_w, a_log, dt_bias, gd_norm_g, w_out, ffn_norm_g, router_w, router_b, w_gate, b_gate, w_up, b_up, w_down, b_down):
    f32 = jnp.float32
    b, s, _ = x.shape
    h = rms_norm(x, mix_norm_g).astype(x.dtype)
    proj = h @ w_in
    split_at = np.cumsum(IN_SPLITS)[:-1].tolist()
    da_q, da_k, da_v, gd_q, gd_k, gd_v, gd_z, gd_b, gd_a, gate_a, gate_b = jnp.split(proj, split_at, axis=-1)

    cos, sin = rope_cos_sin(s, DA_HEAD_DIM)
    q_a = apply_rope(da_q.reshape(b, s, DA_HEADS, 2, DA_HEAD_DIM), cos, sin)
    k_a = apply_rope(da_k.reshape(b, s, DA_HEADS, 2, DA_HEAD_DIM), cos, sin)
    v_a = da_v.reshape(b, s, DA_HEADS, 2 * DA_HEAD_DIM)
    lam_init = 0.8 - 0.6 * math.exp(-0.3 * layer_idx)
    lam = jnp.exp(jnp.sum(lambda_q1.astype(f32) * lambda_k1.astype(f32))) - jnp.exp(jnp.sum(lambda_q2.astype(f32) * lambda_k2.astype(f32))) + lam_init
    o_a = differential_attention(q_a, k_a, v_a, lam)
    y_a = (rms_norm(o_a, subln_g) * (1.0 - lam_init)).reshape(b, s, DA_V_DIM)

    qkv = jax.nn.silu(causal_depthwise_conv(jnp.concatenate([gd_q, gd_k, gd_v], axis=-1), conv_w))
    cq, ck, cv = jnp.split(qkv, [GD_QK_DIM, 2 * GD_QK_DIM], axis=-1)
    q_b = l2_normalize(cq.reshape(b, s, GD_HEADS, GD_HEAD_K)) * (GD_HEAD_K ** -0.5)
    k_b = l2_normalize(ck.reshape(b, s, GD_HEADS, GD_HEAD_K))
    v_b = cv.reshape(b, s, GD_HEADS, GD_HEAD_V).astype(f32)
    beta = jax.nn.sigmoid(gd_b.astype(f32))
    g = -jnp.exp(a_log.astype(f32)) * jax.nn.softplus(gd_a.astype(f32) + dt_bias.astype(f32))
    o_b = gated_delta_rule_chunked(q_b, k_b, v_b, g, beta)
    z = gd_z.reshape(b, s, GD_HEADS, GD_HEAD_V).astype(f32)
    y_b = (rms_norm(o_b, gd_norm_g) * jax.nn.silu(z)).reshape(b, s, GD_V_DIM)

    merged = jax.nn.sigmoid(gate_a.astype(f32)) * y_a + jax.nn.sigmoid(gate_b.astype(f32)) * y_b
    x = x + merged.astype(x.dtype) @ w_out

    h2 = rms_norm(x, ffn_norm_g).astype(x.dtype)
    return x + moe_ffn(h2, router_w, router_b, w_gate, b_gate, w_up, b_up, w_down, b_down)


def setup_inputs(seed: int = 0) -> dict:
    key = jax.random.key(seed)
    ks = jax.random.split(key, 24)
    f32 = jnp.float32
    L = DEPTH

    def normal(k, shape, scale):
        return jax.random.normal(k, shape, f32) * scale

    def gain(k, shape):
        return 1.0 + 0.02 * jax.random.normal(k, shape, f32)

    dt = jnp.exp(jax.random.uniform(ks[10], (L, GD_HEADS), f32, math.log(1e-3), math.log(1e-1)))
    return {
        'x': normal(ks[0], (BATCH, SEQ, D_MODEL), 1.0),
        'mix_norm_g': gain(ks[1], (L, D_MODEL)),
        'w_in': normal(ks[2], (L, D_MODEL, IN_DIM), D_MODEL ** -0.5),
        'da_lambda_q1': normal(ks[3], (L, DA_HEAD_DIM), 0.1),
        'da_lambda_k1': normal(ks[4], (L, DA_HEAD_DIM), 0.1),
        'da_lambda_q2': normal(ks[5], (L, DA_HEAD_DIM), 0.1),
        'da_lambda_k2': normal(ks[6], (L, DA_HEAD_DIM), 0.1),
        'da_subln_g': gain(ks[7], (L, 2 * DA_HEAD_DIM)),
        'gd_conv_w': normal(ks[8], (L, CONV_WIDTH, 2 * GD_QK_DIM + GD_V_DIM), CONV_WIDTH ** -0.5),
        'gd_a_log': jnp.log(jax.random.uniform(ks[9], (L, GD_HEADS), f32, 1.0, 16.0)),
        'gd_dt_bias': dt + jnp.log(-jnp.expm1(-dt)),
        'gd_norm_g': gain(ks[11], (L, GD_HEAD_V)),
        'w_out': normal(ks[12], (L, D_MODEL, D_MODEL), D_MODEL ** -0.5),
        'ffn_norm_g': gain(ks[13], (L, D_MODEL)),
        'router_w': normal(ks[14], (L, D_MODEL, N_EXPERTS), D_MODEL ** -0.5),
        'router_b': normal(ks[15], (L, N_EXPERTS), 0.01),
        'exp_w_gate': normal(ks[16], (L, N_EXPERTS, D_MODEL, D_EXPERT), D_MODEL ** -0.5),
        'exp_b_gate': normal(ks[17], (L, N_EXPERTS, D_EXPERT), 0.01),
        'exp_w_up': normal(ks[18], (L, N_EXPERTS, D_MODEL, D_EXPERT), D_MODEL ** -0.5),
        'exp_b_up': normal(ks[19], (L, N_EXPERTS, D_EXPERT), 0.01),
        'exp_w_down': normal(ks[20], (L, N_EXPERTS, D_EXPERT, D_MODEL), D_EXPERT ** -0.5),
        'exp_b_down': normal(ks[21], (L, N_EXPERTS, D_MODEL), 0.01),
        'final_norm_g': gain(ks[22], (D_MODEL,)),
    }


def reference(x, mix_norm_g, w_in, da_lambda_q1, da_lambda_k1, da_lambda_q2, da_lambda_k2, da_subln_g, gd_conv_w, gd_a_log, gd_dt_bias, gd_norm_g, w_out, ffn_norm_g, router_w, router_b, exp_w_gate, exp_b_gate, exp_w_up, exp_b_up, exp_w_down, exp_b_down, final_norm_g):
    for i in range(DEPTH):
        x = hybrid_layer(x, i, mix_norm_g[i], w_in[i], da_lambda_q1[i], da_lambda_k1[i], da_lambda_q2[i], da_lambda_k2[i], da_subln_g[i], gd_conv_w[i], gd_a_log[i], gd_dt_bias[i], gd_norm_g[i], w_out[i], ffn_norm_g[i], router_w[i], router_b[i], exp_w_gate[i], exp_b_gate[i], exp_w_up[i], exp_b_up[i], exp_w_down[i], exp_b_down[i])
    return rms_norm(x, final_norm_g).astype(x.dtype)
```

```cpp
#include <hip/hip_runtime.h>
#include <cstdio>
#include <cstdint>
#include <cmath>
#include <cstring>

constexpr int T_ = 16384, SEQ = 8192, DM = 1024, IN_DIM = 9232, NEXP = 32;
constexpr float NORM_EPS = 1e-6f;
constexpr float C2 = 0.125f * 1.4426950408889634f;
typedef unsigned short bf16_t;

constexpr size_t MiB = 1u << 20;
constexpr size_t WS_CTL = 0;
constexpr size_t WS_BG = 2 * MiB;
constexpr size_t WS_TOPE = 5 * MiB;
constexpr size_t WS_TOPW = 5 * MiB + 512 * 1024;
constexpr size_t WS_LIST = 6 * MiB;
constexpr size_t WS_SLAB = 8 * MiB;
constexpr size_t SLAB = 32 * MiB;
constexpr size_t WS_R2 = WS_SLAB + 9 * SLAB;
constexpr size_t WS_END = WS_R2 + 192 * MiB;

__device__ __forceinline__ float bf2f(bf16_t v) { return __uint_as_float((unsigned)v << 16); }
__device__ __forceinline__ bf16_t f2bf(float f) { unsigned u = __float_as_uint(f); return (bf16_t)((u + 0x7fffu + ((u >> 16) & 1u)) >> 16); }
__device__ __forceinline__ float wave_sum(float v) {
#pragma unroll
    for (int o = 1; o < 64; o <<= 1) v += __shfl_xor(v, o);
    return v;
}
__device__ __forceinline__ float wave_max(float v) {
#pragma unroll
    for (int o = 1; o < 64; o <<= 1) v = fmaxf(v, __shfl_xor(v, o));
    return v;
}
__device__ __forceinline__ float sigmoidf_(float x) { return 1.0f / (1.0f + __expf(-x)); }

__global__ __launch_bounds__(256) void k_rmsnorm(const float* __restrict__ x, const float* __restrict__ g, float* __restrict__ h) {
    const int row = blockIdx.x * 4 + (threadIdx.x >> 6), lane = threadIdx.x & 63;
    const float4* xr = (const float4*)(x + (size_t)row * DM);
    float4 v[4]; float s = 0.f;
#pragma unroll
    for (int j = 0; j < 4; ++j) { v[j] = xr[lane + 64 * j]; s += v[j].x * v[j].x + v[j].y * v[j].y + v[j].z * v[j].z + v[j].w * v[j].w; }
    s = wave_sum(s);
    const float r = 1.0f / sqrtf(s * (1.0f / DM) + NORM_EPS);
    float4* hr = (float4*)(h + (size_t)row * DM);
#pragma unroll
    for (int j = 0; j < 4; ++j) { const float4 gg = ((const float4*)g)[lane + 64 * j]; float4 o; o.x = v[j].x * r * gg.x; o.y = v[j].y * r * gg.y; o.z = v[j].z * r * gg.z; o.w = v[j].w * r * gg.w; hr[lane + 64 * j] = o; }
}

struct NG { const void* A; const int* list; const int* cnt; const float* B; const float* B2; size_t bstride; int lda, amode, Mfix, ldb, K, N; };
static NG mkNG(const void* A, int lda, int amode, const int* list, const int* cnt, int Mfix, const float* B, const float* B2, int ldb, size_t bstride, int K, int N) {
    NG g; memset(&g, 0, sizeof g); g.A = A; g.lda = lda; g.amode = amode; g.list = list; g.cnt = cnt; g.Mfix = Mfix; g.B = B; g.B2 = B2; g.ldb = ldb; g.bstride = bstride; g.K = K; g.N = N; return g; }
template <bool ABF, bool DUAL, class Epi>
__global__ __launch_bounds__(256) void ngemm(NG g, Epi epi) {
    const int e = blockIdx.z;
    const int M = g.cnt ? g.cnt[e] : g.Mfix;
    const int m0 = blockIdx.y * 64; if (m0 >= M) return;
    const int n0 = blockIdx.x * 64;
    __shared__ float As[16][65];
    __shared__ float Bs[DUAL ? 2 : 1][16][64];
    const int tid = threadIdx.x, tx = tid & 15, ty = tid >> 4;
    const int ar = tid >> 2, ak = (tid & 3) * 4;
    const int grow = m0 + ar; const bool av = grow < M; size_t srow = 0;
    if (av) { if (g.amode == 0) srow = grow; else { const int aid = g.list[e * 16384 + grow]; srow = (g.amode == 1) ? (size_t)(aid >> 2) : (size_t)aid; } }
    const int bk = tid >> 4, bn = (tid & 15) * 4;
    const float* Bp = g.B + (size_t)e * g.bstride; const float* Bp2 = DUAL ? g.B2 + (size_t)e * g.bstride : nullptr;
    const bool bv = (n0 + bn) < g.N;
    float acc[4][4], acc2[4][4];
#pragma unroll
    for (int i = 0; i < 4; ++i)
#pragma unroll
        for (int j = 0; j < 4; ++j) { acc[i][j] = 0.f; acc2[i][j] = 0.f; }
    for (int k0 = 0; k0 < g.K; k0 += 16) {
        float a4[4] = {0.f, 0.f, 0.f, 0.f};
        if (av) {
            if (ABF) { const uint2 u = *(const uint2*)((const bf16_t*)g.A + srow * g.lda + k0 + ak); a4[0] = __uint_as_float(u.x << 16); a4[1] = __uint_as_float(u.x & 0xffff0000u); a4[2] = __uint_as_float(u.y << 16); a4[3] = __uint_as_float(u.y & 0xffff0000u); }
            else { const float4 f = *(const float4*)((const float*)g.A + srow * g.lda + k0 + ak); a4[0] = f.x; a4[1] = f.y; a4[2] = f.z; a4[3] = f.w; }
        }
#pragma unroll
        for (int i = 0; i < 4; ++i) As[ak + i][ar] = a4[i];
        { float4 f = make_float4(0.f, 0.f, 0.f, 0.f); if (bv) f = *(const float4*)(Bp + (size_t)(k0 + bk) * g.ldb + n0 + bn); *(float4*)&Bs[0][bk][bn] = f;
          if (DUAL) { float4 f2 = make_float4(0.f, 0.f, 0.f, 0.f); if (bv) f2 = *(const float4*)(Bp2 + (size_t)(k0 + bk) * g.ldb + n0 + bn); *(float4*)&Bs[DUAL ? 1 : 0][bk][bn] = f2; } }
        __syncthreads();
#pragma unroll
        for (int kk = 0; kk < 16; ++kk) {
            float a[4];
#pragma unroll
            for (int i = 0; i < 4; ++i) a[i] = As[kk][ty * 4 + i];
            const float4 b = *(const float4*)&Bs[0][kk][tx * 4];
#pragma unroll
            for (int i = 0; i < 4; ++i) { acc[i][0] += a[i] * b.x; acc[i][1] += a[i] * b.y; acc[i][2] += a[i] * b.z; acc[i][3] += a[i] * b.w; }
            if (DUAL) { const float4 b2 = *(const float4*)&Bs[DUAL ? 1 : 0][kk][tx * 4];
#pragma unroll
                for (int i = 0; i < 4; ++i) { acc2[i][0] += a[i] * b2.x; acc2[i][1] += a[i] * b2.y; acc2[i][2] += a[i] * b2.z; acc2[i][3] += a[i] * b2.w; } }
        }
        __syncthreads();
    }
#pragma unroll
    for (int i = 0; i < 4; ++i) { const int gr = m0 + ty * 4 + i; if (gr >= M) continue;
#pragma unroll
        for (int j = 0; j < 4; ++j) { const int gc = n0 + tx * 4 + j; if (gc >= g.N) continue; epi(e, gr, gc, acc[i][j], acc2[i][j]); } }
}

struct EpiProj {
    float* qk_tmp; bf16_t* slab; float* bg; const float* a_log; const float* dt_bias;
    __device__ __forceinline__ void operator()(int, int r, int c, float v, float) const {
        if (c < 2048) { qk_tmp[(size_t)r * 2048 + c] = v; return; }
        if (c < 7168) { const int s = c >> 10; slab[(size_t)s * (SLAB / 2) + (size_t)r * DM + (c & 1023)] = f2bf(v); return; }
        if (c < 7176) { bg[(size_t)r * 16 + (c - 7168)] = 1.0f / (1.0f + expf(-v)); return; }
        if (c < 7184) { const int h = c - 7176; const float z = v + dt_bias[h]; const float sp = (z > 20.f) ? z : log1pf(expf(z)); bg[(size_t)r * 16 + 8 + h] = -expf(a_log[h]) * sp; return; }
        const int cc = c - 7184; const int s = 7 + (cc >> 10); slab[(size_t)s * (SLAB / 2) + (size_t)r * DM + (cc & 1023)] = f2bf(v);
    }
};
struct EpiOut { const float* x; float* x1; __device__ __forceinline__ void operator()(int, int r, int c, float v, float) const { x1[(size_t)r * DM + c] = x[(size_t)r * DM + c] + v; } };
struct EpiAct { const int* list; const float* bgate; const float* bup; bf16_t* act;
    __device__ __forceinline__ void operator()(int e, int r, int c, float vg, float vu) const {
        const int aid = list[e * 16384 + r];
        const float gate = fminf(vg + bgate[e * 1024 + c], 7.0f); const float up = fminf(fmaxf(vu + bup[e * 1024 + c], -7.0f), 7.0f);
        act[(size_t)aid * DM + c] = f2bf((up + 1.0f) * gate * (1.0f / (1.0f + expf(-1.702f * gate))));
    } };
struct EpiDown { const int* list; const float* bdown; const float* topw; bf16_t* y;
    __device__ __forceinline__ void operator()(int e, int r, int c, float v, float) const {
        const int aid = list[e * 16384 + r];
        y[(size_t)aid * DM + c] = f2bf((v + bdown[e * 1024 + c]) * topw[aid]);
    } };

__global__ __launch_bounds__(256) void k_rope(const float* __restrict__ qk_tmp, bf16_t* __restrict__ slab) {
    const size_t idx = (size_t)blockIdx.x * 256 + threadIdx.x;
    const int row = (int)(idx >> 10); const int p = (int)(idx & 1023);
    const int grp = p >> 5, i = p & 31;
    const int c = grp * 64 + i;
    const int pos = row % SEQ;
    const float inv_freq = 1.0f / powf(10000.0f, (float)(2 * i) / 64.0f);
    const float ang = (float)pos * inv_freq;
    const float cs = cosf(ang), sn = sinf(ang);
    const float a = qk_tmp[(size_t)row * 2048 + c], b = qk_tmp[(size_t)row * 2048 + c + 32];
    float o0 = a * cs - b * sn, o1 = b * cs + a * sn;
    const int s = c >> 10;
    if (s == 0) { o0 *= C2; o1 *= C2; }
    bf16_t* dst = slab + (size_t)s * (SLAB / 2) + (size_t)row * DM + (c & 1023);
    dst[0] = f2bf(o0); dst[32] = f2bf(o1);
}

__global__ __launch_bounds__(256) void k_attn_naive(const bf16_t* __restrict__ QA, const bf16_t* __restrict__ KA, const bf16_t* __restrict__ VA, bf16_t* __restrict__ O1, bf16_t* __restrict__ O2) {
    const int w = __builtin_amdgcn_readfirstlane(threadIdx.x >> 6), lane = threadIdx.x & 63;
    const int row = blockIdx.x * 4 + w;
    const int hc = blockIdx.y, h = hc >> 1, c = hc & 1;
    const int b = row / SEQ, t = row % SEQ;
    float q[64];
    { const uint4* qp = (const uint4*)(QA + (size_t)row * DM + h * 128 + c * 64);
#pragma unroll
      for (int i = 0; i < 8; ++i) { const uint4 u = qp[i]; q[8 * i + 0] = __uint_as_float(u.x << 16); q[8 * i + 1] = __uint_as_float(u.x & 0xffff0000u); q[8 * i + 2] = __uint_as_float(u.y << 16); q[8 * i + 3] = __uint_as_float(u.y & 0xffff0000u);
          q[8 * i + 4] = __uint_as_float(u.z << 16); q[8 * i + 5] = __uint_as_float(u.z & 0xffff0000u); q[8 * i + 6] = __uint_as_float(u.w << 16); q[8 * i + 7] = __uint_as_float(u.w & 0xffff0000u); } }
    const bf16_t* Kb = KA + (size_t)b * SEQ * DM + h * 128 + c * 64;
    const bf16_t* Vb = VA + (size_t)b * SEQ * DM + h * 128 + 2 * lane;
    float m = -INFINITY, l = 0.f, o0 = 0.f, o1 = 0.f;
    for (int kb = 0; kb <= t; kb += 64) {
        const int key = kb + lane; float s = -INFINITY;
        if (key <= t) { const uint4* kp = (const uint4*)(Kb + (size_t)key * DM); float d = 0.f;
#pragma unroll
            for (int i = 0; i < 8; ++i) { const uint4 u = kp[i]; d += q[8 * i + 0] * __uint_as_float(u.x << 16) + q[8 * i + 1] * __uint_as_float(u.x & 0xffff0000u) + q[8 * i + 2] * __uint_as_float(u.y << 16) + q[8 * i + 3] * __uint_as_float(u.y & 0xffff0000u)
                  + q[8 * i + 4] * __uint_as_float(u.z << 16) + q[8 * i + 5] * __uint_as_float(u.z & 0xffff0000u) + q[8 * i + 6] * __uint_as_float(u.w << 16) + q[8 * i + 7] * __uint_as_float(u.w & 0xffff0000u); }
            s = d; }
        const float mn = fmaxf(m, wave_max(s));
        const float p = (key <= t) ? exp2f(s - mn) : 0.f;
        const float alpha = exp2f(m - mn);
        l = l * alpha + wave_sum(p); o0 *= alpha; o1 *= alpha; m = mn;
        const int nk = min(64, t - kb + 1);
        for (int j = 0; j < nk; ++j) {
            const float pj = __uint_as_float(__builtin_amdgcn_readlane(__float_as_uint(p), j));
            const unsigned u = *(const unsigned*)(Vb + (size_t)(kb + j) * DM);
            o0 += pj * __uint_as_float(u << 16); o1 += pj * __uint_as_float(u & 0xffff0000u);
        }
    }
    bf16_t* O = c ? O2 : O1;
    const float il = 1.0f / l;
    *(unsigned*)(O + (size_t)row * DM + h * 128 + 2 * lane) = (unsigned)f2bf(o0 * il) | ((unsigned)f2bf(o1 * il) << 16);
}

__global__ __launch_bounds__(256) void k_gdn_conv(const bf16_t* __restrict__ slab, const float* __restrict__ conv_w, float* __restrict__ cq, float* __restrict__ ck, float* __restrict__ cv) {
    const int wv = threadIdx.x >> 6, lane = threadIdx.x & 63;
    const int item = blockIdx.x * 4 + wv; const int row = item >> 3, h = item & 7;
    const int t = row % SEQ; const int col = h * 128 + 2 * lane;
#pragma unroll
    for (int ty = 0; ty < 3; ++ty) {
        const bf16_t* src = slab + (size_t)(3 + ty) * (SLAB / 2);
        float a0 = 0.f, a1 = 0.f;
#pragma unroll
        for (int j = 0; j < 4; ++j) { const int tt = t - 3 + j; if (tt < 0) continue;
            const unsigned u = *(const unsigned*)(src + (size_t)(row - 3 + j) * DM + col);
            const float w0 = conv_w[j * 3072 + ty * 1024 + col], w1 = conv_w[j * 3072 + ty * 1024 + col + 1];
            a0 += w0 * __uint_as_float(u << 16); a1 += w1 * __uint_as_float(u & 0xffff0000u); }
        a0 = a0 / (1.0f + expf(-a0)); a1 = a1 / (1.0f + expf(-a1));
        if (ty < 2) { const float ss = wave_sum(a0 * a0 + a1 * a1); float sc = 1.0f / sqrtf(ss + NORM_EPS); if (ty == 0) sc *= 0.08838834764831845f; a0 *= sc; a1 *= sc; }
        float* dst = (ty == 0 ? cq : ty == 1 ? ck : cv) + (size_t)row * DM + col;
        *(float2*)dst = make_float2(a0, a1);
    }
}

__global__ __launch_bounds__(128) void k_gdn_scan(const float* __restrict__ cq, const float* __restrict__ ck, const float* __restrict__ cv, const float* __restrict__ bg, bf16_t* __restrict__ OB) {
    __shared__ float kq[2][256];
    const int bh = blockIdx.x, b = bh >> 3, h = bh & 7, c = threadIdx.x;
    float S[128];
#pragma unroll
    for (int i = 0; i < 128; ++i) S[i] = 0.f;
    const size_t base = (size_t)b * SEQ;
    float kn = ck[base * DM + h * 128 + c], qn = cq[base * DM + h * 128 + c], vn = cv[base * DM + h * 128 + c], bn = bg[base * 16 + h], gn = bg[base * 16 + 8 + h];
    for (int t = 0; t < SEQ; ++t) {
        const int buf = t & 1;
        kq[buf][c] = kn; kq[buf][128 + c] = qn;
        const float v = vn, beta = bn, a = expf(gn);
        if (t + 1 < SEQ) { const size_t r = base + t + 1; kn = ck[r * DM + h * 128 + c]; qn = cq[r * DM + h * 128 + c]; vn = cv[r * DM + h * 128 + c]; bn = bg[r * 16 + h]; gn = bg[r * 16 + 8 + h]; }
        __syncthreads();
        float kS = 0.f;
#pragma unroll
        for (int i = 0; i < 128; i += 4) { const float4 k4 = *(const float4*)&kq[buf][i]; kS += k4.x * S[i] + k4.y * S[i + 1] + k4.z * S[i + 2] + k4.w * S[i + 3]; }
        const float u = beta * (v - a * kS);
        float o = 0.f;
#pragma unroll
        for (int i = 0; i < 128; i += 4) { const float4 k4 = *(const float4*)&kq[buf][i]; const float4 q4 = *(const float4*)&kq[buf][128 + i];
            S[i] = a * S[i] + k4.x * u; S[i + 1] = a * S[i + 1] + k4.y * u; S[i + 2] = a * S[i + 2] + k4.z * u; S[i + 3] = a * S[i + 3] + k4.w * u;
            o += q4.x * S[i] + q4.y * S[i + 1] + q4.z * S[i + 2] + q4.w * S[i + 3]; }
        OB[(base + t) * DM + h * 128 + c] = f2bf(o);
    }
}

__global__ __launch_bounds__(256) void k_merge(const bf16_t* __restrict__ O1, const bf16_t* __restrict__ O2, const bf16_t* __restrict__ OB, const bf16_t* __restrict__ GZ, const bf16_t* __restrict__ GA, const bf16_t* __restrict__ GB,
                                               const float* __restrict__ lq1, const float* __restrict__ lk1, const float* __restrict__ lq2, const float* __restrict__ lk2, const float* __restrict__ subln_g, const float* __restrict__ gdn_g, bf16_t* __restrict__ MG) {
    const int wv = threadIdx.x >> 6, lane = threadIdx.x & 63;
    const int item = blockIdx.x * 4 + wv; const int row = item >> 3, h = item & 7;
    const float lam = expf(wave_sum(lq1[lane] * lk1[lane])) - expf(wave_sum(lq2[lane] * lk2[lane])) + 0.2f;
    const size_t off = (size_t)row * DM + h * 128 + 2 * lane;
    const unsigned u1 = *(const unsigned*)(O1 + off), u2 = *(const unsigned*)(O2 + off), ub = *(const unsigned*)(OB + off), uz = *(const unsigned*)(GZ + off), ua = *(const unsigned*)(GA + off), ugb = *(const unsigned*)(GB + off);
    const float d0 = __uint_as_float(u1 << 16) - lam * __uint_as_float(u2 << 16), d1 = __uint_as_float(u1 & 0xffff0000u) - lam * __uint_as_float(u2 & 0xffff0000u);
    const float ra = 1.0f / sqrtf(wave_sum(d0 * d0 + d1 * d1) * (1.0f / 128.0f) + NORM_EPS);
    const float ya0 = d0 * ra * subln_g[2 * lane] * 0.8f, ya1 = d1 * ra * subln_g[2 * lane + 1] * 0.8f;
    const float b0 = __uint_as_float(ub << 16), b1 = __uint_as_float(ub & 0xffff0000u);
    const float rb = 1.0f / sqrtf(wave_sum(b0 * b0 + b1 * b1) * (1.0f / 128.0f) + NORM_EPS);
    const float z0 = __uint_as_float(uz << 16), z1 = __uint_as_float(uz & 0xffff0000u);
    const float yb0 = b0 * rb * gdn_g[2 * lane] * (z0 / (1.0f + expf(-z0))), yb1 = b1 * rb * gdn_g[2 * lane + 1] * (z1 / (1.0f + expf(-z1)));
    const float m0 = sigmoidf_(__uint_as_float(ua << 16)) * ya0 + sigmoidf_(__uint_as_float(ugb << 16)) * yb0;
    const float m1 = sigmoidf_(__uint_as_float(ua & 0xffff0000u)) * ya1 + sigmoidf_(__uint_as_float(ugb & 0xffff0000u)) * yb1;
    *(unsigned*)(MG + off) = (unsigned)f2bf(m0) | ((unsigned)f2bf(m1) << 16);
}

__global__ __launch_bounds__(256) void k_router(const float* __restrict__ x1, const float* __restrict__ g2, const float* __restrict__ rw, const float* __restrict__ rb, bf16_t* __restrict__ H2, int* __restrict__ tope, float* __restrict__ topw, int* __restrict__ cnt, int* __restrict__ list) {
    const int row = blockIdx.x * 4 + (threadIdx.x >> 6), lane = threadIdx.x & 63;
    const float4* xr = (const float4*)(x1 + (size_t)row * DM);
    float4 v[4]; float s = 0.f;
#pragma unroll
    for (int j = 0; j < 4; ++j) { v[j] = xr[lane + 64 * j]; s += v[j].x * v[j].x + v[j].y * v[j].y + v[j].z * v[j].z + v[j].w * v[j].w; }
    s = wave_sum(s);
    const float r = 1.0f / sqrtf(s * (1.0f / DM) + NORM_EPS);
    float lg[32];
#pragma unroll
    for (int e = 0; e < 32; ++e) lg[e] = 0.f;
#pragma unroll
    for (int j = 0; j < 4; ++j) { const float4 gg = ((const float4*)g2)[lane + 64 * j];
        float hv[4] = {v[j].x * r * gg.x, v[j].y * r * gg.y, v[j].z * r * gg.z, v[j].w * r * gg.w};
        uint2 pk; pk.x = (unsigned)f2bf(hv[0]) | ((unsigned)f2bf(hv[1]) << 16); pk.y = (unsigned)f2bf(hv[2]) | ((unsigned)f2bf(hv[3]) << 16);
        *(uint2*)(H2 + (size_t)row * DM + 4 * (lane + 64 * j)) = pk;
#pragma unroll
        for (int q = 0; q < 4; ++q) { const float4* wr = (const float4*)(rw + (size_t)(4 * (lane + 64 * j) + q) * 32);
#pragma unroll
            for (int e4 = 0; e4 < 8; ++e4) { const float4 w4 = wr[e4]; lg[4 * e4] += hv[q] * w4.x; lg[4 * e4 + 1] += hv[q] * w4.y; lg[4 * e4 + 2] += hv[q] * w4.z; lg[4 * e4 + 3] += hv[q] * w4.w; } } }
#pragma unroll
    for (int e = 0; e < 32; ++e) lg[e] = wave_sum(lg[e]) + rb[e];
    int sel[4]; float sv[4];
#pragma unroll
    for (int k = 0; k < 4; ++k) { float best = -INFINITY; int bi = 0;
#pragma unroll
        for (int e = 0; e < 32; ++e) if (lg[e] > best) { best = lg[e]; bi = e; }
        sel[k] = bi; sv[k] = best;
#pragma unroll
        for (int e = 0; e < 32; ++e) if (e == bi) lg[e] = -INFINITY; }
    const float e0 = 1.0f, e1 = expf(sv[1] - sv[0]), e2 = expf(sv[2] - sv[0]), e3 = expf(sv[3] - sv[0]); const float inv = 1.0f / (e0 + e1 + e2 + e3);
    if (lane < 4) { const int k = lane; const int ex = (k == 0) ? sel[0] : (k == 1) ? sel[1] : (k == 2) ? sel[2] : sel[3]; const float wv = ((k == 0) ? e0 : (k == 1) ? e1 : (k == 2) ? e2 : e3) * inv;
        tope[row * 4 + k] = ex; topw[row * 4 + k] = wv;
        const int pos = atomicAdd(&cnt[ex], 1); list[ex * 16384 + pos] = row * 4 + k; }
}

__global__ __launch_bounds__(256) void k_final(float* __restrict__ x1out, const bf16_t* __restrict__ y, const float* __restrict__ g) {
    const int row = blockIdx.x * 4 + (threadIdx.x >> 6), lane = threadIdx.x & 63;
    float4* xr = (float4*)(x1out + (size_t)row * DM);
    float4 v[4]; float s = 0.f;
#pragma unroll
    for (int j = 0; j < 4; ++j) { v[j] = xr[lane + 64 * j];
#pragma unroll
        for (int k = 0; k < 4; ++k) { const uint2 u = *(const uint2*)(y + (size_t)(row * 4 + k) * DM + 4 * (lane + 64 * j));
            v[j].x += __uint_as_float(u.x << 16); v[j].y += __uint_as_float(u.x & 0xffff0000u); v[j].z += __uint_as_float(u.y << 16); v[j].w += __uint_as_float(u.y & 0xffff0000u); }
        s += v[j].x * v[j].x + v[j].y * v[j].y + v[j].z * v[j].z + v[j].w * v[j].w; }
    s = wave_sum(s);
    const float r = 1.0f / sqrtf(s * (1.0f / DM) + NORM_EPS);
#pragma unroll
    for (int j = 0; j < 4; ++j) { const float4 gg = ((const float4*)g)[lane + 64 * j]; float4 o; o.x = v[j].x * r * gg.x; o.y = v[j].y * r * gg.y; o.z = v[j].z * r * gg.z; o.w = v[j].w * r * gg.w; xr[lane + 64 * j] = o; }
}

extern "C" void kernel_launch(void* const* d_in, const int* in_sizes, int n_in, void* d_out, int out_size, void* d_ws, size_t ws_size, hipStream_t stream) {
    if (n_in != 23 || ws_size < WS_END || out_size != T_ * DM) { fprintf(stderr, "kernel_launch: unexpected shapes n_in %d ws %zu out %d\n", n_in, ws_size, out_size); return; }
    const float* x = (const float*)d_in[0]; const float* mix_g = (const float*)d_in[1]; const float* w_in = (const float*)d_in[2];
    const float *lq1 = (const float*)d_in[3], *lk1 = (const float*)d_in[4], *lq2 = (const float*)d_in[5], *lk2 = (const float*)d_in[6];
    const float* subln_g = (const float*)d_in[7]; const float* conv_w = (const float*)d_in[8]; const float* a_log = (const float*)d_in[9]; const float* dt_bias = (const float*)d_in[10];
    const float* gdn_g = (const float*)d_in[11]; const float* w_out = (const float*)d_in[12]; const float* ffn_g = (const float*)d_in[13]; const float* router_w = (const float*)d_in[14]; const float* router_b = (const float*)d_in[15];
    const float *wg = (const float*)d_in[16], *bgate = (const float*)d_in[17], *wu = (const float*)d_in[18], *bup = (const float*)d_in[19], *wd = (const float*)d_in[20], *bdown = (const float*)d_in[21]; const float* final_g = (const float*)d_in[22];
    unsigned char* ws = (unsigned char*)d_ws; float* out = (float*)d_out;
    int* cnt = (int*)(ws + WS_CTL); float* bg = (float*)(ws + WS_BG); int* tope = (int*)(ws + WS_TOPE); float* topw = (float*)(ws + WS_TOPW); int* list = (int*)(ws + WS_LIST);
    bf16_t* slab = (bf16_t*)(ws + WS_SLAB);
    bf16_t *QA = slab, *KA = slab + 1 * (SLAB / 2), *VA = slab + 2 * (SLAB / 2), *GQ = slab + 3 * (SLAB / 2), *GZ = slab + 6 * (SLAB / 2), *GA = slab + 7 * (SLAB / 2), *GB = slab + 8 * (SLAB / 2);
    float* hbuf = (float*)(ws + WS_R2); float* qk_tmp = (float*)(ws + WS_R2 + 64 * MiB);
    float *cq = (float*)(ws + WS_R2), *ck = (float*)(ws + WS_R2 + 64 * MiB), *cv = (float*)(ws + WS_R2 + 128 * MiB);
    bf16_t* O1 = (bf16_t*)d_out; bf16_t* O2 = O1 + (size_t)T_ * DM;
    bf16_t* act = (bf16_t*)(ws + WS_R2); bf16_t* ybuf = VA;

    (void)hipMemsetAsync(ws + WS_CTL, 0, 4096, stream);
    k_rmsnorm<<<T_ / 4, 256, 0, stream>>>(x, mix_g, hbuf);
    { NG g = mkNG(hbuf, DM, 0, nullptr, nullptr, T_, w_in, nullptr, IN_DIM, 0, DM, IN_DIM); EpiProj E{qk_tmp, slab, bg, a_log, dt_bias};
      ngemm<false, false, EpiProj><<<dim3((IN_DIM + 63) / 64, T_ / 64, 1), 256, 0, stream>>>(g, E); }
    k_rope<<<T_ * 1024 / 256, 256, 0, stream>>>(qk_tmp, slab);
    k_attn_naive<<<dim3(T_ / 4, 16), 256, 0, stream>>>(QA, KA, VA, O1, O2);
    k_gdn_conv<<<T_ * 8 / 4, 256, 0, stream>>>(slab, conv_w, cq, ck, cv);
    k_gdn_scan<<<16, 128, 0, stream>>>(cq, ck, cv, bg, GQ);
    k_merge<<<T_ * 8 / 4, 256, 0, stream>>>(O1, O2, GQ, GZ, GA, GB, lq1, lk1, lq2, lk2, subln_g, gdn_g, QA);
    { NG g = mkNG(QA, DM, 0, nullptr, nullptr, T_, w_out, nullptr, DM, 0, DM, DM); EpiOut E{x, out};
      ngemm<true, false, EpiOut><<<dim3(DM / 64, T_ / 64, 1), 256, 0, stream>>>(g, E); }
    k_router<<<T_ / 4, 256, 0, stream>>>(out, ffn_g, router_w, router_b, KA, tope, topw, cnt, list);
    { NG g = mkNG(KA, DM, 1, list, cnt, 0, wg, wu, DM, (size_t)DM * DM, DM, DM); EpiAct E{list, bgate, bup, act};
      ngemm<true, true, EpiAct><<<dim3(DM / 64, T_ / 64, NEXP), 256, 0, stream>>>(g, E); }
    { NG g = mkNG(act, DM, 2, list, cnt, 0, wd, nullptr, DM, (size_t)DM * DM, DM, DM); EpiDown E{list, bdown, topw, ybuf};
      ngemm<true, false, EpiDown><<<dim3(DM / 64, T_ / 64, NEXP), 256, 0, stream>>>(g, E); }
    k_final<<<T_ / 4, 256, 0, stream>>>(out, ybuf, final_g);
}
```

```cpp
#include <hip/hip_runtime.h>
#include <hip/hip_bf16.h>
#include <cstdio>
#include <cstdint>
#include <cmath>
#include <cstring>

constexpr int T_ = 16384, SEQ = 8192, DM = 1024, IN_DIM = 9232, NEXP = 32;
constexpr float NORM_EPS = 1e-6f;
constexpr float C2 = 0.125f * 1.4426950408889634f;
typedef unsigned short bf16_t;

constexpr size_t MiB = 1u << 20;
constexpr size_t WS_CTL = 0, CTL_ZERO_BYTES = 64 * 1024;
constexpr size_t WS_BG = 2 * MiB;
constexpr size_t WS_ROPE = 3 * MiB;
constexpr size_t WS_TOPE = 5 * MiB;
constexpr size_t WS_TOPW = 5 * MiB + 512 * 1024;
constexpr size_t WS_LIST = 6 * MiB;
constexpr size_t WS_SLAB = 8 * MiB;
constexpr size_t SLAB = 32 * MiB;
constexpr size_t WS_H2 = WS_SLAB;
constexpr size_t WS_R2 = WS_SLAB + 9 * SLAB;
constexpr size_t WS_WOUT = WS_R2 + 192 * MiB;
constexpr size_t WS_SLOT = WS_WOUT + 2 * MiB;
constexpr size_t WS_END = WS_SLOT + 4 * MiB;
constexpr int CW_CNT = 8192;
constexpr int CW_Q = 64;
constexpr int CW_BAR = 4096;

__device__ __forceinline__ float bf2f(bf16_t v) { return __uint_as_float((unsigned)v << 16); }
__device__ __forceinline__ bf16_t f2bf(float f) { unsigned u = __float_as_uint(f); return (bf16_t)((u + 0x7fffu + ((u >> 16) & 1u)) >> 16); }
#define WAVE_DPP(x, ctrl, rmask, old) __int_as_float(__builtin_amdgcn_update_dpp(__float_as_int(old), __float_as_int(x), ctrl, rmask, 0xF, false))
__device__ __forceinline__ float wave_sum(float v) {
    v += WAVE_DPP(v, 0xB1, 0xF, 0.f); v += WAVE_DPP(v, 0x4E, 0xF, 0.f); v += WAVE_DPP(v, 0x141, 0xF, 0.f); v += WAVE_DPP(v, 0x140, 0xF, 0.f);
    v += WAVE_DPP(v, 0x142, 0xA, 0.f); v += WAVE_DPP(v, 0x143, 0xC, 0.f);
    return __int_as_float(__builtin_amdgcn_readlane(__float_as_int(v), 63));
}
__device__ __forceinline__ float wave_max(float v) {
    v = fmaxf(v, WAVE_DPP(v, 0xB1, 0xF, v)); v = fmaxf(v, WAVE_DPP(v, 0x4E, 0xF, v)); v = fmaxf(v, WAVE_DPP(v, 0x141, 0xF, v)); v = fmaxf(v, WAVE_DPP(v, 0x140, 0xF, v));
    v = fmaxf(v, WAVE_DPP(v, 0x142, 0xA, v)); v = fmaxf(v, WAVE_DPP(v, 0x143, 0xC, v));
    return __int_as_float(__builtin_amdgcn_readlane(__float_as_int(v), 63));
}
__device__ __forceinline__ float sigmoidf_(float x) { return __builtin_amdgcn_rcpf(1.0f + __expf(-x)); }

constexpr int TID_TBL_OFF = 152576 + 320 + 256;
__device__ __forceinline__ int hw_slot() { return (int)(__builtin_amdgcn_s_getreg((5 << 11) | 4) & 63u); }
__device__ __forceinline__ int lane_now() { unsigned z; asm volatile("v_mov_b32 %0, 0" : "=v"(z)); return (int)__builtin_amdgcn_mbcnt_hi(~0u, __builtin_amdgcn_mbcnt_lo(~0u, z)); }
__device__ __forceinline__ int wave_now(const void* ring_base) { const __attribute__((address_space(3))) unsigned* T = (const __attribute__((address_space(3))) unsigned*)((const __attribute__((address_space(3))) unsigned char*)(unsigned)(uintptr_t)ring_base + TID_TBL_OFF);
    return __builtin_amdgcn_readfirstlane((int)T[hw_slot()]); }
__device__ __forceinline__ int tid_now(const void* ring_base) { return wave_now(ring_base) * 64 + lane_now(); }

#ifndef PROBE_ID
#define PROBE_ID -1
#endif
#define PRB4_B(id, PRB) do { if (PROBE_ID == (id) && blockIdx.x == 0 && threadIdx.x == 256) (PRB)[1] = (unsigned)__builtin_amdgcn_s_memrealtime(); } while (0)
#define PRB4_E(id, PRB) do { if (PROBE_ID == (id) && blockIdx.x == 0 && threadIdx.x == 256) (PRB)[0] += (unsigned)__builtin_amdgcn_s_memrealtime() - (PRB)[1]; } while (0)
#ifndef PROBE_TID
#define PROBE_TID 0
#endif
#define PRB_B(id, PRB) do { if (PROBE_ID == (id) && blockIdx.x == 0 && threadIdx.x == PROBE_TID) (PRB)[1] = (unsigned)__builtin_amdgcn_s_memrealtime(); } while (0)
#define PRBC_B(id, PRB) do { if (PROBE_ID == (id) && blockIdx.x == 0 && threadIdx.x == 0) (PRB)[1] = (unsigned)__builtin_amdgcn_s_memtime(); } while (0)
#define PRBC_E(id, PRB) do { if (PROBE_ID == (id) && blockIdx.x == 0 && threadIdx.x == 0) (PRB)[0] += ((unsigned)__builtin_amdgcn_s_memtime() - (PRB)[1]) >> 4; } while (0)
#define PRB_E(id, PRB) do { if (PROBE_ID == (id) && blockIdx.x == 0 && threadIdx.x == PROBE_TID) (PRB)[0] += (unsigned)__builtin_amdgcn_s_memrealtime() - (PRB)[1]; } while (0)

namespace pg8 {
#define PG8_LAS __attribute__((address_space(3)))
typedef unsigned short bf16_t;
typedef short bf16x8 __attribute__((ext_vector_type(8)));
typedef float f32x4 __attribute__((ext_vector_type(4)));
typedef unsigned u32x4 __attribute__((ext_vector_type(4)));
constexpr int BM = 256, BK = 64, HALF = 128, HTB = HALF * BK * 2  , STAGE_BYTES = 8 * HTB, NXCD = 8, WGM = 8;

__host__ __device__ __forceinline__ int lds_byte(int r, int c) { const int st = (r >> 4) * 2 + (c >> 5), rr = r & 15, cc = c & 31, ob = rr * 64 + cc * 2; return st * 1024 + (ob ^ (((ob >> 9) & 1) << 5)); }
__host__ __device__ __forceinline__ void stage_rc(int b, int& R, int& C) { const int st = b / 1024, sb = b % 1024, swz = sb ^ (((sb >> 9) & 1) << 5); R = (st >> 1) * 16 + swz / 64; C = (st & 1) * 32 + (swz % 64) / 2; }
__host__ __device__ __forceinline__ int perm32(int rho) { const int n = rho >> 4, i = rho & 15; return 8 * (i >> 2) + 4 * n + (i & 3); }

struct Unit { int pm, pn; long boff; int e; int half, rofs; };
struct Gemm { const bf16_t* A; const bf16_t* Bt; int M, N, K; const int* list; unsigned ldsStart, ldsCnt; };

struct StaticOrder {
    int nM, nN, nwg, G, c;
    __host__ __device__ void init(int M, int N, int G_, int c_) { nM = M / BM; nN = N / BM; nwg = nM * nN; G = G_; c = c_; }
    __host__ __device__ bool next(int i, Unit& u) const { const long L = (long)i * G + c; if (L >= nwg) return false; map((int)L, u); return true; }
    __host__ __device__ void map(int L, Unit& u) const {
        int wgid = L; { const int q = nwg / NXCD, r = nwg % NXCD, xcd = wgid % NXCD, off = wgid / NXCD; wgid = (xcd < r ? xcd * (q + 1) : r * (q + 1) + (xcd - r) * q) + off; }
        const int nig = WGM * nN, gid = wgid / nig, fm = gid * WGM, gsz = (nM - fm) < WGM ? (nM - fm) : WGM;
        u.pm = fm + ((wgid % nig) % gsz); u.pn = (wgid % nig) / gsz; u.boff = 0; u.e = 0; u.half = 0; u.rofs = 0;
    }
    __device__ __forceinline__ void a_ready(const Unit&) const {}
    __device__ __forceinline__ void done(const Unit&) const {}
};


#ifndef GAS
#define GAS __attribute__((address_space(1)))
#endif
__device__ __forceinline__ unsigned cvt_pk_bf16(float lo, float hi) { unsigned r; asm volatile("v_cvt_pk_bf16_f32 %0, %1, %2" : "=v"(r) : "v"(lo), "v"(hi)); return r; }
typedef unsigned u32x2 __attribute__((ext_vector_type(2)));

struct EpiProj {
    static constexpr bool PERM = true, AFTER_DRAIN = false;
    bf16_t* slab; const float* rope;
    __device__ __forceinline__ void operator()(const f32x4 (&acc)[2][2][4][2], const Unit& u, int wr, int wc, int fr, int fq) const {
        const int s = u.pn >> 2; bf16_t* base = slab + (size_t)s * (SLAB / 2); const int colt = (u.pn & 3) * 256;
        const int row0 = u.pm * BM + wr * 64 + fr;
        if (s < 2) {
            const float sc = (s == 0) ? C2 : 1.0f; const int i0 = 16 * (wc & 1) + 4 * fq;
            f32x4 csv[2][4], snv[2][4];
#pragma unroll
            for (int ai = 0; ai < 2; ++ai)
#pragma unroll
                for (int m = 0; m < 4; ++m) { const int pos = (row0 + ai * HALF + m * 16) & (SEQ - 1);
                    csv[ai][m] = *(const GAS f32x4*)(rope + pos * 32 + i0); snv[ai][m] = *(const GAS f32x4*)(rope + SEQ * 32 + pos * 32 + i0); }
#pragma unroll
            for (int ai = 0; ai < 2; ++ai)
#pragma unroll
                for (int m = 0; m < 4; ++m) { const int row = row0 + ai * HALF + m * 16;
                    const f32x4 cs = csv[ai][m] * sc, sn = snv[ai][m] * sc;
#pragma unroll
                    for (int bj = 0; bj < 2; ++bj) { const f32x4 v0 = acc[ai][bj][m][0], v1 = acc[ai][bj][m][1];
                        const f32x4 lo = v0 * cs - v1 * sn, hi = v1 * cs + v0 * sn;
                        bf16_t* p = base + (size_t)row * DM + colt + 64 * (2 * bj + (wc >> 1)) + i0;
                        u32x2 w0, w1; w0.x = cvt_pk_bf16(lo[0], lo[1]); w0.y = cvt_pk_bf16(lo[2], lo[3]); w1.x = cvt_pk_bf16(hi[0], hi[1]); w1.y = cvt_pk_bf16(hi[2], hi[3]);
                        *(GAS u32x2*)p = w0; *(GAS u32x2*)(p + 32) = w1; } }
        } else {
            const int col0 = colt + wc * 32 + 8 * fq;
#pragma unroll
            for (int ai = 0; ai < 2; ++ai)
#pragma unroll
                for (int m = 0; m < 4; ++m) { bf16_t* rowp = base + (size_t)(row0 + ai * HALF + m * 16) * DM + col0;
#pragma unroll
                    for (int bj = 0; bj < 2; ++bj) { const f32x4 v0 = acc[ai][bj][m][0], v1 = acc[ai][bj][m][1];
                        u32x4 w; w.x = cvt_pk_bf16(v0[0], v0[1]); w.y = cvt_pk_bf16(v0[2], v0[3]); w.z = cvt_pk_bf16(v1[0], v1[1]); w.w = cvt_pk_bf16(v1[2], v1[3]);
                        *(GAS u32x4*)(rowp + bj * HALF) = w; } }
        }
    }
};
struct EpiOutRes {
    static constexpr bool PERM = false, AFTER_DRAIN = false;
    const float* x; float* x1;
    __device__ __forceinline__ void operator()(const f32x4 (&acc)[2][2][4][2], const Unit& u, int wr, int wc, int fr, int fq) const {
        const int col0 = u.pn * BM + wc * 32 + 4 * fq;
#pragma unroll
        for (int ai = 0; ai < 2; ++ai) { f32x4 bs[4][2][2];
#pragma unroll
            for (int m = 0; m < 4; ++m) { const size_t off = (size_t)(u.pm * BM + ai * HALF + wr * 64 + m * 16 + fr) * DM + col0;
#pragma unroll
                for (int bj = 0; bj < 2; ++bj)
#pragma unroll
                    for (int n = 0; n < 2; ++n) bs[m][bj][n] = *(const GAS f32x4*)(x + off + bj * HALF + n * 16); }
#pragma unroll
            for (int m = 0; m < 4; ++m) { const size_t off = (size_t)(u.pm * BM + ai * HALF + wr * 64 + m * 16 + fr) * DM + col0;
#pragma unroll
                for (int bj = 0; bj < 2; ++bj)
#pragma unroll
                    for (int n = 0; n < 2; ++n) *(GAS f32x4*)(x1 + off + bj * HALF + n * 16) = bs[m][bj][n] + acc[ai][bj][m][n]; } }
    }
};
struct EpiAct {
    static constexpr bool PERM = true, AFTER_DRAIN = false;
    bf16_t* act; const float* bgate; const float* bup; const int* tile_e;
    __device__ __forceinline__ void operator()(const f32x4 (&acc)[2][2][4][2], const Unit& u, int wr, int wc, int fr, int fq) const {
        const int e = u.e;
        const int col0 = u.pn * HALF + wc * 32 + 8 * fq; const int row0 = u.pm * BM + u.rofs + wr * 64 + fr;
        const f32x4 bg0 = *(const GAS f32x4*)(bgate + e * 1024 + col0), bg1 = *(const GAS f32x4*)(bgate + e * 1024 + col0 + 4), bu0 = *(const GAS f32x4*)(bup + e * 1024 + col0), bu1 = *(const GAS f32x4*)(bup + e * 1024 + col0 + 4);
#pragma unroll
        for (int ai = 0; ai < 2; ++ai) { if (ai == 1 && u.half) break;
#pragma unroll
            for (int m = 0; m < 4; ++m) { f32x4 o[2];
#pragma unroll
                for (int n = 0; n < 2; ++n) { const f32x4 g = acc[ai][0][m][n] + (n ? bg1 : bg0), up = acc[ai][1][m][n] + (n ? bu1 : bu0);
                    f32x4 gate, uu, ex;
#pragma unroll
                    for (int q = 0; q < 4; ++q) { gate[q] = fminf(g[q], 7.0f); uu[q] = fminf(fmaxf(up[q], -7.0f), 7.0f); }
                    const f32x4 tt = gate * (-1.702f * 1.4426950408889634f);
#pragma unroll
                    for (int q = 0; q < 4; ++q) ex[q] = __builtin_amdgcn_exp2f(tt[q]);
                    const f32x4 den = ex + 1.0f; f32x4 rc;
#pragma unroll
                    for (int q = 0; q < 4; ++q) rc[q] = __builtin_amdgcn_rcpf(den[q]);
                    o[n] = (uu + 1.0f) * gate * rc; }
                u32x4 w; w.x = cvt_pk_bf16(o[0][0], o[0][1]); w.y = cvt_pk_bf16(o[0][2], o[0][3]); w.z = cvt_pk_bf16(o[1][0], o[1][1]); w.w = cvt_pk_bf16(o[1][2], o[1][3]);
                *(GAS u32x4*)(act + (size_t)(row0 + ai * HALF + m * 16) * DM + col0) = w; } }
    }
};
struct EpiDown {
    static constexpr bool PERM = true, AFTER_DRAIN = false;
    bf16_t* y; const float* bdown; const float* wslot; const int* tile_e;
    __device__ __forceinline__ void operator()(const f32x4 (&acc)[2][2][4][2], const Unit& u, int wr, int wc, int fr, int fq) const {
        const int e = u.e;
        const int col0 = u.pn * BM + wc * 32 + 8 * fq; const int row0 = u.pm * BM + u.rofs + wr * 64 + fr;
        f32x4 bv[2][2]; float wsv[2][4];
#pragma unroll
        for (int bj = 0; bj < 2; ++bj)
#pragma unroll
            for (int n = 0; n < 2; ++n) bv[bj][n] = *(const GAS f32x4*)(bdown + e * 1024 + col0 + bj * HALF + 4 * n);
#pragma unroll
        for (int ai = 0; ai < 2; ++ai)
#pragma unroll
            for (int m = 0; m < 4; ++m) wsv[ai][m] = *(const GAS float*)(wslot + row0 + (u.half ? 0 : ai * HALF) + m * 16);
#pragma unroll
        for (int ai = 0; ai < 2; ++ai) { if (ai == 1 && u.half) break;
#pragma unroll
            for (int m = 0; m < 4; ++m) { const int row = row0 + ai * HALF + m * 16; const float ws = wsv[ai][m];
#pragma unroll
                for (int bj = 0; bj < 2; ++bj) { const f32x4 v0 = (acc[ai][bj][m][0] + bv[bj][0]) * ws, v1 = (acc[ai][bj][m][1] + bv[bj][1]) * ws;
                    u32x4 w; w.x = cvt_pk_bf16(v0[0], v0[1]); w.y = cvt_pk_bf16(v0[2], v0[3]); w.z = cvt_pk_bf16(v1[0], v1[1]); w.w = cvt_pk_bf16(v1[2], v1[3]);
                    *(GAS u32x4*)(y + (size_t)row * DM + col0 + bj * HALF) = w; } } }
    }
};
template <bool LDS_TBL> struct MoeOrderT {
    StaticOrder so; const int* tile_e; long estride; int nfull, rem;
    __device__ void init(int nMt, int N, int G_, int c_, const int* te, long es) { so.nM = nMt; so.nN = N / BM; so.nwg = so.nM * so.nN; so.G = G_; so.c = c_; tile_e = te; estride = es;
        nfull = (so.nwg / G_) * G_; rem = so.nwg - nfull; }
    __device__ bool next(int i, Unit& u) const { const long L = (long)i * so.G + so.c; int idx, half = 0, rofs = 0;
        if (L < nfull) idx = (int)L;
        else { const int j = (int)(L - nfull); if (2 * rem <= so.G) { if (j >= 2 * rem) return false; idx = nfull + (j >> 1); half = 1; rofs = (j & 1) * HALF; } else { if (j >= rem) return false; idx = nfull + j; } }
        so.map(idx, u); int e; if constexpr (LDS_TBL) e = *(const PG8_LAS int*)(uintptr_t)((unsigned)(uintptr_t)tile_e + 4u * (unsigned)u.pm); else e = __hip_atomic_load(tile_e + u.pm, __ATOMIC_RELAXED, __HIP_MEMORY_SCOPE_AGENT);
        u.boff = (long)e * estride; u.e = e; u.half = half; u.rofs = rofs; return true; }
    __device__ __forceinline__ void a_ready(const Unit&) const {}
    __device__ __forceinline__ void done(const Unit&) const {}
};
typedef MoeOrderT<false> MoeOrder;
template <class Epi, class Sched, bool ALIGN_EPI = false, bool SP2 = false, bool GATHER = false>
__device__ __forceinline__ void gemm_phase(PG8_LAS unsigned char* lds, const Gemm g, const Sched& S, const Epi& E) {
    const int wid = wave_now((const void*)(uintptr_t)(unsigned)(uintptr_t)lds), lane = lane_now(), tid = wid * 64 + lane, wr = wid >> 2, wc = wid & 3, fr = lane & 15, fq = lane >> 4;
    const int K = g.K, nt = K / BK;
    unsigned voffA[2], voffB[2];
#pragma unroll
    for (int i = 0; i < 2; ++i) { int R, C; stage_rc(tid * 16 + i * 8192, R, C); const int Rb = Epi::PERM ? ((R & ~31) + perm32(R & 31)) : R;
        voffA[i] = (unsigned)(R * K + C) * 2u; voffB[i] = (unsigned)(Rb * K + C) * 2u; }
    const size_t kstep = (size_t)(BK * 2);
    const size_t hstep = (size_t)HALF * K * 2;
    const size_t tstep = 2 * hstep;
    const unsigned ldsw = (unsigned)wid * 1024u;
    const int aoff = lds_byte(wr * 64 + fr, fq * 8), boff = lds_byte(wc * 32 + fr, fq * 8);
#define PG8_SA(b, h) (((b) * 2 + (h)) * HTB)
#define PG8_SB(b, h) ((4 + (b) * 2 + (h)) * HTB)
#define PG8_STAGE(bufoff, gbase, voff) do { _Pragma("unroll") for (int _i = 0; _i < 2; ++_i) \
        __builtin_amdgcn_global_load_lds((const unsigned*)((const char*)(gbase) + (voff)[_i]), (PG8_LAS unsigned*)(lds + (bufoff) + ldsw + _i * 8192), 16, 0, 0); } while (0)
#define PG8_STA(bufoff, P, h, G) do { if constexpr (GATHER) { PG8_STAGE(bufoff, P, (G)[h]); } else { PG8_STAGE(bufoff, (P) + (h) * hstep, voffA); } } while (0)
#define PG8_LDA(dst, b, h) do { _Pragma("unroll") for (int m = 0; m < 4; ++m) _Pragma("unroll") for (int k = 0; k < 2; ++k) dst[m][k] = *(const PG8_LAS bf16x8*)(lds + PG8_SA(b, h) + aoff + m * 2048 + k * 1024); } while (0)
#define PG8_LDB(dst, b, h) do { _Pragma("unroll") for (int n = 0; n < 2; ++n) _Pragma("unroll") for (int k = 0; k < 2; ++k) dst[n][k] = *(const PG8_LAS bf16x8*)(lds + PG8_SB(b, h) + boff + n * 2048 + k * 1024); } while (0)
#define PG8_MMA(ai, bj, At, Bt) do { __builtin_amdgcn_s_setprio(1); _Pragma("unroll") for (int m = 0; m < 4; ++m) _Pragma("unroll") for (int n = 0; n < 2; ++n) _Pragma("unroll") for (int k = 0; k < 2; ++k) \
        acc[ai][bj][m][n] = __builtin_amdgcn_mfma_f32_16x16x32_bf16(Bt[n][k], At[m][k], acc[ai][bj][m][n], 0, 0, 0); __builtin_amdgcn_s_setprio(0); } while (0)
#define PG8_WAIT_V(n) asm volatile("s_waitcnt vmcnt(" #n ")" ::: "memory")
#define PG8_WAIT_L(n) asm volatile("s_waitcnt lgkmcnt(" #n ")" ::: "memory")
#define PG8_BAR __builtin_amdgcn_s_barrier()
#define PG8_SCHED __builtin_amdgcn_sched_barrier(0)
    Unit cur, nxt; int ui = 0;
    if (!S.next(0, cur)) return;
    f32x4 acc[2][2][4][2];
#pragma unroll
    for (int a = 0; a < 2; ++a)
#pragma unroll
        for (int b = 0; b < 2; ++b)
#pragma unroll
            for (int m = 0; m < 4; ++m)
#pragma unroll
                for (int n = 0; n < 2; ++n) acc[a][b][m][n] = (f32x4){0.f, 0.f, 0.f, 0.f};
    bf16x8 At[4][2], B0[2][2], B1[2][2];
    const char* cA = (const char*)g.A + (GATHER ? (size_t)0 : (size_t)cur.pm * tstep + (size_t)cur.rofs * K * 2); const char* cB = (const char*)g.Bt + cur.boff + (size_t)cur.pn * tstep;
    S.a_ready(cur);
    unsigned gC[2][2], gX[2][2];
#define PG8_ROWIDS(G, U_) do { const int se_ = *(const PG8_LAS int*)(uintptr_t)(g.ldsStart + 4u * (unsigned)(U_).e), ce_ = *(const PG8_LAS int*)(uintptr_t)(g.ldsCnt + 4u * (unsigned)(U_).e);   \
        const int* lb_ = g.list + (U_).e * 16384;                                                                                                       \
        _Pragma("unroll") for (int h_ = 0; h_ < 2; ++h_) _Pragma("unroll") for (int i_ = 0; i_ < 2; ++i_) {                                              \
            int pos_ = (U_).pm * 256 + (U_).rofs + ((U_).half ? 0 : h_ * 128) + (int)(voffA[i_] / (unsigned)(2 * K)) - se_; if (pos_ >= ce_) pos_ = 0;     \
            const int* rp_ = lb_ + pos_; unsigned v_; asm volatile("global_load_dword %0, %1, off" : "=v"(v_) : "v"(rp_) : "memory"); G[h_][i_] = v_; } } while (0)
#define PG8_ROWFIX(G) do { _Pragma("unroll") for (int h_ = 0; h_ < 2; ++h_) _Pragma("unroll") for (int i_ = 0; i_ < 2; ++i_) G[h_][i_] = (G[h_][i_] >> 2) * (unsigned)(2 * K) + voffA[i_] % (unsigned)(2 * K); } while (0)
    if constexpr (GATHER) { PG8_ROWIDS(gC, cur); asm volatile("s_waitcnt vmcnt(0)" ::: "memory"); PG8_ROWFIX(gC);
#pragma unroll
        for (int h_ = 0; h_ < 2; ++h_) { gX[h_][0] = gC[h_][0]; gX[h_][1] = gC[h_][1]; } }
    if constexpr (SP2) {
        PG8_STAGE(PG8_SB(0, 0), cB, voffB); PG8_STAGE(PG8_SB(0, 1), cB + hstep, voffB); PG8_STA(PG8_SA(0, 0), cA, 0, gC); PG8_STA(PG8_SA(0, 1), cA, 1, gC);
        if (wr == 1) PG8_BAR;
        PG8_WAIT_V(2); PG8_BAR;
        PG8_STAGE(PG8_SB(1, 0), cB + kstep, voffB); PG8_STA(PG8_SA(1, 0), cA + kstep, 0, gC); PG8_STAGE(PG8_SB(1, 1), cB + hstep + kstep, voffB);
        PG8_WAIT_V(6); PG8_BAR;
    } else {
        PG8_STAGE(PG8_SB(0, 0), cB, voffB); PG8_STA(PG8_SA(0, 0), cA, 0, gC); PG8_STAGE(PG8_SB(0, 1), cB + hstep, voffB); PG8_STA(PG8_SA(0, 1), cA, 1, gC);
        if (wr == 1) PG8_BAR;
        PG8_WAIT_V(4); PG8_BAR;
        PG8_STAGE(PG8_SB(1, 0), cB + kstep, voffB); PG8_STA(PG8_SA(1, 0), cA + kstep, 0, gC); PG8_STAGE(PG8_SB(1, 1), cB + hstep + kstep, voffB);
        PG8_WAIT_V(6); PG8_BAR;
    }
    for (;;) {
        const bool has_next = S.next(ui + 1, nxt);
        const char* nA = (has_next && !GATHER) ? (const char*)g.A + (size_t)nxt.pm * tstep + (size_t)nxt.rofs * K * 2 : cA; const char* nB = has_next ? (const char*)g.Bt + nxt.boff + (size_t)nxt.pn * tstep : cB;
        if constexpr (GATHER) { if (has_next) PG8_ROWIDS(gX, nxt); }
        for (int t = 0; t < nt; t += 2) {
            const bool last = (t == nt - 2);
            const char* a1 = cA + (size_t)(t + 1) * kstep;
            const char* a2 = last ? nA : cA + (size_t)(t + 2) * kstep; const char* b2 = last ? nB : cB + (size_t)(t + 2) * kstep;
            const char* a3 = a2 + kstep; const char* b3 = b2 + kstep;
            if (last && has_next) S.a_ready(nxt);
            unsigned g2[2][2];
            if constexpr (GATHER) { if (last && has_next) PG8_ROWFIX(gX);
#pragma unroll
                for (int h_ = 0; h_ < 2; ++h_) { g2[h_][0] = last ? gX[h_][0] : gC[h_][0]; g2[h_][1] = last ? gX[h_][1] : gC[h_][1]; } }
            if constexpr (SP2) {
            const bool hc = cur.half != 0, h2 = last ? (has_next ? nxt.half != 0 : hc) : hc;
            PG8_LDB(B0, 0, 0); PG8_LDB(B1, 0, 1); PG8_SCHED; PG8_LDA(At, 0, 0); if (!hc) PG8_STA(PG8_SA(1, 1), a1, 1, gC);
            PG8_WAIT_V(8); PG8_WAIT_L(0); PG8_BAR; PG8_MMA(0, 0, At, B0); PG8_MMA(0, 1, At, B1); PG8_BAR; PG8_SCHED;
            if (!hc) PG8_LDA(At, 0, 1); PG8_STAGE(PG8_SB(0, 0), b2, voffB); PG8_STAGE(PG8_SB(0, 1), b2 + hstep, voffB); PG8_STA(PG8_SA(0, 0), a2, 0, g2);
            if (hc) PG8_WAIT_V(6); else PG8_WAIT_V(8);
            PG8_WAIT_L(0); PG8_BAR; if (!hc) { PG8_MMA(1, 0, At, B0); PG8_MMA(1, 1, At, B1); } PG8_BAR; PG8_SCHED;
            PG8_LDB(B0, 1, 0); PG8_LDB(B1, 1, 1); PG8_SCHED; PG8_LDA(At, 1, 0); if (!h2) PG8_STA(PG8_SA(0, 1), a2, 1, g2);
            if (h2) PG8_WAIT_V(6); else PG8_WAIT_V(8);
            PG8_WAIT_L(0); PG8_BAR; PG8_MMA(0, 0, At, B0); PG8_MMA(0, 1, At, B1); PG8_BAR; PG8_SCHED;
            if (!hc) PG8_LDA(At, 1, 1); PG8_STAGE(PG8_SB(1, 0), b3, voffB); PG8_STAGE(PG8_SB(1, 1), b3 + hstep, voffB); PG8_STA(PG8_SA(1, 0), a3, 0, g2);
            if (h2) PG8_WAIT_V(6); else PG8_WAIT_V(8);
            PG8_WAIT_L(0); PG8_BAR; if (!hc) { PG8_MMA(1, 0, At, B0); PG8_MMA(1, 1, At, B1); } PG8_BAR; PG8_SCHED;
            } else {
            PG8_LDB(B0, 0, 0); PG8_SCHED; PG8_LDA(At, 0, 0); PG8_STA(PG8_SA(1, 1), a1, 1, gC);
            PG8_WAIT_L(8); PG8_BAR; PG8_WAIT_L(0); PG8_MMA(0, 0, At, B0); PG8_BAR; PG8_SCHED;
            PG8_LDB(B1, 0, 1); PG8_STAGE(PG8_SB(0, 0), b2, voffB);
            PG8_BAR; PG8_WAIT_L(0); PG8_MMA(0, 1, At, B1); PG8_BAR;
            PG8_LDA(At, 0, 1); PG8_STA(PG8_SA(0, 0), a2, 0, g2);
            PG8_BAR; PG8_WAIT_L(0); PG8_MMA(1, 0, At, B0); PG8_BAR; PG8_SCHED;
            PG8_STAGE(PG8_SB(0, 1), b2 + hstep, voffB);
            PG8_WAIT_V(6); PG8_BAR; PG8_MMA(1, 1, At, B1); PG8_BAR;
            PG8_LDB(B0, 1, 0); PG8_SCHED; PG8_LDA(At, 1, 0); PG8_STA(PG8_SA(0, 1), a2, 1, g2);
            PG8_WAIT_L(8); PG8_BAR; PG8_WAIT_L(0); PG8_MMA(0, 0, At, B0); PG8_BAR; PG8_SCHED;
            PG8_LDB(B1, 1, 1); PG8_STAGE(PG8_SB(1, 0), b3, voffB);
            PG8_BAR; PG8_WAIT_L(0); PG8_MMA(0, 1, At, B1); PG8_BAR;
            PG8_LDA(At, 1, 1); PG8_STA(PG8_SA(1, 0), a3, 0, g2);
            PG8_BAR; PG8_WAIT_L(0); PG8_MMA(1, 0, At, B0); PG8_BAR; PG8_SCHED;
            PG8_STAGE(PG8_SB(1, 1), b3 + hstep, voffB);
            PG8_WAIT_V(6); PG8_BAR; PG8_MMA(1, 1, At, B1); PG8_BAR;
            }
        }
        if constexpr (ALIGN_EPI) { if (wr == 0) PG8_BAR; }
        if constexpr (!Epi::AFTER_DRAIN) { E(acc, cur, wr, wc, fr, fq); S.done(cur); }
        if (!has_next) break;
#pragma unroll
        for (int a = 0; a < 2; ++a)
#pragma unroll
            for (int b = 0; b < 2; ++b)
#pragma unroll
                for (int m = 0; m < 4; ++m)
#pragma unroll
                    for (int n = 0; n < 2; ++n) acc[a][b][m][n] = (f32x4){0.f, 0.f, 0.f, 0.f};
        cur = nxt; cA = nA; cB = nB; ++ui;
        if constexpr (GATHER) {
#pragma unroll
            for (int h_ = 0; h_ < 2; ++h_) { gC[h_][0] = gX[h_][0]; gC[h_][1] = gX[h_][1]; } }
        if constexpr (ALIGN_EPI) { if (wr == 1) PG8_BAR; }
    }
    PG8_WAIT_V(0);
    if constexpr (!ALIGN_EPI) { if (wr == 0) PG8_BAR; }
    PG8_BAR;
    if constexpr (Epi::AFTER_DRAIN) { E.fused(acc, cur, wr, wc, fr, fq, lds, wid, lane); S.done(cur); }
#undef PG8_SA
#undef PG8_STA
#undef PG8_ROWIDS
#undef PG8_ROWFIX
#undef PG8_SB
#undef PG8_STAGE
#undef PG8_LDA
#undef PG8_LDB
#undef PG8_MMA
#undef PG8_WAIT_V
#undef PG8_WAIT_L
#undef PG8_BAR
#undef PG8_SCHED
}
}

#include <hip/hip_bf16.h>
#include <cmath>
namespace attn_body {
using bf16=__hip_bfloat16;
using bf16x8=__attribute__((ext_vector_type(8)))short;
using s16x4=__attribute__((ext_vector_type(4)))short;
using f32x16=__attribute__((ext_vector_type(16)))float;
using u32x4=__attribute__((ext_vector_type(4)))unsigned;
constexpr int BATCH=2,NHEAD=16,SEQ=8192,D=64,DM=NHEAD*D;
constexpr int NW=8,QBLK=32,QB=QBLK*NW,KVBLK=64,NQB=SEQ/QB;
constexpr int ATTN_PITCH=DM, ATTN_UNIT_ROWS=QB;
__device__ __forceinline__ int crow(int r,int hi){return (r&3)+8*(r>>2)+4*hi;}
#define SBAR() __builtin_amdgcn_sched_barrier(0)
__device__ __forceinline__ void cmask(f32x16&p0,f32x16&p1,int jb,int qrel,int hi){
  const float NEG=-INFINITY; int kb=64*jb+4*hi;
  #pragma unroll
  for(int r=0;r<16;++r){int kv=kb+(r&3)+8*(r>>2); if(kv>qrel)p0[r]=NEG; if(kv+32>qrel)p1[r]=NEG;}
}

constexpr int NSLOT=3, SLOTB=8192;
constexpr int LDS_K=0, LDS_V=NSLOT*SLOTB, LDS_WS=2*NSLOT*SLOTB, LDS_OST=LDS_WS+NW*64*4, LDS_BYTES=LDS_OST+NW*4096;
constexpr float C2=0.125f*1.4426950408889634f;
__device__ __forceinline__ void glds16(const void*gsrc,unsigned lds_dst){unsigned keep;
  asm volatile("s_mov_b32 %0, m0\n\ts_mov_b32 m0, %2\n\ts_nop 0\n\tglobal_load_lds_dwordx4 %1, off\n\ts_mov_b32 m0, %0":"=&s"(keep):"v"(gsrc),"s"(lds_dst):"memory");}
__device__ __forceinline__ float max3f(float a,float b,float c){float r;asm("v_max3_f32 %0, %1, %2, %3":"=v"(r):"v"(a),"v"(b),"v"(c));return r;}
__device__ __forceinline__ float max2f(float a,float b){float r;asm("v_max_f32_e32 %0, %1, %2":"=v"(r):"v"(a),"v"(b));return r;}
__device__ __forceinline__ float fadd_s(float a,float b){float r;asm("v_add_f32_e32 %0, %1, %2":"=v"(r):"v"(a),"v"(b));return r;}
__device__ __forceinline__ float fsub_s(float a,float b){float r;asm("v_sub_f32_e32 %0, %1, %2":"=v"(r):"v"(a),"v"(b));return r;}
typedef float f32x2_t __attribute__((ext_vector_type(2))); typedef __bf16 bf16x2_t __attribute__((ext_vector_type(2)));
__device__ __forceinline__ unsigned cvtpk_s(float lo,float hi){f32x2_t v={lo,hi};bf16x2_t b=__builtin_convertvector(v,bf16x2_t);return __builtin_bit_cast(unsigned,b);}
#define WAIT_BAR(N) asm volatile("s_waitcnt vmcnt(" #N ") lgkmcnt(0)\n\ts_barrier":::"memory")

__device__ __forceinline__ void qkt(f32x16&p0,f32x16&p1,const char*Kslot,const bf16x8*qr,const f32x16&negm,int r32,int hi){
  const char*kb=Kslot+hi*1024+r32*16;
  #pragma unroll
  for(int d0=0;d0<4;++d0){
    const bf16x8 b0=*reinterpret_cast<const bf16x8*>(kb+d0*2048);
    const bf16x8 b1=*reinterpret_cast<const bf16x8*>(kb+d0*2048+512);
    if(d0==0){p0=__builtin_amdgcn_mfma_f32_32x32x16_bf16(b0,qr[0],negm,0,0,0);p1=__builtin_amdgcn_mfma_f32_32x32x16_bf16(b1,qr[0],negm,0,0,0);}
    else{p0=__builtin_amdgcn_mfma_f32_32x32x16_bf16(b0,qr[d0],p0,0,0,0);p1=__builtin_amdgcn_mfma_f32_32x32x16_bf16(b1,qr[d0],p1,0,0,0);}}
}
typedef __attribute__((address_space(3))) const char* lds_cptr;
typedef short v4i16_t __attribute__((ext_vector_type(4)));
__device__ __forceinline__ void kload8(bf16x8*kf,lds_cptr kp){
  kf[0]=*(const __attribute__((address_space(3))) bf16x8*)(kp);      kf[1]=*(const __attribute__((address_space(3))) bf16x8*)(kp+512);
  kf[2]=*(const __attribute__((address_space(3))) bf16x8*)(kp+2048); kf[3]=*(const __attribute__((address_space(3))) bf16x8*)(kp+2560);
  kf[4]=*(const __attribute__((address_space(3))) bf16x8*)(kp+4096); kf[5]=*(const __attribute__((address_space(3))) bf16x8*)(kp+4608);
  kf[6]=*(const __attribute__((address_space(3))) bf16x8*)(kp+6144); kf[7]=*(const __attribute__((address_space(3))) bf16x8*)(kp+6656);
}
__device__ __forceinline__ void kload2(bf16x8*kf,lds_cptr kp,int j){ kf[2*j]=*(const __attribute__((address_space(3))) bf16x8*)(kp+j*2048); kf[2*j+1]=*(const __attribute__((address_space(3))) bf16x8*)(kp+j*2048+512); }
__device__ __forceinline__ s16x4 vtr(lds_cptr p){ return __builtin_bit_cast(s16x4,__builtin_amdgcn_ds_read_tr16_b64_v4i16((__attribute__((address_space(3))) v4i16_t*)p)); }
__device__ __forceinline__ float rowmax(const f32x16&p0,const f32x16&p1){
  float a=max3f(p0[0],p0[1],p1[0]),b=max3f(p0[2],p0[3],p1[1]);a=max3f(a,p1[2],p1[3]);
  #pragma unroll
  for(int r=4;r<16;r+=4){a=max3f(a,p0[r],p0[r+1]);b=max3f(b,p0[r+2],p0[r+3]);a=max3f(a,p1[r],p1[r+1]);b=max3f(b,p1[r+2],p1[r+3]);}
  const float m=max2f(a,b);
  auto rr=__builtin_amdgcn_permlane32_swap(__float_as_uint(m),__float_as_uint(m),false,false);
  return max2f(__uint_as_float(rr[0]),__uint_as_float(rr[1]));
}
__device__ __forceinline__ void pv(f32x16*o,int vb,bf16x8 pa0,bf16x8 pa1,bf16x8 pa2,bf16x8 pa3){
  #pragma unroll
  for(int d0=0;d0<2;++d0){s16x4 lo[4],hi[4];
    #pragma unroll
    for(int ks=0;ks<4;++ks){
      asm volatile("ds_read_b64_tr_b16 %0,%1 offset:%c2":"=&v"(lo[ks]):"v"(vb),"i"(d0*4096+ks*1024):"memory");
      asm volatile("ds_read_b64_tr_b16 %0,%1 offset:%c2":"=&v"(hi[ks]):"v"(vb),"i"(d0*4096+ks*1024+512):"memory");}
    asm volatile("s_waitcnt lgkmcnt(0)":::"memory");SBAR();
    #define PK(k) (bf16x8){lo[k][0],lo[k][1],lo[k][2],lo[k][3],hi[k][0],hi[k][1],hi[k][2],hi[k][3]}
    o[d0]=__builtin_amdgcn_mfma_f32_32x32x16_bf16(pa0,PK(0),o[d0],0,0,0);
    o[d0]=__builtin_amdgcn_mfma_f32_32x32x16_bf16(pa1,PK(1),o[d0],0,0,0);
    o[d0]=__builtin_amdgcn_mfma_f32_32x32x16_bf16(pa2,PK(2),o[d0],0,0,0);
    o[d0]=__builtin_amdgcn_mfma_f32_32x32x16_bf16(pa3,PK(3),o[d0],0,0,0);
    #undef PK
  }
}

#ifndef ATTN_STORE16
#define ATTN_STORE16(p,v) (*(u32x4*)(p)=(v))
#endif
template<int THRL> __device__ __forceinline__ void attn_unit(int b,int h,int qb,int hv,const bf16*Q,const bf16*__restrict__ K,const bf16*__restrict__ V,bf16*O,char*shm){
  const int lane=lane_now(),r32=lane&31,hi=lane>>5; const int wid=wave_now(shm);
  const long rowbase=(long)b*SEQ; const int q0=qb*QB;
  const bf16*Qw=Q+(rowbase+q0+wid*QBLK)*DM+h*D;
  const bf16*Kh=K+rowbase*DM+h*D,*Vh=V+rowbase*DM+hv*D;
  const unsigned lds0=(unsigned)(uintptr_t)shm;
  float*wsf=(float*)(shm+LDS_WS)+wid*64;
  const bf16*ksrc=Kh+(long)lane*DM+wid*8;
  const bf16*vsrc=Vh+(long)(16*(wid&3)+(lane>>2))*DM+(wid>>2)*32+(lane&3)*8;
  const unsigned kdst=lds0+LDS_K+wid*1024, vdst=lds0+LDS_V+wid*1024;
  #define DMA_K(t,slot) glds16(ksrc+(long)(t)*KVBLK*DM,(unsigned)__builtin_amdgcn_readfirstlane(kdst+(slot)))
  #define DMA_V(t,slot) glds16(vsrc+(long)(t)*KVBLK*DM,(unsigned)__builtin_amdgcn_readfirstlane(vdst+(slot)))
  const int vb0=(int)(lds0+LDS_V)+((lane>>4)&1)*32+(lane&3)*8+(4*hi+((lane&15)>>2))*64;
  const char*Kbase=shm+LDS_K; bf16x8 kf[8];
  const lds_cptr shm3=(lds_cptr)shm; const lds_cptr kp0=shm3+LDS_K+hi*1024+r32*16; const lds_cptr vp0=shm3+LDS_V+((lane>>4)&1)*32+(lane&3)*8+(4*hi+((lane&15)>>2))*64;
  const int NT=(q0+QB)/KVBLK;
  DMA_K(0,0);DMA_V(0,0);DMA_K(1,SLOTB);
  bf16x8 qr[4];
  #pragma unroll
  for(int d0=0;d0<4;++d0)qr[d0]=*reinterpret_cast<const bf16x8*>(&Qw[(long)r32*DM+d0*16+hi*8]);
  float mhat=0.f,l_reg=0.f;f32x16 o[2];f32x16 negm; { float zz; asm volatile("v_mov_b32 %0, 0":"=v"(zz)); _Pragma("unroll") for(int r=0;r<16;++r){o[0][r]=zz;o[1][r]=zz;negm[r]=zz;} } asm volatile("":"+v"(negm));
  const int qrel=wid*QBLK+r32;
  #define CMASK(P0,P1,t) do{int jb_=(t)-(NT-4); if(jb_>=0)cmask(P0,P1,jb_,qrel,hi);}while(0)
  bool resc=false;
  #define START(P0,P1) do{ const float rm=rowmax(P0,P1); resc=false; \
    { const float dl=rm; mhat=fadd_s(mhat,dl); \
      _Pragma("unroll") for(int r=0;r<16;++r){P0[r]=fsub_s(P0[r],dl);P1[r]=fsub_s(P1[r],dl);} \
      _Pragma("unroll") for(int r=0;r<16;++r)negm[r]=-mhat; asm volatile("":"+v"(negm)); } \
    _Pragma("unroll") for(int r=0;r<16;++r)P0[r]=__builtin_amdgcn_exp2f(P0[r]); }while(0)
  #define RESC() do{ if(resc){ asm volatile("s_waitcnt lgkmcnt(0)":::"memory"); \
      _Pragma("unroll") for(int d_=0;d_<2;++d_) _Pragma("unroll") for(int r=0;r<16;++r)o[d_][r]*=wsf[crow(r,hi)]; } }while(0)
  f32x16 pA0,pA1,pB0,pB1;
  int sl_prev=0,sl_cur=0,sl_next=SLOTB;
  #define ROT() do{sl_prev=sl_cur;sl_cur=sl_next;sl_next=(sl_next==(NSLOT-1)*SLOTB)?0:sl_next+SLOTB;}while(0)
  DMA_K(2,2*SLOTB);
  WAIT_BAR(3);
  qkt(pA0,pA1,Kbase,qr,negm,r32,hi);asm volatile("s_nop 15\n\ts_nop 7":"+v"(pA0),"+v"(pA1));CMASK(pA0,pA1,0);
  START(pA0,pA1);
  _Pragma("unroll") for(int r=0;r<16;++r)pA1[r]=__builtin_amdgcn_exp2f(pA1[r]);
  WAIT_BAR(0);
  DMA_K(3,0);DMA_V(1,SLOTB);
  ROT();
  kload8(kf,kp0+sl_cur);
  WAIT_BAR(2);
  s16x4 vlo[8],vhi[8]; u32x4 pw0,pw1,pw2,pw3;
  #define PKW(P,B) cvtpk_s(P[B],P[B+1])
  #define PAF(k) __builtin_bit_cast(bf16x8,pw##k)
  #define VFR(i) (bf16x8){vlo[i][0],vlo[i][1],vlo[i][2],vlo[i][3],vhi[i][0],vhi[i][1],vhi[i][2],vhi[i][3]}
  #define PIN(x) asm volatile("":"+v"(x))
  #define MX3(a,b,c) __builtin_fmaxf(__builtin_fmaxf((a),(b)),(c))
  #define GAPA(MF,A0,A1,A2,A3,W0,W1,PW) do{ MF; sacc+=A0; sacc+=A1; sacc+=A2; sacc+=A3; PIN(sacc); W0; W1; PIN(PW); SBAR(); }while(0)
  #define EX(v) __builtin_amdgcn_exp2f(v)
  #define GAPB(MF,X,B) do{ MF; X[B]=EX(X[B]); X[B+1]=EX(X[B+1]); X[B+2]=EX(X[B+2]); X[B+3]=EX(X[B+3]); PIN(X); SBAR(); }while(0)
  #define VRD(i) do{ vlo[i]=vtr(vp_+(((i)>>2)*4096+((i)&3)*1024)); vhi[i]=vtr(vp_+(((i)>>2)*4096+((i)&3)*1024+512)); }while(0)
  #define KRD(G,j) do{ if(G){ kload2(kf,kp0+sl_next,j); SBAR(); } }while(0)
  #define STEP(C0,C1,P0,P1,t,GK,GV,GL) do{ SBAR(); \
    const lds_cptr vp_=vp0+sl_prev; \
    VRD(0); SBAR(); float sacc=(P0[0]+P0[1]); \
    GAPA(C0=__builtin_amdgcn_mfma_f32_32x32x16_bf16(kf[0],qr[0],negm,0,0,0), P0[2],P0[3],P0[4],P0[5],     pw0[0]=PKW(P0,0), pw0[1]=PKW(P0,2), pw0); \
    VRD(4); SBAR(); GAPA(C1=__builtin_amdgcn_mfma_f32_32x32x16_bf16(kf[1],qr[0],negm,0,0,0), P0[6],P0[7],P0[8],P0[9],     pw0[2]=PKW(P0,4), pw0[3]=PKW(P0,6), pw0); \
    VRD(1); SBAR(); GAPA(C0=__builtin_amdgcn_mfma_f32_32x32x16_bf16(kf[2],qr[1],C0,0,0,0),   P0[10],P0[11],P0[12],P0[13], pw1[0]=PKW(P0,8), pw1[1]=PKW(P0,10), pw1); \
    VRD(5); SBAR(); GAPA(C1=__builtin_amdgcn_mfma_f32_32x32x16_bf16(kf[3],qr[1],C1,0,0,0),   P0[14],P0[15],P1[0],P1[1],   pw1[2]=PKW(P0,12),pw1[3]=PKW(P0,14), pw1); \
    VRD(2); SBAR(); GAPA(C0=__builtin_amdgcn_mfma_f32_32x32x16_bf16(kf[4],qr[2],C0,0,0,0),   P1[2],P1[3],P1[4],P1[5],     pw2[0]=PKW(P1,0), pw2[1]=PKW(P1,2), pw2); \
    VRD(6); SBAR(); GAPA(C1=__builtin_amdgcn_mfma_f32_32x32x16_bf16(kf[5],qr[2],C1,0,0,0),   P1[6],P1[7],P1[8],P1[9],     pw2[2]=PKW(P1,4), pw2[3]=PKW(P1,6), pw2); \
    VRD(3); SBAR(); GAPA(C0=__builtin_amdgcn_mfma_f32_32x32x16_bf16(kf[6],qr[3],C0,0,0,0),   P1[10],P1[11],P1[12],P1[13], pw3[0]=PKW(P1,8), pw3[1]=PKW(P1,10), pw3); \
    VRD(7); SBAR(); GAPA(C1=__builtin_amdgcn_mfma_f32_32x32x16_bf16(kf[7],qr[3],C1,0,0,0),   P1[14],P1[15],0.f,0.f,       pw3[2]=PKW(P1,12),pw3[3]=PKW(P1,14), pw3); \
    l_reg+=sacc; \
    if(GK){DMA_K((t)+3,sl_cur);} if(GV){DMA_V((t)+1,sl_next);} \
    CMASK(C0,C1,t); \
    { float a=MX3(C0[0],C0[1],C1[0]),b=MX3(C0[2],C0[3],C1[1]); a=MX3(a,C1[2],C1[3]); \
      _Pragma("unroll") for(int r=4;r<16;r+=4){a=MX3(a,C0[r],C0[r+1]);b=MX3(b,C0[r+2],C0[r+3]);a=MX3(a,C1[r],C1[r+1]);b=MX3(b,C1[r+2],C1[r+3]);} \
      float rm=__builtin_fmaxf(a,b); { auto rr=__builtin_amdgcn_permlane32_swap(__float_as_uint(rm),__float_as_uint(rm),false,false); rm=__builtin_fmaxf(__uint_as_float(rr[0]),__uint_as_float(rr[1])); } \
      resc=false; \
      if(__builtin_expect(__any(rm>(float)THRL),0)){ const float dl=__builtin_fmaxf(rm,0.f); mhat+=dl; \
        _Pragma("unroll") for(int r=0;r<16;++r){C0[r]-=dl;C1[r]-=dl;} \
        _Pragma("unroll") for(int r=0;r<16;++r)negm[r]=-mhat; asm volatile("":"+v"(negm)); \
        const float f=__builtin_amdgcn_exp2f(-dl); l_reg*=f; if(hi==0)wsf[r32]=f; resc=true; } } \
    SBAR(); \
    GAPB(o[0]=__builtin_amdgcn_mfma_f32_32x32x16_bf16(PAF(0),VFR(0),o[0],0,0,0), C0,0); \
    GAPB(o[1]=__builtin_amdgcn_mfma_f32_32x32x16_bf16(PAF(0),VFR(4),o[1],0,0,0), C0,4); \
    KRD(GL,0); GAPB(o[0]=__builtin_amdgcn_mfma_f32_32x32x16_bf16(PAF(1),VFR(1),o[0],0,0,0), C0,8); \
    KRD(GL,1); GAPB(o[1]=__builtin_amdgcn_mfma_f32_32x32x16_bf16(PAF(1),VFR(5),o[1],0,0,0), C0,12); \
    KRD(GL,2); GAPB(o[0]=__builtin_amdgcn_mfma_f32_32x32x16_bf16(PAF(2),VFR(2),o[0],0,0,0), C1,0); \
    KRD(GL,3); GAPB(o[1]=__builtin_amdgcn_mfma_f32_32x32x16_bf16(PAF(2),VFR(6),o[1],0,0,0), C1,4); \
    GAPB(o[0]=__builtin_amdgcn_mfma_f32_32x32x16_bf16(PAF(3),VFR(3),o[0],0,0,0), C1,8); \
    GAPB(o[1]=__builtin_amdgcn_mfma_f32_32x32x16_bf16(PAF(3),VFR(7),o[1],0,0,0), C1,12); \
    }while(0)
  int t=1;
  #undef CMASK
  #define CMASK(P0,P1,t) do{}while(0)
  for(;t+5<NT;t+=2){
    STEP(pB0,pB1,pA0,pA1,t,true,true,true);     WAIT_BAR(2); RESC(); ROT();
    STEP(pA0,pA1,pB0,pB1,t+1,true,true,true);   WAIT_BAR(2); RESC(); ROT();
  }
  #undef CMASK
  #define CMASK(P0,P1,t) do{int jb_=(t)-(NT-4); if(jb_>=0)cmask(P0,P1,jb_,qrel,hi);}while(0)
  #define ENDW(tt) do{ if((tt)+3<NT){WAIT_BAR(2);} else if((tt)+2<NT){WAIT_BAR(1);} else {WAIT_BAR(0);} }while(0)
  for(;t+1<NT;t+=2){
    STEP(pB0,pB1,pA0,pA1,t,(t+3<NT),(t+1<NT),(t+1<NT));       ENDW(t);   RESC(); ROT();
    STEP(pA0,pA1,pB0,pB1,t+1,(t+4<NT),(t+2<NT),(t+2<NT));     ENDW(t+1); RESC(); ROT();
  }
  STEP(pB0,pB1,pA0,pA1,NT-1,false,false,false); RESC();
  { float sacc=pB0[0]+pB0[1]; _Pragma("unroll") for(int r=2;r<16;++r)sacc+=pB0[r]; _Pragma("unroll") for(int r=0;r<16;++r)sacc+=pB1[r]; l_reg+=sacc;
    pw0=(u32x4){PKW(pB0,0),PKW(pB0,2),PKW(pB0,4),PKW(pB0,6)};pw1=(u32x4){PKW(pB0,8),PKW(pB0,10),PKW(pB0,12),PKW(pB0,14)};pw2=(u32x4){PKW(pB1,0),PKW(pB1,2),PKW(pB1,4),PKW(pB1,6)};pw3=(u32x4){PKW(pB1,8),PKW(pB1,10),PKW(pB1,12),PKW(pB1,14)};
    SBAR(); pv(o,vb0+sl_cur,PAF(0),PAF(1),PAF(2),PAF(3)); }
  #undef PKW
  #undef PAF
  #undef VFR
  #undef PIN
  #undef MX3
  #undef GAPA
  #undef GAPB
  #undef EX
  #undef VRD
  #undef KRD
  #undef STEP
  #undef ENDW
  {auto rr=__builtin_amdgcn_permlane32_swap(__float_as_uint(l_reg),__float_as_uint(l_reg),false,false);l_reg=__uint_as_float(rr[0])+__uint_as_float(rr[1]);}
  if(hi==0)wsf[32+r32]=l_reg;asm volatile("s_waitcnt lgkmcnt(0)":::"memory");
  float rli[16];
  #pragma unroll
  for(int r=0;r<16;++r)rli[r]=__builtin_amdgcn_rcpf(wsf[32+crow(r,hi)]);
  bf16*Ow=O+(rowbase+q0+wid*QBLK)*DM+hv*D;
  { bf16*stg=(bf16*)(shm+LDS_OST)+wid*2048;
    #pragma unroll
    for(int r=0;r<16;++r){const int orow=crow(r,hi);
      #pragma unroll
      for(int d0=0;d0<2;++d0)stg[orow*64+d0*32+r32]=__float2bfloat16(o[d0][r]*rli[r]);}
    asm volatile("s_waitcnt lgkmcnt(0)":::"memory");
    #pragma unroll
    for(int i=0;i<4;++i){const int row=i*8+(lane>>3),ch=lane&7; const u32x4 v=*(const u32x4*)(stg+row*64+ch*8); ATTN_STORE16(Ow+(long)row*DM+ch*8,v);} }
  asm volatile("s_waitcnt lgkmcnt(0)\n\ts_barrier":::"memory");
  #undef DMA_K
  #undef DMA_V
  #undef CMASK
  #undef START
  #undef RESC
  #undef ROT
}
constexpr int ATTN_LDS_BYTES=LDS_BYTES;
#undef SBAR
#undef WAIT_BAR
}

namespace attn128 {
using attn_body::bf16; using attn_body::bf16x8; using attn_body::s16x4; using attn_body::f32x16; using attn_body::u32x4;
constexpr int SEQ_ = 8192, DMP = 1024, NW = 8, QBLK = 32, QB = 256, KVBLK = 64;
constexpr int KSLOT = 8192, VSLOT = 16384, NBUF = 3;
constexpr int L_K = 0, L_V = NBUF * KSLOT, L_WS = L_V + NBUF * VSLOT, L_OST = L_WS + NW * 64 * 4, L_BYTES = L_OST + NW * 8192;
#define A128_SBAR() __builtin_amdgcn_sched_barrier(0)
#define A128_WAITL(n) asm volatile("s_waitcnt lgkmcnt(" #n ")" ::: "memory")
__device__ __forceinline__ void pv128(f32x16* o, int vb, bf16x8 pa0, bf16x8 pa1, bf16x8 pa2, bf16x8 pa3) {
    s16x4 lo0, hi0, lo1, hi1, lo2, hi2, lo3, hi3, lo4, hi4;
#define A128_RDF(i, LO, HI) do { asm volatile("ds_read_b64_tr_b16 %0,%1 offset:%c2" : "=&v"(LO) : "v"(vb), "i"(((i) & 3) * 4096 + ((i) >> 2) * 1024) : "memory"); \
                                 asm volatile("ds_read_b64_tr_b16 %0,%1 offset:%c2" : "=&v"(HI) : "v"(vb), "i"(((i) & 3) * 4096 + ((i) >> 2) * 1024 + 512) : "memory"); } while (0)
#define A128_FR(LO, HI) (bf16x8){LO[0], LO[1], LO[2], LO[3], HI[0], HI[1], HI[2], HI[3]}
#define A128_MF(i, PA, LO, HI) o[(i) & 3] = __builtin_amdgcn_mfma_f32_32x32x16_bf16(PA, A128_FR(LO, HI), o[(i) & 3], 0, 0, 0)
    A128_RDF(0, lo0, hi0); A128_RDF(1, lo1, hi1); A128_RDF(2, lo2, hi2); A128_RDF(3, lo3, hi3);
    A128_RDF(4, lo4, hi4); A128_WAITL(8); A128_SBAR(); A128_MF(0, pa0, lo0, hi0);
    A128_RDF(5, lo0, hi0); A128_WAITL(8); A128_SBAR(); A128_MF(1, pa0, lo1, hi1);
    A128_RDF(6, lo1, hi1); A128_WAITL(8); A128_SBAR(); A128_MF(2, pa0, lo2, hi2);
    A128_RDF(7, lo2, hi2); A128_WAITL(8); A128_SBAR(); A128_MF(3, pa0, lo3, hi3);
    A128_RDF(8, lo3, hi3); A128_WAITL(8); A128_SBAR(); A128_MF(4, pa1, lo4, hi4);
    A128_RDF(9, lo4, hi4); A128_WAITL(8); A128_SBAR(); A128_MF(5, pa1, lo0, hi0);
    A128_RDF(10, lo0, hi0); A128_WAITL(8); A128_SBAR(); A128_MF(6, pa1, lo1, hi1);
    A128_RDF(11, lo1, hi1); A128_WAITL(8); A128_SBAR(); A128_MF(7, pa1, lo2, hi2);
    A128_RDF(12, lo2, hi2); A128_WAITL(8); A128_SBAR(); A128_MF(8, pa2, lo3, hi3);
    A128_RDF(13, lo3, hi3); A128_WAITL(8); A128_SBAR(); A128_MF(9, pa2, lo4, hi4);
    A128_RDF(14, lo4, hi4); A128_WAITL(8); A128_SBAR(); A128_MF(10, pa2, lo0, hi0);
    A128_RDF(15, lo0, hi0); A128_WAITL(8); A128_SBAR(); A128_MF(11, pa2, lo1, hi1);
    A128_WAITL(6); A128_SBAR(); A128_MF(12, pa3, lo2, hi2);
    A128_WAITL(4); A128_SBAR(); A128_MF(13, pa3, lo3, hi3);
    A128_WAITL(2); A128_SBAR(); A128_MF(14, pa3, lo4, hi4);
    A128_WAITL(0); A128_SBAR(); A128_MF(15, pa3, lo0, hi0);
#undef A128_RDF
#undef A128_FR
#undef A128_MF
}
__device__ __forceinline__ void qkt128(f32x16& p0, f32x16& p1, int kb, const bf16x8* qr, const f32x16& negm) {
    bf16x8 k0, k1, k2, k3, k4, k5, k6, k7;
#define A128_RDK(K, OFF) asm volatile("ds_read_b128 %0,%1 offset:%c2" : "=&v"(K) : "v"(kb), "i"(OFF) : "memory")
    A128_RDK(k0, 0); A128_RDK(k1, 512); A128_RDK(k2, 2048); A128_RDK(k3, 2560); A128_RDK(k4, 4096); A128_RDK(k5, 4608); A128_RDK(k6, 6144); A128_RDK(k7, 6656);
    A128_WAITL(7); A128_SBAR(); p0 = __builtin_amdgcn_mfma_f32_32x32x16_bf16(k0, qr[0], negm, 0, 0, 0);
    A128_WAITL(6); A128_SBAR(); p1 = __builtin_amdgcn_mfma_f32_32x32x16_bf16(k1, qr[0], negm, 0, 0, 0);
    A128_WAITL(5); A128_SBAR(); p0 = __builtin_amdgcn_mfma_f32_32x32x16_bf16(k2, qr[1], p0, 0, 0, 0);
    A128_WAITL(4); A128_SBAR(); p1 = __builtin_amdgcn_mfma_f32_32x32x16_bf16(k3, qr[1], p1, 0, 0, 0);
    A128_WAITL(3); A128_SBAR(); p0 = __builtin_amdgcn_mfma_f32_32x32x16_bf16(k4, qr[2], p0, 0, 0, 0);
    A128_WAITL(2); A128_SBAR(); p1 = __builtin_amdgcn_mfma_f32_32x32x16_bf16(k5, qr[2], p1, 0, 0, 0);
    A128_WAITL(1); A128_SBAR(); p0 = __builtin_amdgcn_mfma_f32_32x32x16_bf16(k6, qr[3], p0, 0, 0, 0);
    A128_WAITL(0); A128_SBAR(); p1 = __builtin_amdgcn_mfma_f32_32x32x16_bf16(k7, qr[3], p1, 0, 0, 0);
#undef A128_RDK
    asm volatile("s_nop 15\n\ts_nop 7" : "+v"(p0), "+v"(p1));
}
constexpr int NB2 = 4, L2_K = 0, L2_V = NB2 * KSLOT, L2_WS = L2_V + NB2 * VSLOT, L2_OST = L2_WS + NW * 64 * 4, L2_BYTES = L2_OST + NW * 4096;
template <int THRL> __device__ __forceinline__ void unit2(int b, int hq, int hv, int qb, const bf16* Q, const bf16* __restrict__ K, const bf16* __restrict__ V, bf16* O, char* shm, volatile __attribute__((address_space(3))) unsigned* PRB = nullptr) {
    const int tid = threadIdx.x; int lane = tid & 63; asm volatile("" : "+v"(lane));
    const int r32 = lane & 31, hi = lane >> 5; const int wid = __builtin_amdgcn_readfirstlane(tid >> 6);
    const long rowbase = (long)b * SEQ_; const int q0 = qb * QB;
    const bf16* Qw = Q + (rowbase + q0 + wid * QBLK) * DMP + hq * 64;
    const bf16* Kh = K + rowbase * DMP + hq * 64, * Vh = V + rowbase * DMP + hv * 64;
    const unsigned lds0 = (unsigned)(uintptr_t)shm;
    float* wsf = (float*)(shm + L2_WS) + wid * 64;
    const bf16* ksrc = Kh + (long)lane * DMP + wid * 8;
    const bf16* vsrc = Vh + (long)(16 * (wid & 3) + (lane >> 2)) * DMP + (wid >> 2) * 32 + (lane & 3) * 8;
    const unsigned kdst = lds0 + L2_K + wid * 1024, vdst = lds0 + L2_V + wid * 1024;
#define A128_DMAK(t) attn_body::glds16(ksrc + (long)(t) * KVBLK * DMP, (unsigned)__builtin_amdgcn_readfirstlane(kdst + ((t) & 3) * KSLOT))
#define A128_DMAV(t) do { attn_body::glds16(vsrc + (long)(t) * KVBLK * DMP, (unsigned)__builtin_amdgcn_readfirstlane(vdst + ((t) & 3) * VSLOT)); \
        attn_body::glds16(vsrc + (long)(t) * KVBLK * DMP + 64, (unsigned)__builtin_amdgcn_readfirstlane(vdst + ((t) & 3) * VSLOT + 8192)); } while (0)
    const int vb0 = (int)(lds0 + L2_V) + ((lane >> 4) & 1) * 32 + (lane & 3) * 8 + (4 * hi + ((lane & 15) >> 2)) * 64;
    const int kb0 = (int)(lds0 + L2_K) + hi * 1024 + r32 * 16;
    const int NT = (q0 + QB) / KVBLK;
    A128_DMAK(0); A128_DMAV(0); A128_DMAK(1); A128_DMAV(1); A128_DMAK(2);
    bf16x8 qr[4];
#pragma unroll
    for (int d0 = 0; d0 < 4; ++d0) qr[d0] = *reinterpret_cast<const bf16x8*>(&Qw[(long)r32 * DMP + d0 * 16 + hi * 8]);
    float mhat = 0.f, l_reg = 0.f; f32x16 o[4]; f32x16 negm;
    { float zz; asm volatile("v_mov_b32 %0, 0" : "=v"(zz));
#pragma unroll
      for (int r = 0; r < 16; ++r) { o[0][r] = zz; o[1][r] = zz; o[2][r] = zz; o[3][r] = zz; negm[r] = zz; } }
    const int qrel = wid * QBLK + r32;
    asm volatile("s_waitcnt vmcnt(0) lgkmcnt(0)\n\ts_barrier" ::: "memory");
    u32x4 pw0, pw1, pw2, pw3;
#define A128_ROWMAX(rm) do { float a = fmaxf(fmaxf(c0[0], c0[1]), c1[0]), bb = fmaxf(fmaxf(c0[2], c0[3]), c1[1]); a = fmaxf(fmaxf(a, c1[2]), c1[3]);                    \
          _Pragma("unroll") for (int r = 4; r < 16; r += 4) { a = fmaxf(fmaxf(a, c0[r]), c0[r + 1]); bb = fmaxf(fmaxf(bb, c0[r + 2]), c0[r + 3]); a = fmaxf(fmaxf(a, c1[r]), c1[r + 1]); bb = fmaxf(fmaxf(bb, c1[r + 2]), c1[r + 3]); } \
          rm = fmaxf(a, bb); auto rr = __builtin_amdgcn_permlane32_swap(__float_as_uint(rm), __float_as_uint(rm), false, false); rm = fmaxf(__uint_as_float(rr[0]), __uint_as_float(rr[1])); } while (0)
    { A128_DMAK(3); A128_DMAV(2);
      f32x16 c0, c1; qkt128(c0, c1, kb0, qr, negm);
      { const int jb = 0 - (NT - 4); if (jb >= 0) attn_body::cmask(c0, c1, jb, qrel, hi); }
      float rm; A128_ROWMAX(rm); mhat = rm;
#pragma unroll
      for (int r = 0; r < 16; ++r) { c0[r] -= rm; c1[r] -= rm; negm[r] = -mhat; }
      float sacc = 0.f;
#pragma unroll
      for (int r = 0; r < 16; ++r) { c0[r] = __builtin_amdgcn_exp2f(c0[r]); c1[r] = __builtin_amdgcn_exp2f(c1[r]); }
#pragma unroll
      for (int r = 0; r < 16; ++r) sacc += c0[r] + c1[r];
      l_reg += sacc;
#define A128_PKW(P, B) attn_body::cvtpk_s(P[B], P[B + 1])
      pw0 = (u32x4){A128_PKW(c0, 0), A128_PKW(c0, 2), A128_PKW(c0, 4), A128_PKW(c0, 6)}; pw1 = (u32x4){A128_PKW(c0, 8), A128_PKW(c0, 10), A128_PKW(c0, 12), A128_PKW(c0, 14)};
      pw2 = (u32x4){A128_PKW(c1, 0), A128_PKW(c1, 2), A128_PKW(c1, 4), A128_PKW(c1, 6)}; pw3 = (u32x4){A128_PKW(c1, 8), A128_PKW(c1, 10), A128_PKW(c1, 12), A128_PKW(c1, 14)};
#undef A128_PKW
      asm volatile("s_waitcnt vmcnt(3) lgkmcnt(0)\n\ts_barrier" ::: "memory"); }
#define A128_RDF(i, LO, HI) do { asm volatile("ds_read_b64_tr_b16 %0,%1 offset:%c2" : "=&v"(LO) : "v"(vb), "i"(((i) >> 2) * 4096 + ((i) & 3) * 1024) : "memory"); \
                                 asm volatile("ds_read_b64_tr_b16 %0,%1 offset:%c2" : "=&v"(HI) : "v"(vb), "i"(((i) >> 2) * 4096 + ((i) & 3) * 1024 + 512) : "memory"); } while (0)
#define A128_FR(LO, HI) (bf16x8){LO[0], LO[1], LO[2], LO[3], HI[0], HI[1], HI[2], HI[3]}
#define A128_MF(i, PA, LO, HI) o[(i) >> 2] = __builtin_amdgcn_mfma_f32_32x32x16_bf16(PA, A128_FR(LO, HI), o[(i) >> 2], 0, 0, 0)
    PRB_B(36, PRB); PRBC_B(41, PRB);
    for (int t = 1; t < NT; ++t) {
        if (t + 3 < NT) A128_DMAK(t + 3);
        if (t + 2 < NT) A128_DMAV(t + 2);
        const bf16x8 pa0 = __builtin_bit_cast(bf16x8, pw0), pa1 = __builtin_bit_cast(bf16x8, pw1), pa2 = __builtin_bit_cast(bf16x8, pw2), pa3 = __builtin_bit_cast(bf16x8, pw3);
        u32x4 pn0, pn1, pn2, pn3; float sacc = 0.f; bool resc = false;
        const int vb = vb0 + ((t - 1) & 3) * VSLOT;
        s16x4 lo0, hi0, lo1, hi1, lo2, hi2, lo3, hi3, lo4, hi4;
        A128_RDF(0, lo0, hi0); A128_RDF(1, lo1, hi1); A128_RDF(2, lo2, hi2); A128_RDF(3, lo3, hi3);
        f32x16 c0, c1; qkt128(c0, c1, kb0 + (t & 3) * KSLOT, qr, negm);
        { const int jb = t - (NT - 4); if (__builtin_expect(jb >= 0, 0)) { asm volatile("" ::: "memory"); attn_body::cmask(c0, c1, jb, qrel, hi); } }
        float rmA, rmB, rm;
        A128_RDF(4, lo4, hi4); A128_WAITL(8); A128_SBAR(); A128_MF(0, pa0, lo0, hi0); rmA = fmaxf(fmaxf(c0[0], c0[1]), c1[0]); rmB = fmaxf(fmaxf(c0[2], c0[3]), c1[1]); rmA = fmaxf(fmaxf(rmA, c1[2]), c1[3]); rmA = fmaxf(fmaxf(rmA, c0[4]), c0[5]); rmB = fmaxf(fmaxf(rmB, c0[6]), c0[7]); asm volatile("" : "+v"(rmA), "+v"(rmB)); A128_SBAR();
        A128_RDF(5, lo0, hi0); A128_WAITL(8); A128_SBAR(); A128_MF(1, pa1, lo1, hi1); rmA = fmaxf(fmaxf(rmA, c1[4]), c1[5]); rmB = fmaxf(fmaxf(rmB, c1[6]), c1[7]); rmA = fmaxf(fmaxf(rmA, c0[8]), c0[9]); rmB = fmaxf(fmaxf(rmB, c0[10]), c0[11]); rmA = fmaxf(fmaxf(rmA, c1[8]), c1[9]); asm volatile("" : "+v"(rmA), "+v"(rmB)); A128_SBAR();
        A128_RDF(6, lo1, hi1); A128_WAITL(8); A128_SBAR(); A128_MF(2, pa2, lo2, hi2); rmB = fmaxf(fmaxf(rmB, c1[10]), c1[11]); rmA = fmaxf(fmaxf(rmA, c0[12]), c0[13]); rmB = fmaxf(fmaxf(rmB, c0[14]), c0[15]); rmA = fmaxf(fmaxf(rmA, c1[12]), c1[13]); rmB = fmaxf(fmaxf(rmB, c1[14]), c1[15]); asm volatile("" : "+v"(rmA), "+v"(rmB)); A128_SBAR();
        A128_RDF(7, lo2, hi2); A128_WAITL(8); A128_SBAR(); A128_MF(3, pa3, lo3, hi3); rm = fmaxf(rmA, rmB); { auto rr = __builtin_amdgcn_permlane32_swap(__float_as_uint(rm), __float_as_uint(rm), false, false); rm = fmaxf(__uint_as_float(rr[0]), __uint_as_float(rr[1])); } asm volatile("" : "+v"(rm)); A128_SBAR();
        if (__builtin_expect(__any(rm > (float)THRL), 0)) {
            const float dl = fmaxf(rm, 0.f); mhat += dl;
#pragma unroll
            for (int r = 0; r < 16; ++r) { c0[r] -= dl; c1[r] -= dl; negm[r] = -mhat; }
            const float f = __builtin_amdgcn_exp2f(-dl); l_reg *= f; if (hi == 0) wsf[r32] = f; resc = true; asm volatile("s_waitcnt lgkmcnt(0)" ::: "memory"); }
        A128_RDF(8, lo3, hi3); A128_WAITL(8); A128_SBAR(); A128_MF(4, pa0, lo4, hi4); { const float e0_ = __builtin_amdgcn_exp2f(c0[0]), e1_ = __builtin_amdgcn_exp2f(c0[1]); sacc += e0_; sacc += e1_; pn0[0] = attn_body::cvtpk_s(e0_, e1_); asm volatile("" : "+v"(sacc), "+v"(pn0)); } { const float e0_ = __builtin_amdgcn_exp2f(c0[2]), e1_ = __builtin_amdgcn_exp2f(c0[3]); sacc += e0_; sacc += e1_; pn0[1] = attn_body::cvtpk_s(e0_, e1_); asm volatile("" : "+v"(sacc), "+v"(pn0)); } A128_SBAR();
        A128_RDF(9, lo4, hi4); A128_WAITL(8); A128_SBAR(); A128_MF(5, pa1, lo0, hi0); { const float e0_ = __builtin_amdgcn_exp2f(c0[4]), e1_ = __builtin_amdgcn_exp2f(c0[5]); sacc += e0_; sacc += e1_; pn0[2] = attn_body::cvtpk_s(e0_, e1_); asm volatile("" : "+v"(sacc), "+v"(pn0)); } A128_SBAR();
        A128_RDF(10, lo0, hi0); A128_WAITL(8); A128_SBAR(); A128_MF(6, pa2, lo1, hi1); { const float e0_ = __builtin_amdgcn_exp2f(c0[6]), e1_ = __builtin_amdgcn_exp2f(c0[7]); sacc += e0_; sacc += e1_; pn0[3] = attn_body::cvtpk_s(e0_, e1_); asm volatile("" : "+v"(sacc), "+v"(pn0)); } A128_SBAR();
        A128_RDF(11, lo1, hi1); A128_WAITL(8); A128_SBAR(); A128_MF(7, pa3, lo2, hi2); { const float e0_ = __builtin_amdgcn_exp2f(c0[8]), e1_ = __builtin_amdgcn_exp2f(c0[9]); sacc += e0_; sacc += e1_; pn1[0] = attn_body::cvtpk_s(e0_, e1_); asm volatile("" : "+v"(sacc), "+v"(pn1)); } { const float e0_ = __builtin_amdgcn_exp2f(c0[10]), e1_ = __builtin_amdgcn_exp2f(c0[11]); sacc += e0_; sacc += e1_; pn1[1] = attn_body::cvtpk_s(e0_, e1_); asm volatile("" : "+v"(sacc), "+v"(pn1)); } A128_SBAR();
        A128_RDF(12, lo2, hi2); A128_WAITL(8); A128_SBAR(); A128_MF(8, pa0, lo3, hi3); { const float e0_ = __builtin_amdgcn_exp2f(c0[12]), e1_ = __builtin_amdgcn_exp2f(c0[13]); sacc += e0_; sacc += e1_; pn1[2] = attn_body::cvtpk_s(e0_, e1_); asm volatile("" : "+v"(sacc), "+v"(pn1)); } A128_SBAR();
        A128_RDF(13, lo3, hi3); A128_WAITL(8); A128_SBAR(); A128_MF(9, pa1, lo4, hi4); { const float e0_ = __builtin_amdgcn_exp2f(c0[14]), e1_ = __builtin_amdgcn_exp2f(c0[15]); sacc += e0_; sacc += e1_; pn1[3] = attn_body::cvtpk_s(e0_, e1_); asm volatile("" : "+v"(sacc), "+v"(pn1)); } A128_SBAR();
        A128_RDF(14, lo4, hi4); A128_WAITL(8); A128_SBAR(); A128_MF(10, pa2, lo0, hi0); { const float e0_ = __builtin_amdgcn_exp2f(c1[0]), e1_ = __builtin_amdgcn_exp2f(c1[1]); sacc += e0_; sacc += e1_; pn2[0] = attn_body::cvtpk_s(e0_, e1_); asm volatile("" : "+v"(sacc), "+v"(pn2)); } { const float e0_ = __builtin_amdgcn_exp2f(c1[2]), e1_ = __builtin_amdgcn_exp2f(c1[3]); sacc += e0_; sacc += e1_; pn2[1] = attn_body::cvtpk_s(e0_, e1_); asm volatile("" : "+v"(sacc), "+v"(pn2)); } A128_SBAR();
        A128_RDF(15, lo0, hi0); A128_WAITL(8); A128_SBAR(); A128_MF(11, pa3, lo1, hi1); { const float e0_ = __builtin_amdgcn_exp2f(c1[4]), e1_ = __builtin_amdgcn_exp2f(c1[5]); sacc += e0_; sacc += e1_; pn2[2] = attn_body::cvtpk_s(e0_, e1_); asm volatile("" : "+v"(sacc), "+v"(pn2)); } A128_SBAR();
        A128_WAITL(6); A128_SBAR(); A128_MF(12, pa0, lo2, hi2); { const float e0_ = __builtin_amdgcn_exp2f(c1[6]), e1_ = __builtin_amdgcn_exp2f(c1[7]); sacc += e0_; sacc += e1_; pn2[3] = attn_body::cvtpk_s(e0_, e1_); asm volatile("" : "+v"(sacc), "+v"(pn2)); } A128_SBAR();
        A128_WAITL(4); A128_SBAR(); A128_MF(13, pa1, lo3, hi3); { const float e0_ = __builtin_amdgcn_exp2f(c1[8]), e1_ = __builtin_amdgcn_exp2f(c1[9]); sacc += e0_; sacc += e1_; pn3[0] = attn_body::cvtpk_s(e0_, e1_); asm volatile("" : "+v"(sacc), "+v"(pn3)); } { const float e0_ = __builtin_amdgcn_exp2f(c1[10]), e1_ = __builtin_amdgcn_exp2f(c1[11]); sacc += e0_; sacc += e1_; pn3[1] = attn_body::cvtpk_s(e0_, e1_); asm volatile("" : "+v"(sacc), "+v"(pn3)); } A128_SBAR();
        A128_WAITL(2); A128_SBAR(); A128_MF(14, pa2, lo4, hi4); { const float e0_ = __builtin_amdgcn_exp2f(c1[12]), e1_ = __builtin_amdgcn_exp2f(c1[13]); sacc += e0_; sacc += e1_; pn3[2] = attn_body::cvtpk_s(e0_, e1_); asm volatile("" : "+v"(sacc), "+v"(pn3)); } A128_SBAR();
        A128_WAITL(0); A128_SBAR(); A128_MF(15, pa3, lo0, hi0); { const float e0_ = __builtin_amdgcn_exp2f(c1[14]), e1_ = __builtin_amdgcn_exp2f(c1[15]); sacc += e0_; sacc += e1_; pn3[3] = attn_body::cvtpk_s(e0_, e1_); asm volatile("" : "+v"(sacc), "+v"(pn3)); } A128_SBAR();
        l_reg += sacc;
        if (resc) { asm volatile("s_waitcnt lgkmcnt(0)" ::: "memory");
#pragma unroll
            for (int r = 0; r < 16; ++r) { const float fr = wsf[attn_body::crow(r, hi)]; o[0][r] *= fr; o[1][r] *= fr; o[2][r] *= fr; o[3][r] *= fr; } }
        pw0 = pn0; pw1 = pn1; pw2 = pn2; pw3 = pn3;
        if (t + 3 < NT) asm volatile("s_waitcnt vmcnt(6) lgkmcnt(0)\n\ts_barrier" ::: "memory");
        else if (t + 2 < NT) asm volatile("s_waitcnt vmcnt(5) lgkmcnt(0)\n\ts_barrier" ::: "memory");
        else if (t + 1 < NT) asm volatile("s_waitcnt vmcnt(2) lgkmcnt(0)\n\ts_barrier" ::: "memory");
        else asm volatile("s_waitcnt vmcnt(0) lgkmcnt(0)\n\ts_barrier" ::: "memory");
    }
    PRB_E(36, PRB); PRBC_E(41, PRB);
#undef A128_RDF
#undef A128_FR
#undef A128_MF
    pv128(o, vb0 + ((NT - 1) & 3) * VSLOT, __builtin_bit_cast(bf16x8, pw0), __builtin_bit_cast(bf16x8, pw1), __builtin_bit_cast(bf16x8, pw2), __builtin_bit_cast(bf16x8, pw3));
    { auto rr = __builtin_amdgcn_permlane32_swap(__float_as_uint(l_reg), __float_as_uint(l_reg), false, false); l_reg = __uint_as_float(rr[0]) + __uint_as_float(rr[1]); }
    int lne = lane; asm volatile("" : "+v"(lne));
    const int r32e = lne & 31, hie = lne >> 5;
    if (hie == 0) wsf[32 + r32e] = l_reg; asm volatile("s_waitcnt lgkmcnt(0)" ::: "memory");
    float rli[16];
#pragma unroll
    for (int r = 0; r < 16; ++r) rli[r] = __builtin_amdgcn_rcpf(wsf[32 + attn_body::crow(r, hie)]);
    bf16* Ow = O + (rowbase + q0 + wid * QBLK) * DMP + hv * 64;
    { bf16* stg = (bf16*)(shm + L2_OST) + wid * 2048;
#pragma unroll
      for (int half = 0; half < 2; ++half) {
#pragma unroll
          for (int r = 0; r < 16; ++r) { const int orow = attn_body::crow(r, hie);
#pragma unroll
              for (int d0 = 0; d0 < 2; ++d0) stg[orow * 64 + d0 * 32 + r32e] = __float2bfloat16(o[2 * half + d0][r] * rli[r]); }
          asm volatile("s_waitcnt lgkmcnt(0)" ::: "memory");
#pragma unroll
          for (int i = 0; i < 4; ++i) { const int row = i * 8 + (lne >> 3), ch = lne & 7; const u32x4 v = *(const u32x4*)(stg + row * 64 + ch * 8); *(u32x4*)(Ow + (long)row * DMP + half * 64 + ch * 8) = v; }
          asm volatile("s_waitcnt lgkmcnt(0)" ::: "memory"); } }
    asm volatile("s_waitcnt lgkmcnt(0)\n\ts_barrier" ::: "memory");
#undef A128_DMAK
#undef A128_DMAV
#undef A128_ROWMAX
}
constexpr int NB3_ = 4;
template <int THRL> __device__ __forceinline__ void unit3(int b, int hq, int hv, int qb, const bf16* Q, const bf16* __restrict__ K, const bf16* __restrict__ V, bf16* O, char* shm) {
    const int tid = threadIdx.x; int lane = tid & 63; asm volatile("" : "+v"(lane));
    const int r32 = lane & 31, hi = lane >> 5; const int wid = __builtin_amdgcn_readfirstlane(tid >> 6);
    const long rowbase = (long)b * SEQ_; const int q0 = qb * QB;
    const bf16* Qw = Q + (rowbase + q0 + wid * QBLK) * DMP + hq * 64;
    const bf16* Kh = K + rowbase * DMP + hq * 64, * Vh = V + rowbase * DMP + hv * 64;
    const unsigned lds0 = (unsigned)(uintptr_t)shm;
    float* wsf = (float*)(shm + L2_WS) + wid * 64;
    const bf16* ksrc = Kh + (long)lane * DMP + wid * 8;
    const bf16* vsrc = Vh + (long)(16 * (wid & 3) + (lane >> 2)) * DMP + (wid >> 2) * 32 + (lane & 3) * 8;
    const unsigned kdst = lds0 + L2_K + wid * 1024, vdst = lds0 + L2_V + wid * 1024;
#define A128_DMAK(t) attn_body::glds16(ksrc + (long)(t) * KVBLK * DMP, (unsigned)__builtin_amdgcn_readfirstlane(kdst + ((t) & 3) * KSLOT))
#define A128_DMAV(t) do { attn_body::glds16(vsrc + (long)(t) * KVBLK * DMP, (unsigned)__builtin_amdgcn_readfirstlane(vdst + ((t) & 3) * VSLOT)); \
        attn_body::glds16(vsrc + (long)(t) * KVBLK * DMP + 64, (unsigned)__builtin_amdgcn_readfirstlane(vdst + ((t) & 3) * VSLOT + 8192)); } while (0)
    const int vb0 = (int)(lds0 + L2_V) + ((lane >> 4) & 1) * 32 + (lane & 3) * 8 + (4 * hi + ((lane & 15) >> 2)) * 64;
    const int kb0 = (int)(lds0 + L2_K) + hi * 1024 + r32 * 16;
    const int NT = (q0 + QB) / KVBLK;
    A128_DMAV(0); A128_DMAK(0); A128_DMAK(1); A128_DMAK(2);
    bf16x8 qr[4];
#pragma unroll
    for (int d0 = 0; d0 < 4; ++d0) qr[d0] = *reinterpret_cast<const bf16x8*>(&Qw[(long)r32 * DMP + d0 * 16 + hi * 8]);
    float mhat = 0.f, l_reg = 0.f; f32x16 o[4]; f32x16 negm;
    { float zz; asm volatile("v_mov_b32 %0, 0" : "=v"(zz));
#pragma unroll
      for (int r = 0; r < 16; ++r) { o[0][r] = zz; o[1][r] = zz; o[2][r] = zz; o[3][r] = zz; negm[r] = zz; } }
    const int qrel = wid * QBLK + r32;
    asm volatile("s_waitcnt vmcnt(0) lgkmcnt(0)\n\ts_barrier" ::: "memory");
    u32x4 pw0, pw1, pw2, pw3;
#define A128_ROWMAX(rm) do { float a = fmaxf(fmaxf(c0[0], c0[1]), c1[0]), bb = fmaxf(fmaxf(c0[2], c0[3]), c1[1]); a = fmaxf(fmaxf(a, c1[2]), c1[3]);                    \
          _Pragma("unroll") for (int r = 4; r < 16; r += 4) { a = fmaxf(fmaxf(a, c0[r]), c0[r + 1]); bb = fmaxf(fmaxf(bb, c0[r + 2]), c0[r + 3]); a = fmaxf(fmaxf(a, c1[r]), c1[r + 1]); bb = fmaxf(fmaxf(bb, c1[r + 2]), c1[r + 3]); } \
          rm = fmaxf(a, bb); auto rr = __builtin_amdgcn_permlane32_swap(__float_as_uint(rm), __float_as_uint(rm), false, false); rm = fmaxf(__uint_as_float(rr[0]), __uint_as_float(rr[1])); } while (0)
    f32x16 c0, c1; bool resc = false;
#define A128_PKW(P, B) attn_body::cvtpk_s(P[B], P[B + 1])
#define A128_RDF(i, LO, HI) do { asm volatile("ds_read_b64_tr_b16 %0,%1 offset:%c2" : "=&v"(LO) : "v"(vb), "i"(((i) >> 2) * 4096 + ((i) & 3) * 1024) : "memory"); \
                                 asm volatile("ds_read_b64_tr_b16 %0,%1 offset:%c2" : "=&v"(HI) : "v"(vb), "i"(((i) >> 2) * 4096 + ((i) & 3) * 1024 + 512) : "memory"); } while (0)
#define A128_FR(LO, HI) (bf16x8){LO[0], LO[1], LO[2], LO[3], HI[0], HI[1], HI[2], HI[3]}
#define A128_MF(i, PA, LO, HI) o[(i) >> 2] = __builtin_amdgcn_mfma_f32_32x32x16_bf16(PA, A128_FR(LO, HI), o[(i) >> 2], 0, 0, 0)
#define A128_H1(t) do { qkt128(c0, c1, kb0 + ((t) & 3) * KSLOT, qr, negm);                                                                        \
        { const int jb = (t) - (NT - 4); if (__builtin_expect(jb >= 0, 0)) { asm volatile("" ::: "memory"); attn_body::cmask(c0, c1, jb, qrel, hi); } } \
        float rm; A128_ROWMAX(rm); resc = false;                                                                                                  \
        if ((t) == 0) { mhat = rm; _Pragma("unroll") for (int r = 0; r < 16; ++r) { c0[r] -= rm; c1[r] -= rm; negm[r] = -mhat; } }               \
        else if (__builtin_expect(__any(rm > (float)THRL), 0)) { const float dl = fmaxf(rm, 0.f); mhat += dl;                                     \
            _Pragma("unroll") for (int r = 0; r < 16; ++r) { c0[r] -= dl; c1[r] -= dl; negm[r] = -mhat; }                                         \
            const float f = __builtin_amdgcn_exp2f(-dl); l_reg *= f; if (hi == 0) wsf[r32] = f; resc = true; } } while (0)
#define A128_H2_0() do { float sacc = 0.f;                                                                                                          \
        _Pragma("unroll") for (int r = 0; r < 16; ++r) { c0[r] = __builtin_amdgcn_exp2f(c0[r]); c1[r] = __builtin_amdgcn_exp2f(c1[r]); }          \
        _Pragma("unroll") for (int r = 0; r < 16; ++r) sacc += c0[r] + c1[r];                                                                     \
        l_reg += sacc;                                                                                                                            \
        pw0 = (u32x4){A128_PKW(c0, 0), A128_PKW(c0, 2), A128_PKW(c0, 4), A128_PKW(c0, 6)}; pw1 = (u32x4){A128_PKW(c0, 8), A128_PKW(c0, 10), A128_PKW(c0, 12), A128_PKW(c0, 14)}; \
        pw2 = (u32x4){A128_PKW(c1, 0), A128_PKW(c1, 2), A128_PKW(c1, 4), A128_PKW(c1, 6)}; pw3 = (u32x4){A128_PKW(c1, 8), A128_PKW(c1, 10), A128_PKW(c1, 12), A128_PKW(c1, 14)}; } while (0)
#define A128_H2(t) do { const bf16x8 pa0 = __builtin_bit_cast(bf16x8, pw0), pa1 = __builtin_bit_cast(bf16x8, pw1), pa2 = __builtin_bit_cast(bf16x8, pw2), pa3 = __builtin_bit_cast(bf16x8, pw3); \
        u32x4 pn0, pn1, pn2, pn3; float sacc = 0.f; const int vb = vb0 + (((t) - 1) & 3) * VSLOT;                                                 \
        s16x4 lo0, hi0, lo1, hi1, lo2, hi2, lo3, hi3, lo4, hi4; A128_SBAR();                                                                      \
        A128_RDF(0, lo0, hi0); A128_RDF(1, lo1, hi1); A128_RDF(2, lo2, hi2); A128_RDF(3, lo3, hi3); \
        A128_RDF(4, lo4, hi4); A128_WAITL(8); A128_SBAR(); A128_MF(0, pa0, lo0, hi0); { const float e0_ = __builtin_amdgcn_exp2f(c0[0]), e1_ = __builtin_amdgcn_exp2f(c0[1]); sacc += e0_; sacc += e1_; pn0[0] = attn_body::cvtpk_s(e0_, e1_); asm volatile("" : "+v"(sacc), "+v"(pn0)); } A128_SBAR(); \
        A128_RDF(5, lo0, hi0); A128_WAITL(8); A128_SBAR(); A128_MF(1, pa1, lo1, hi1); { const float e0_ = __builtin_amdgcn_exp2f(c0[2]), e1_ = __builtin_amdgcn_exp2f(c0[3]); sacc += e0_; sacc += e1_; pn0[1] = attn_body::cvtpk_s(e0_, e1_); asm volatile("" : "+v"(sacc), "+v"(pn0)); } A128_SBAR(); \
        A128_RDF(6, lo1, hi1); A128_WAITL(8); A128_SBAR(); A128_MF(2, pa2, lo2, hi2); { const float e0_ = __builtin_amdgcn_exp2f(c0[4]), e1_ = __builtin_amdgcn_exp2f(c0[5]); sacc += e0_; sacc += e1_; pn0[2] = attn_body::cvtpk_s(e0_, e1_); asm volatile("" : "+v"(sacc), "+v"(pn0)); } A128_SBAR(); \
        A128_RDF(7, lo2, hi2); A128_WAITL(8); A128_SBAR(); A128_MF(3, pa3, lo3, hi3); { const float e0_ = __builtin_amdgcn_exp2f(c0[6]), e1_ = __builtin_amdgcn_exp2f(c0[7]); sacc += e0_; sacc += e1_; pn0[3] = attn_body::cvtpk_s(e0_, e1_); asm volatile("" : "+v"(sacc), "+v"(pn0)); } A128_SBAR(); \
        A128_RDF(8, lo3, hi3); A128_WAITL(8); A128_SBAR(); A128_MF(4, pa0, lo4, hi4); { const float e0_ = __builtin_amdgcn_exp2f(c0[8]), e1_ = __builtin_amdgcn_exp2f(c0[9]); sacc += e0_; sacc += e1_; pn1[0] = attn_body::cvtpk_s(e0_, e1_); asm volatile("" : "+v"(sacc), "+v"(pn1)); } A128_SBAR(); \
        A128_RDF(9, lo4, hi4); A128_WAITL(8); A128_SBAR(); A128_MF(5, pa1, lo0, hi0); { const float e0_ = __builtin_amdgcn_exp2f(c0[10]), e1_ = __builtin_amdgcn_exp2f(c0[11]); sacc += e0_; sacc += e1_; pn1[1] = attn_body::cvtpk_s(e0_, e1_); asm volatile("" : "+v"(sacc), "+v"(pn1)); } A128_SBAR(); \
        A128_RDF(10, lo0, hi0); A128_WAITL(8); A128_SBAR(); A128_MF(6, pa2, lo1, hi1); { const float e0_ = __builtin_amdgcn_exp2f(c0[12]), e1_ = __builtin_amdgcn_exp2f(c0[13]); sacc += e0_; sacc += e1_; pn1[2] = attn_body::cvtpk_s(e0_, e1_); asm volatile("" : "+v"(sacc), "+v"(pn1)); } A128_SBAR(); \
        A128_RDF(11, lo1, hi1); A128_WAITL(8); A128_SBAR(); A128_MF(7, pa3, lo2, hi2); { const float e0_ = __builtin_amdgcn_exp2f(c0[14]), e1_ = __builtin_amdgcn_exp2f(c0[15]); sacc += e0_; sacc += e1_; pn1[3] = attn_body::cvtpk_s(e0_, e1_); asm volatile("" : "+v"(sacc), "+v"(pn1)); } A128_SBAR(); \
        A128_RDF(12, lo2, hi2); A128_WAITL(8); A128_SBAR(); A128_MF(8, pa0, lo3, hi3); { const float e0_ = __builtin_amdgcn_exp2f(c1[0]), e1_ = __builtin_amdgcn_exp2f(c1[1]); sacc += e0_; sacc += e1_; pn2[0] = attn_body::cvtpk_s(e0_, e1_); asm volatile("" : "+v"(sacc), "+v"(pn2)); } A128_SBAR(); \
        A128_RDF(13, lo3, hi3); A128_WAITL(8); A128_SBAR(); A128_MF(9, pa1, lo4, hi4); { const float e0_ = __builtin_amdgcn_exp2f(c1[2]), e1_ = __builtin_amdgcn_exp2f(c1[3]); sacc += e0_; sacc += e1_; pn2[1] = attn_body::cvtpk_s(e0_, e1_); asm volatile("" : "+v"(sacc), "+v"(pn2)); } A128_SBAR(); \
        A128_RDF(14, lo4, hi4); A128_WAITL(8); A128_SBAR(); A128_MF(10, pa2, lo0, hi0); { const float e0_ = __builtin_amdgcn_exp2f(c1[4]), e1_ = __builtin_amdgcn_exp2f(c1[5]); sacc += e0_; sacc += e1_; pn2[2] = attn_body::cvtpk_s(e0_, e1_); asm volatile("" : "+v"(sacc), "+v"(pn2)); } A128_SBAR(); \
        A128_RDF(15, lo0, hi0); A128_WAITL(8); A128_SBAR(); A128_MF(11, pa3, lo1, hi1); { const float e0_ = __builtin_amdgcn_exp2f(c1[6]), e1_ = __builtin_amdgcn_exp2f(c1[7]); sacc += e0_; sacc += e1_; pn2[3] = attn_body::cvtpk_s(e0_, e1_); asm volatile("" : "+v"(sacc), "+v"(pn2)); } A128_SBAR(); \
        A128_WAITL(6); A128_SBAR(); A128_MF(12, pa0, lo2, hi2); { const float e0_ = __builtin_amdgcn_exp2f(c1[8]), e1_ = __builtin_amdgcn_exp2f(c1[9]); sacc += e0_; sacc += e1_; pn3[0] = attn_body::cvtpk_s(e0_, e1_); asm volatile("" : "+v"(sacc), "+v"(pn3)); } A128_SBAR(); \
        A128_WAITL(4); A128_SBAR(); A128_MF(13, pa1, lo3, hi3); { const float e0_ = __builtin_amdgcn_exp2f(c1[10]), e1_ = __builtin_amdgcn_exp2f(c1[11]); sacc += e0_; sacc += e1_; pn3[1] = attn_body::cvtpk_s(e0_, e1_); asm volatile("" : "+v"(sacc), "+v"(pn3)); } A128_SBAR(); \
        A128_WAITL(2); A128_SBAR(); A128_MF(14, pa2, lo4, hi4); { const float e0_ = __builtin_amdgcn_exp2f(c1[12]), e1_ = __builtin_amdgcn_exp2f(c1[13]); sacc += e0_; sacc += e1_; pn3[2] = attn_body::cvtpk_s(e0_, e1_); asm volatile("" : "+v"(sacc), "+v"(pn3)); } A128_SBAR(); \
        A128_WAITL(0); A128_SBAR(); A128_MF(15, pa3, lo0, hi0); { const float e0_ = __builtin_amdgcn_exp2f(c1[14]), e1_ = __builtin_amdgcn_exp2f(c1[15]); sacc += e0_; sacc += e1_; pn3[3] = attn_body::cvtpk_s(e0_, e1_); asm volatile("" : "+v"(sacc), "+v"(pn3)); } A128_SBAR(); \
        l_reg += sacc;                                                                                                                            \
        if (resc) { asm volatile("s_waitcnt lgkmcnt(0)" ::: "memory");                                                                            \
            _Pragma("unroll") for (int r = 0; r < 16; ++r) { const float fr = wsf[attn_body::crow(r, hi)]; o[0][r] *= fr; o[1][r] *= fr; o[2][r] *= fr; o[3][r] *= fr; } } \
        pw0 = pn0; pw1 = pn1; pw2 = pn2; pw3 = pn3; } while (0)
#define A128_ISSUE(t) do { if ((t) + 1 < NT) A128_DMAV((t) + 1); if ((t) + 3 < NT) A128_DMAK((t) + 3); } while (0)
#define A128_END(t) do { if ((t) + 3 < NT) asm volatile("s_waitcnt vmcnt(4) lgkmcnt(0)\n\ts_barrier" ::: "memory");                               \
        else if ((t) + 2 < NT) asm volatile("s_waitcnt vmcnt(3) lgkmcnt(0)\n\ts_barrier" ::: "memory");                                          \
        else if ((t) + 1 < NT) asm volatile("s_waitcnt vmcnt(2) lgkmcnt(0)\n\ts_barrier" ::: "memory");                                          \
        else asm volatile("s_waitcnt vmcnt(0) lgkmcnt(0)\n\ts_barrier" ::: "memory"); } while (0)
    if (wid < 4) {
        A128_ISSUE(0); A128_H1(0); A128_H2_0(); A128_END(0);
        for (int t = 1; t < NT; ++t) { A128_ISSUE(t); A128_H1(t); A128_H2(t); A128_END(t); }
    } else {
        A128_ISSUE(0); A128_H1(0); A128_END(0);
        A128_ISSUE(1); A128_H2_0(); A128_H1(1); A128_END(1);
        for (int t = 2; t < NT; ++t) { A128_ISSUE(t); A128_H2(t - 1); A128_H1(t); A128_END(t); }
        A128_H2(NT - 1);
    }
    asm volatile("s_waitcnt vmcnt(0) lgkmcnt(0)\n\ts_barrier" ::: "memory");
#undef A128_H1
#undef A128_H2_0
#undef A128_H2
#undef A128_ISSUE
#undef A128_END
#undef A128_PKW
#undef A128_RDF
#undef A128_FR
#undef A128_MF
    pv128(o, vb0 + ((NT - 1) & 3) * VSLOT, __builtin_bit_cast(bf16x8, pw0), __builtin_bit_cast(bf16x8, pw1), __builtin_bit_cast(bf16x8, pw2), __builtin_bit_cast(bf16x8, pw3));
    { auto rr = __builtin_amdgcn_permlane32_swap(__float_as_uint(l_reg), __float_as_uint(l_reg), false, false); l_reg = __uint_as_float(rr[0]) + __uint_as_float(rr[1]); }
    int lne = lane; asm volatile("" : "+v"(lne));
    const int r32e = lne & 31, hie = lne >> 5;
    if (hie == 0) wsf[32 + r32e] = l_reg; asm volatile("s_waitcnt lgkmcnt(0)" ::: "memory");
    float rli[16];
#pragma unroll
    for (int r = 0; r < 16; ++r) rli[r] = __builtin_amdgcn_rcpf(wsf[32 + attn_body::crow(r, hie)]);
    bf16* Ow = O + (rowbase + q0 + wid * QBLK) * DMP + hv * 64;
    { bf16* stg = (bf16*)(shm + L2_OST) + wid * 2048;
#pragma unroll
      for (int half = 0; half < 2; ++half) {
#pragma unroll
          for (int r = 0; r < 16; ++r) { const int orow = attn_body::crow(r, hie);
#pragma unroll
              for (int d0 = 0; d0 < 2; ++d0) stg[orow * 64 + d0 * 32 + r32e] = __float2bfloat16(o[2 * half + d0][r] * rli[r]); }
          asm volatile("s_waitcnt lgkmcnt(0)" ::: "memory");
#pragma unroll
          for (int i = 0; i < 4; ++i) { const int row = i * 8 + (lne >> 3), ch = lne & 7; const u32x4 v = *(const u32x4*)(stg + row * 64 + ch * 8); *(u32x4*)(Ow + (long)row * DMP + half * 64 + ch * 8) = v; }
          asm volatile("s_waitcnt lgkmcnt(0)" ::: "memory"); } }
    asm volatile("s_waitcnt lgkmcnt(0)\n\ts_barrier" ::: "memory");
#undef A128_DMAK
#undef A128_DMAV
#undef A128_ROWMAX
}
#define A128_ROWMAX(rm) do { float a = fmaxf(fmaxf(c0[0], c0[1]), c1[0]), bb = fmaxf(fmaxf(c0[2], c0[3]), c1[1]); a = fmaxf(fmaxf(a, c1[2]), c1[3]);                    \
          _Pragma("unroll") for (int r = 4; r < 16; r += 4) { a = fmaxf(fmaxf(a, c0[r]), c0[r + 1]); bb = fmaxf(fmaxf(bb, c0[r + 2]), c0[r + 3]); a = fmaxf(fmaxf(a, c1[r]), c1[r + 1]); bb = fmaxf(fmaxf(bb, c1[r + 2]), c1[r + 3]); } \
          rm = fmaxf(a, bb); auto rr = __builtin_amdgcn_permlane32_swap(__float_as_uint(rm), __float_as_uint(rm), false, false); rm = fmaxf(__uint_as_float(rr[0]), __uint_as_float(rr[1])); } while (0)

__device__ __forceinline__ void qkt128r(f32x16& p0, f32x16& p1, int kb, const bf16x8* qr, const f32x16& negm) {
    bf16x8 k0, k1, k2, k3;
#define A128_RDK(K, OFF) asm volatile("ds_read_b128 %0,%1 offset:%c2" : "=&v"(K) : "v"(kb), "i"(OFF) : "memory")
#define A128_RDK2(K, OFF) asm volatile("ds_read_b128 %0,%1 offset:%c2" : "+v"(K) : "v"(kb), "i"(OFF) : "memory")
    A128_RDK(k0, 0); A128_RDK(k1, 512); A128_RDK(k2, 2048); A128_RDK(k3, 2560);
    A128_WAITL(3); A128_SBAR(); p0 = __builtin_amdgcn_mfma_f32_32x32x16_bf16(k0, qr[0], negm, 0, 0, 0); A128_SBAR(); A128_RDK2(k0, 4096);
    A128_WAITL(3); A128_SBAR(); p1 = __builtin_amdgcn_mfma_f32_32x32x16_bf16(k1, qr[0], negm, 0, 0, 0); A128_SBAR(); A128_RDK2(k1, 4608);
    A128_WAITL(3); A128_SBAR(); p0 = __builtin_amdgcn_mfma_f32_32x32x16_bf16(k2, qr[1], p0, 0, 0, 0); A128_SBAR(); A128_RDK2(k2, 6144);
    A128_WAITL(3); A128_SBAR(); p1 = __builtin_amdgcn_mfma_f32_32x32x16_bf16(k3, qr[1], p1, 0, 0, 0); A128_SBAR(); A128_RDK2(k3, 6656);
    A128_WAITL(3); A128_SBAR(); p0 = __builtin_amdgcn_mfma_f32_32x32x16_bf16(k0, qr[2], p0, 0, 0, 0);
    A128_WAITL(2); A128_SBAR(); p1 = __builtin_amdgcn_mfma_f32_32x32x16_bf16(k1, qr[2], p1, 0, 0, 0);
    A128_WAITL(1); A128_SBAR(); p0 = __builtin_amdgcn_mfma_f32_32x32x16_bf16(k2, qr[3], p0, 0, 0, 0);
    A128_WAITL(0); A128_SBAR(); p1 = __builtin_amdgcn_mfma_f32_32x32x16_bf16(k3, qr[3], p1, 0, 0, 0);
#undef A128_RDK
#undef A128_RDK2
    asm volatile("s_nop 15\n\ts_nop 7" : "+v"(p0), "+v"(p1));
}
template <int THRL> __device__ __forceinline__ void unit4(int b, int hq, int hv, int qb, const bf16* Q, const bf16* __restrict__ K, const bf16* __restrict__ V, bf16* O, char* shm, volatile __attribute__((address_space(3))) unsigned* PRB = nullptr) {
    const int tid = threadIdx.x; int lane = tid & 63; asm volatile("" : "+v"(lane));
    const int r32 = lane & 31, hi = lane >> 5; const int wid = __builtin_amdgcn_readfirstlane(tid >> 6);
    const long rowbase = (long)b * SEQ_; const int q0 = qb * QB;
    const bf16* Qw = Q + (rowbase + q0 + wid * QBLK) * DMP + hq * 64;
    const bf16* Kh = K + rowbase * DMP + hq * 64, * Vh = V + rowbase * DMP + hv * 64;
    const unsigned lds0 = (unsigned)(uintptr_t)shm;
    float* wsf = (float*)(shm + L2_WS) + wid * 64;
    const bf16* ksrc = Kh + (long)lane * DMP + wid * 8;
    const bf16* vsrc = Vh + (long)(16 * (wid & 3) + (lane >> 2)) * DMP + (wid >> 2) * 32 + (lane & 3) * 8;
    const unsigned kdst = lds0 + L2_K + wid * 1024, vdst = lds0 + L2_V + wid * 1024;
#define A128_DMAK(t) attn_body::glds16(ksrc + (long)(t) * KVBLK * DMP, (unsigned)__builtin_amdgcn_readfirstlane(kdst + ((t) & 3) * KSLOT))
#define A128_DMAV(t) do { attn_body::glds16(vsrc + (long)(t) * KVBLK * DMP, (unsigned)__builtin_amdgcn_readfirstlane(vdst + ((t) & 3) * VSLOT)); \
        attn_body::glds16(vsrc + (long)(t) * KVBLK * DMP + 64, (unsigned)__builtin_amdgcn_readfirstlane(vdst + ((t) & 3) * VSLOT + 8192)); } while (0)
    const int vb0 = (int)(lds0 + L2_V) + ((lane >> 4) & 1) * 32 + (lane & 3) * 8 + (4 * hi + ((lane & 15) >> 2)) * 64;
    const int kb0 = (int)(lds0 + L2_K) + hi * 1024 + r32 * 16;
    const int NT = (q0 + QB) / KVBLK;
    A128_DMAK(0); A128_DMAV(0); A128_DMAK(1); A128_DMAV(1); A128_DMAK(2);
    bf16x8 qr[4];
#pragma unroll
    for (int d0 = 0; d0 < 4; ++d0) qr[d0] = *reinterpret_cast<const bf16x8*>(&Qw[(long)r32 * DMP + d0 * 16 + hi * 8]);
    float mhat = 0.f, l_reg = 0.f; f32x16 o[4]; f32x16 negm;
    { float zz; asm volatile("v_mov_b32 %0, 0" : "=v"(zz));
#pragma unroll
      for (int r = 0; r < 16; ++r) { o[0][r] = zz; o[1][r] = zz; o[2][r] = zz; o[3][r] = zz; negm[r] = zz; } }
    const int qrel = wid * QBLK + r32;
    asm volatile("s_waitcnt vmcnt(0) lgkmcnt(0)\n\ts_barrier" ::: "memory");
    u32x4 pw0, pw1, pw2, pw3; f32x16 c0, c1;
#define A128_PKW(P, B) attn_body::cvtpk_s(P[B], P[B + 1])
#define A128_ISSUE(s) do { if ((s) + 3 < NT) A128_DMAK((s) + 3); if ((s) + 2 < NT) A128_DMAV((s) + 2); } while (0)
#define A128_BARE() asm volatile("s_waitcnt lgkmcnt(0)\n\ts_barrier" ::: "memory")
#define A128_BARO(s) do { PRB_B(55, PRB); if ((s) + 3 < NT) asm volatile("s_waitcnt vmcnt(6) lgkmcnt(0)" ::: "memory");                               \
        else if ((s) + 2 < NT) asm volatile("s_waitcnt vmcnt(5) lgkmcnt(0)" ::: "memory");                                          \
        else if ((s) + 1 < NT) asm volatile("s_waitcnt vmcnt(2) lgkmcnt(0)" ::: "memory");                                          \
        else asm volatile("s_waitcnt vmcnt(0) lgkmcnt(0)" ::: "memory"); PRB_E(55, PRB); PRB_B(56, PRB); asm volatile("s_barrier" ::: "memory"); PRB_E(56, PRB); } while (0)
#define A128_MQK(t) qkt128r(c0, c1, kb0 + ((t) & 3) * KSLOT, qr, negm)
#define A128_MPV(t) pv128(o, vb0 + ((t) & 3) * VSLOT, __builtin_bit_cast(bf16x8, pw0), __builtin_bit_cast(bf16x8, pw1), __builtin_bit_cast(bf16x8, pw2), __builtin_bit_cast(bf16x8, pw3))
#define A128_VEC(t) do { int hv_ = hi, qrel_ = qrel, r32_ = r32; asm volatile("" : "+v"(hv_), "+v"(qrel_), "+v"(r32_));                                \
        { const int jb = (t) - (NT - 4); if (__builtin_expect(jb >= 0, 0)) { asm volatile("" ::: "memory"); attn_body::cmask(c0, c1, jb, qrel_, hv_); } } \
        float rm; A128_ROWMAX(rm);                                                                                                                 \
        if ((t) == 0) { mhat = rm; _Pragma("unroll") for (int r = 0; r < 16; ++r) { c0[r] -= rm; c1[r] -= rm; negm[r] = -mhat; } }                \
        else if (__builtin_expect(__any(rm > (float)THRL), 0)) { const float dl = fmaxf(rm, 0.f); mhat += dl;                                      \
            _Pragma("unroll") for (int r = 0; r < 16; ++r) { c0[r] -= dl; c1[r] -= dl; negm[r] = -mhat; }                                          \
            const float f = __builtin_amdgcn_exp2f(-dl); l_reg *= f; if (hv_ == 0) wsf[r32_] = f; asm volatile("s_waitcnt lgkmcnt(0)" ::: "memory"); \
            _Pragma("unroll") for (int r = 0; r < 16; ++r) { const float fr = wsf[attn_body::crow(r, hv_)]; o[0][r] *= fr; o[1][r] *= fr; o[2][r] *= fr; o[3][r] *= fr; } } \
        float sacc = 0.f;                                                                                                                          \
        _Pragma("unroll") for (int r = 0; r < 16; ++r) { c0[r] = __builtin_amdgcn_exp2f(c0[r]); c1[r] = __builtin_amdgcn_exp2f(c1[r]); }           \
        _Pragma("unroll") for (int r = 0; r < 16; ++r) sacc += c0[r] + c1[r];                                                                      \
        l_reg += sacc;                                                                                                                             \
        pw0 = (u32x4){A128_PKW(c0, 0), A128_PKW(c0, 2), A128_PKW(c0, 4), A128_PKW(c0, 6)}; pw1 = (u32x4){A128_PKW(c0, 8), A128_PKW(c0, 10), A128_PKW(c0, 12), A128_PKW(c0, 14)}; \
        pw2 = (u32x4){A128_PKW(c1, 0), A128_PKW(c1, 2), A128_PKW(c1, 4), A128_PKW(c1, 6)}; pw3 = (u32x4){A128_PKW(c1, 8), A128_PKW(c1, 10), A128_PKW(c1, 12), A128_PKW(c1, 14)}; } while (0)
    const bool isB = wid >= 4;
    A128_ISSUE(0); A128_MQK(0);
    if (isB) { A128_BARO(0); A128_ISSUE(1); }
    A128_VEC(0);
    if (!isB) { A128_BARO(0); }
    for (int s = 1; s < NT; ++s) {
        if (!isB) A128_ISSUE(s);
        A128_MQK(s); A128_MPV(s - 1);
        if (isB) { A128_BARO(s); A128_ISSUE(s + 1); }
        A128_VEC(s);
        if (!isB) { A128_BARO(s); }
    }
    A128_MPV(NT - 1);
#undef A128_PKW
#undef A128_ISSUE
#undef A128_BARE
#undef A128_BARO
#undef A128_MQK
#undef A128_MPV
#undef A128_VEC
    { auto rr = __builtin_amdgcn_permlane32_swap(__float_as_uint(l_reg), __float_as_uint(l_reg), false, false); l_reg = __uint_as_float(rr[0]) + __uint_as_float(rr[1]); }
    int lne = lane; asm volatile("" : "+v"(lne));
    const int r32e = lne & 31, hie = lne >> 5;
    if (hie == 0) wsf[32 + r32e] = l_reg; asm volatile("s_waitcnt lgkmcnt(0)" ::: "memory");
    float rli[16];
#pragma unroll
    for (int r = 0; r < 16; ++r) rli[r] = __builtin_amdgcn_rcpf(wsf[32 + attn_body::crow(r, hie)]);
    bf16* Ow = O + (rowbase + q0 + wid * QBLK) * DMP + hv * 64;
    { bf16* stg = (bf16*)(shm + L2_OST) + wid * 2048;
#pragma unroll
      for (int half = 0; half < 2; ++half) {
#pragma unroll
          for (int r = 0; r < 16; ++r) { const int orow = attn_body::crow(r, hie);
#pragma unroll
              for (int d0 = 0; d0 < 2; ++d0) stg[orow * 64 + d0 * 32 + r32e] = __float2bfloat16(o[2 * half + d0][r] * rli[r]); }
          asm volatile("s_waitcnt lgkmcnt(0)" ::: "memory");
#pragma unroll
          for (int i = 0; i < 4; ++i) { const int row = i * 8 + (lne >> 3), ch = lne & 7; const u32x4 v = *(const u32x4*)(stg + row * 64 + ch * 8); *(u32x4*)(Ow + (long)row * DMP + half * 64 + ch * 8) = v; }
          asm volatile("s_waitcnt lgkmcnt(0)" ::: "memory"); } }
    asm volatile("s_waitcnt lgkmcnt(0)\n\ts_barrier" ::: "memory");
#undef A128_DMAK
#undef A128_DMAV
}
#undef A128_ROWMAX
#undef A128_SBAR
#undef A128_WAITL
}

#ifndef GAS
#define GAS __attribute__((address_space(1)))
#endif
#define LAS __attribute__((address_space(3)))
typedef unsigned short bf16;
typedef unsigned v4u __attribute__((ext_vector_type(4)));
typedef float f32x4 __attribute__((ext_vector_type(4)));
typedef float f32x2 __attribute__((ext_vector_type(2)));
typedef short bf16x8 __attribute__((ext_vector_type(8)));
typedef GAS unsigned gu32;
typedef GAS unsigned long long gu64;
#define RLX_AGENT __ATOMIC_RELAXED, __HIP_MEMORY_SCOPE_AGENT
#define LDS_WAIT() asm volatile("s_waitcnt lgkmcnt(0)" ::: "memory")
#define VM_WAIT() asm volatile("s_waitcnt vmcnt(0)" ::: "memory")
__device__ __forceinline__ unsigned long long rt() { return __builtin_amdgcn_s_memrealtime(); }
typedef float f32x2_pk __attribute__((ext_vector_type(2))); typedef __bf16 bf16x2_pk __attribute__((ext_vector_type(2)));
__device__ __forceinline__ unsigned pk2h(float lo, float hi) { f32x2_pk v = {lo, hi}; bf16x2_pk b = __builtin_convertvector(v, bf16x2_pk); return __builtin_bit_cast(unsigned, b); }
__device__ __forceinline__ unsigned pk2(float lo, float hi) { f32x2_pk v = {lo, hi}; bf16x2_pk b = __builtin_convertvector(v, bf16x2_pk); return __builtin_bit_cast(unsigned, b); }

#define XB_TMO      128
#define XB_XCNT(j)  (256  + 64 * (j))
#define XB_XSUB(j)  (1280 + 64 * (j))
#define XB_XGEN(j)  (2304 + 64 * (j))
#define XB_TOP      3328
#define XB_TOPGEN   3392
#define XCD_BAR_WORDS 3456
#define XB_SPIN_CAP (1u << 18)

__device__ __forceinline__ unsigned xb_ld(unsigned* p)              { return __hip_atomic_load(p, __ATOMIC_RELAXED, __HIP_MEMORY_SCOPE_AGENT); }
__device__ __forceinline__ unsigned xb_add(unsigned* p, unsigned v) { return __hip_atomic_fetch_add(p, v, __ATOMIC_RELAXED, __HIP_MEMORY_SCOPE_AGENT); }
__device__ __forceinline__ unsigned xb_xcc_id() { return (unsigned)__builtin_amdgcn_s_getreg((3 << 11) | 20) & 0xFu; }
#define XB_SPIN(cond, bar) do { unsigned _sp = 0; while (cond) { __builtin_amdgcn_s_sleep(1); \
    if ((++_sp & 255u) == 0u) { if (xb_ld(&(bar)[XB_TMO])) break; if (_sp > XB_SPIN_CAP) { atomicAdd(&(bar)[XB_TMO], 1u); break; } } } } while (0)

struct XcdBarrier {
    unsigned* bar; unsigned x;
    volatile LAS unsigned* st;
};

__device__ __forceinline__ XcdBarrier xcd_barrier_post(unsigned* bar, volatile LAS unsigned* st) {
    XcdBarrier b; b.bar = bar; b.x = xb_xcc_id(); b.st = st;
    if (threadIdx.x == 0) (void)xb_add(&bar[XB_XCNT(b.x)], 1u);
    return b;
}
__device__ __forceinline__ void xcd_barrier_complete(unsigned* bar, unsigned x, unsigned& nloc, unsigned& nx) {
    const unsigned G = gridDim.x * gridDim.y * gridDim.z;
    unsigned sum, cnt, mine, sp = 0u;
    for (;;) {
        sum = 0u; cnt = 0u; mine = 0u;
#pragma unroll
        for (unsigned j = 0; j < 16; ++j) { const unsigned c = xb_ld(&bar[XB_XCNT(j)]); sum += c; cnt += (c > 0u) ? 1u : 0u; mine = (j == x) ? c : mine; }
        if (sum == G) break;
        __builtin_amdgcn_s_sleep(1);
        if ((++sp & 255u) == 0u) { if (xb_ld(&bar[XB_TMO])) break; if (sp > XB_SPIN_CAP) { atomicAdd(&bar[XB_TMO], 1u); break; } }
    }
    nloc = mine > 0u ? mine : 1u; nx = cnt > 0u ? cnt : 1u;
}

__device__ __forceinline__ void xcd_barrier(const XcdBarrier& b) {
    asm volatile("s_waitcnt vmcnt(0)" ::: "memory");
    __syncthreads();
    if (tid_now((const void*)(uintptr_t)((unsigned)(uintptr_t)b.st - (320 + 32) - 152576)) == 0) {
        unsigned* bar = b.bar;
        __builtin_amdgcn_s_waitcnt(0);
        unsigned nloc = b.st[0], nx = b.st[1];
        if (nloc == 0u) { xcd_barrier_complete(bar, b.x, nloc, nx); b.st[0] = nloc; b.st[1] = nx; }
        const unsigned old = xb_add(&bar[XB_XSUB(b.x)], 1u);
        const unsigned gen = old / nloc;
        if (old + 1u == (gen + 1u) * nloc) {
            __builtin_amdgcn_fence(__ATOMIC_RELEASE, "agent");
            asm volatile("s_waitcnt vmcnt(0)" ::: "memory");
            const unsigned og = xb_add(&bar[XB_TOP], 1u);
            const unsigned tg = og / nx;
            if (og + 1u == (tg + 1u) * nx) xb_add(&bar[XB_TOPGEN], 1u);
            else XB_SPIN(xb_ld(&bar[XB_TOPGEN]) == tg, bar);
            __builtin_amdgcn_fence(__ATOMIC_ACQUIRE, "agent");
            xb_add(&bar[XB_XGEN(b.x)], 1u);
            asm volatile("s_waitcnt vmcnt(0)" ::: "memory");
        } else {
            XB_SPIN(xb_ld(&bar[XB_XGEN(b.x)]) == gen, bar);
            __builtin_amdgcn_fence(__ATOMIC_ACQUIRE, "agent");
            asm volatile("s_waitcnt vmcnt(0)" ::: "memory");
        }
    }
    __syncthreads();
}

namespace gdn {
constexpr int BLK = 75776, OFF_NEGW = 0, OFF_QDEC = 16384, OFF_KDT = 32768, OFF_AQK = 49152, OFF_U = 57344, OFF_HDR = 73728;
constexpr int GRP_BYTES = 74752, G_KN = 0, G_QN = 16384, G_VC = 32768, G_AM = 49152, G_AQS = 65536, G_CG = 73728, G_BT = 73984, G_FK = 74240;
typedef short bf16x8 __attribute__((ext_vector_type(8)));
typedef float f32x16 __attribute__((ext_vector_type(16)));
__device__ __forceinline__ int crow(int r, int hi) { return (r & 3) + 8 * (r >> 2) + 4 * hi; }
__device__ __forceinline__ int kperm(int k) { return (k & ~12) | ((k & 4) << 1) | ((k & 8) >> 1); }
__device__ __forceinline__ unsigned pk2h(float lo, float hi) { typedef float f2_ __attribute__((ext_vector_type(2))); typedef __bf16 b2_ __attribute__((ext_vector_type(2))); f2_ v = {lo, hi}; b2_ b = __builtin_convertvector(v, b2_); return __builtin_bit_cast(unsigned, b); }
__device__ __forceinline__ float silu(float a) { return a * __builtin_amdgcn_rcpf(1.0f + __expf(-a)); }

__device__ __forceinline__ void stageA(LAS unsigned char* lds, int tid, int vcu, int G, const bf16_t* slab, const float* conv_w, const float* bg, unsigned char* r2, volatile LAS unsigned* PRB) {
    const int grp = __builtin_amdgcn_readfirstlane(tid >> 8), tg = tid & 255, lane = tid & 63; const int wg = __builtin_amdgcn_readfirstlane((tid >> 6) & 3);
    LAS unsigned char* gb = lds + grp * GRP_BYTES;
    LAS float* CG = (LAS float*)(gb + G_CG); LAS float* BT = (LAS float*)(gb + G_BT); LAS float* FK = (LAS float*)(gb + G_FK); LAS float* AM = (LAS float*)(gb + G_AM);
    float pcw[6], pgv = 0.f, pbt = 0.f;
#define GDN_S0LOAD(IT) do { const int ch_ = 2 * (IT) + grp; const int n_ = ch_ & 127, bh_ = ch_ >> 7, h_ = bh_ & 7, b_ = bh_ >> 3; const size_t row0_ = (size_t)b_ * SEQ + 64 * n_; int tq_ = tg; asm volatile("" : "+v"(tq_)); \
        _Pragma("unroll") for (int i = 0; i < 6; ++i) { const int idx = tq_ + 256 * i; const int tj = idx >> 7, col = idx & 127; pcw[i] = *(const GAS float*)(conv_w + (tj & 3) * 3072 + (tj >> 2) * 1024 + h_ * 128 + col); } \
        if (wg == 0) { const int ln0_ = tq_ & 63; pgv = *(const GAS float*)(bg + (row0_ + ln0_) * 16 + 8 + h_); pbt = *(const GAS float*)(bg + (row0_ + ln0_) * 16 + h_); } } while (0)
    if (vcu < 1024) GDN_S0LOAD(vcu);
    for (int it = vcu; it < 1024; it += G) {
        const int ch = 2 * it + grp; const int n = ch & 127, bh = ch >> 7, h = bh & 7, b = bh >> 3;
        const size_t row0 = (size_t)b * SEQ + 64 * n;
        unsigned char* blk = r2 + (size_t)ch * BLK;
        PRB_B(26, PRB); PRB_B(20, PRB);
        int tg0 = tg; asm volatile("" : "+v"(tg0));
        { LAS float* CW = (LAS float*)(gb + G_AQS);
#pragma unroll
          for (int i = 0; i < 6; ++i) CW[tg0 + 256 * i] = pcw[i]; }
        if (wg == 0) { const int ln0 = tg0 & 63; const float gv = pgv, bt = pbt; float cg = gv;
#pragma unroll
            for (int o = 1; o < 64; o <<= 1) { const float t = __shfl_up(cg, o); if (ln0 >= o) cg += t; }
            CG[ln0] = cg; BT[ln0] = bt; FK[ln0] = bt * __expf(cg); }
        __syncthreads(); PRB_E(20, PRB); PRB_B(21, PRB);
        { int tg1 = tg; asm volatile("" : "+v"(tg1)); const int r = tg1 >> 2, seg = tg1 & 3; const float cgr = CG[r], cgl = CG[63];
          v4u raw[4][4], rawn[4][4];
#define GDN_LOADRAW(DST, TY) do { const bf16_t* src_ = slab + (size_t)(3 + (TY)) * (SLAB / 2) + h * 128 + seg * 32;                                          \
            _Pragma("unroll") for (int j = 0; j < 4; ++j) { const bool ok = (64 * n + r - 3 + j) >= 0;     \
                _Pragma("unroll") for (int sub = 0; sub < 4; ++sub) { DST[j][sub] = *(const GAS v4u*)(src_ + (row0 + (ok ? r - 3 + j : 0)) * DM + sub * 8); } } } while (0)
          GDN_LOADRAW(raw, 0);
#pragma unroll
          for (int ty = 0; ty < 3; ++ty) {
            float val[32];
            __builtin_amdgcn_sched_barrier(0);
#pragma unroll
            for (int sub = 0; sub < 4; ++sub) {
                float a8[8];
#pragma unroll
                for (int e = 0; e < 8; ++e) a8[e] = 0.f;
#pragma unroll
                for (int j = 0; j < 4; ++j) { const bool okj = (64 * n + r - 3 + j) >= 0; v4u rw_ = raw[j][sub]; if (!okj) rw_ = (v4u){0u, 0u, 0u, 0u};
                    const f32x4 w0 = *(const LAS f32x4*)(gb + G_AQS + ((ty * 4 + j) * 128 + seg * 32 + sub * 8) * 4), w1 = *(const LAS f32x4*)(gb + G_AQS + ((ty * 4 + j) * 128 + seg * 32 + sub * 8 + 4) * 4);
                    a8[0] += w0.x * __uint_as_float(rw_.x << 16); a8[1] += w0.y * __uint_as_float(rw_.x & 0xffff0000u); a8[2] += w0.z * __uint_as_float(rw_.y << 16); a8[3] += w0.w * __uint_as_float(rw_.y & 0xffff0000u);
                    a8[4] += w1.x * __uint_as_float(rw_.z << 16); a8[5] += w1.y * __uint_as_float(rw_.z & 0xffff0000u); a8[6] += w1.z * __uint_as_float(rw_.w << 16); a8[7] += w1.w * __uint_as_float(rw_.w & 0xffff0000u); }
#pragma unroll
                for (int e = 0; e < 8; ++e) val[sub * 8 + e] = silu(a8[e]);
                asm volatile("" : "+v"(val[sub * 8 + 0]), "+v"(val[sub * 8 + 1]), "+v"(val[sub * 8 + 2]), "+v"(val[sub * 8 + 3]), "+v"(val[sub * 8 + 4]), "+v"(val[sub * 8 + 5]), "+v"(val[sub * 8 + 6]), "+v"(val[sub * 8 + 7]) :: "memory");
            }
            __builtin_amdgcn_sched_barrier(0);
            if (ty < 2) { GDN_LOADRAW(rawn, ty + 1); }
            __builtin_amdgcn_sched_barrier(0);
            if (ty < 2) { float ss = 0.f;
#pragma unroll
                for (int e = 0; e < 32; ++e) ss += val[e] * val[e];
                ss += __shfl_xor(ss, 1); ss += __shfl_xor(ss, 2);
                float sc = __builtin_amdgcn_rsqf(ss + NORM_EPS); if (ty == 0) sc *= 0.08838834764831845f;
#pragma unroll
                for (int e = 0; e < 32; ++e) val[e] *= sc; }
            LAS unsigned char* img = gb + (ty == 0 ? G_QN : ty == 1 ? G_KN : G_VC);
#pragma unroll
            for (int sub = 0; sub < 4; ++sub) { v4u o; o.x = pk2h(val[sub * 8], val[sub * 8 + 1]); o.y = pk2h(val[sub * 8 + 2], val[sub * 8 + 3]); o.z = pk2h(val[sub * 8 + 4], val[sub * 8 + 5]); o.w = pk2h(val[sub * 8 + 6], val[sub * 8 + 7]);
                *(LAS v4u*)(img + r * 256 + (((4 * seg + sub) ^ (r & 15)) << 4)) = o; }
            if (ty == 0) {
                const float f = __expf(cgr);
#pragma unroll
                for (int kb = 0; kb < 2; ++kb)
#pragma unroll
                    for (int hh = 0; hh < 2; ++hh) { const int k0 = 16 * kb + 4 * hh; v4u o; o.x = pk2h(val[k0] * f, val[k0 + 1] * f); o.y = pk2h(val[k0 + 2] * f, val[k0 + 3] * f); o.z = pk2h(val[k0 + 8] * f, val[k0 + 9] * f); o.w = pk2h(val[k0 + 10] * f, val[k0 + 11] * f);
                        const int chunk = 2 * (2 * seg + kb) + hh; *(GAS v4u*)(blk + OFF_QDEC + r * 256 + ((chunk ^ (r & 15)) << 4)) = o; } }
            if (ty == 1) {
                const float f = __expf(cgl - cgr); const int sc = kperm(r);
#pragma unroll
                for (int e = 0; e < 32; ++e) { const int d = 32 * seg + e; *(LAS bf16_t*)(gb + G_AM + d * 128 + ((((sc >> 3) ^ ((d >> 1) & 7))) << 4) + (sc & 7) * 2) = (bf16_t)pk2h(val[e] * f, 0.f); } }
            __builtin_amdgcn_sched_barrier(0);
            if (ty < 2) {
#pragma unroll
                for (int j = 0; j < 4; ++j)
#pragma unroll
                    for (int sub = 0; sub < 4; ++sub) raw[j][sub] = rawn[j][sub]; }
          }
#undef GDN_LOADRAW
        }
        __syncthreads(); PRB_E(21, PRB); PRB_B(22, PRB);
        { int tgf = tg; asm volatile("" : "+v"(tgf));
#pragma unroll
          for (int i = 0; i < 4; ++i) *(GAS v4u*)(blk + OFF_KDT + tgf * 16 + i * 4096) = *(const LAS v4u*)(gb + G_AM + tgf * 16 + i * 4096); }
        __syncthreads(); PRB_E(22, PRB); PRB_B(23, PRB);
        if (wg < 3) { const int ib = (wg + 1) >> 1, jb = wg >> 1; int ln3 = lane; asm volatile("" : "+v"(ln3)); const int r32 = ln3 & 31, hi = ln3 >> 5; const int rowA = ib * 32 + r32, rowB = jb * 32 + r32;
            f32x16 ckk, cqk;
#pragma unroll
            for (int r = 0; r < 16; ++r) { ckk[r] = 0.f; cqk[r] = 0.f; }
#pragma unroll
            for (int ks = 0; ks < 8; ++ks) {
                const bf16x8 ak = *(const LAS bf16x8*)(gb + G_KN + rowA * 256 + (((2 * ks + hi) ^ (rowA & 15)) << 4));
                const bf16x8 aq = *(const LAS bf16x8*)(gb + G_QN + rowA * 256 + (((2 * ks + hi) ^ (rowA & 15)) << 4));
                const bf16x8 bk = *(const LAS bf16x8*)(gb + G_KN + rowB * 256 + (((2 * ks + hi) ^ (rowB & 15)) << 4));
                ckk = __builtin_amdgcn_mfma_f32_32x32x16_bf16(ak, bk, ckk, 0, 0, 0); cqk = __builtin_amdgcn_mfma_f32_32x32x16_bf16(aq, bk, cqk, 0, 0, 0); }
            const int j = jb * 32 + r32; const float cgj = CG[j]; const int scj = kperm(j);
#pragma unroll
            for (int r = 0; r < 16; ++r) { const int i = ib * 32 + crow(r, hi); const float dec = __expf(fminf(CG[i] - cgj, 0.f));
                AM[i * 64 + j] = (j < i) ? BT[i] * ckk[r] * dec : 0.f;
                *(LAS bf16_t*)(gb + G_AQS + i * 128 + ((((scj >> 3) ^ ((i >> 1) & 7))) << 4) + (scj & 7) * 2) = (bf16_t)pk2h((j <= i) ? cqk[r] * dec : 0.f, 0.f); } }
        else { int l3 = lane; asm volatile("" : "+v"(l3));
#pragma unroll
            for (int i = 0; i < 8; ++i) { const int row = 4 * i + (l3 >> 4), c4 = (l3 & 15) >> 2, w = l3 & 3; *(LAS unsigned*)(gb + G_AQS + row * 128 + (((4 + c4) ^ ((row >> 1) & 7)) << 4) + w * 4) = 0u; } }
        __syncthreads(); PRB_E(23, PRB); PRB_B(24, PRB);
        { int tgf = tg; asm volatile("" : "+v"(tgf));
#pragma unroll
          for (int i = 0; i < 2; ++i) *(GAS v4u*)(blk + OFF_AQK + tgf * 16 + i * 4096) = *(const LAS v4u*)(gb + G_AQS + tgf * 16 + i * 4096); }
        if (it + G < 1024) GDN_S0LOAD(it + G);
        { const bool isw = wg >= 2; int tg5 = tg; asm volatile("" : "+v"(tg5)); const int cc = tg5 & 127; const LAS unsigned char* img = gb + (isw ? G_KN : G_VC); const LAS float* fac = isw ? FK : BT;
          float X[64];
#pragma unroll
          for (int jj = 0; jj < 64; ++jj) { const bf16_t raw = *(const LAS bf16_t*)(img + jj * 256 + ((((cc >> 3) ^ (jj & 15))) << 4) + (cc & 7) * 2); X[jj] = bf2f(raw) * fac[jj]; }
          f32x4 arow[2][16];
          arow[1][0] = *(const LAS f32x4*)(AM + 1 * 64);
#pragma unroll
          for (int i = 1; i < 64; ++i) {
              if (i + 1 < 64) {
#pragma unroll
                  for (int q = 0; q < (i + 1 + 3) / 4; ++q) arow[(i + 1) & 1][q] = *(const LAS f32x4*)(AM + (i + 1) * 64 + 4 * q); }
              __builtin_amdgcn_sched_barrier(0);
              float acc0 = X[i], acc1 = 0.f;
#pragma unroll
              for (int q = 0; q < (i + 3) / 4; ++q) { const f32x4 a4 = arow[i & 1][q]; const int j4 = 4 * q;
                  acc0 -= a4.x * X[j4]; if (j4 + 1 < i) acc1 -= a4.y * X[j4 + 1]; if (j4 + 2 < i) acc0 -= a4.z * X[j4 + 2]; if (j4 + 3 < i) acc1 -= a4.w * X[j4 + 3]; }
              X[i] = acc0 + acc1; __builtin_amdgcn_sched_barrier(0); }
          if (!isw) { const int slice = cc >> 5, c31 = cc & 31;
#pragma unroll
              for (int mt = 0; mt < 2; ++mt)
#pragma unroll
                  for (int rp = 0; rp < 8; ++rp)
#pragma unroll
                      for (int hi = 0; hi < 2; ++hi) *(GAS unsigned*)(blk + OFF_U + ((((slice * 2 + mt) * 8 + rp) * 64) + hi * 32 + c31) * 4) = pk2h(X[32 * mt + crow(2 * rp, hi)], X[32 * mt + crow(2 * rp + 1, hi)]);
          } else { const int sc = kperm(cc);
#pragma unroll
              for (int i = 0; i < 64; ++i) *(LAS bf16_t*)(gb + G_QN + i * 256 + ((((sc >> 3) ^ (i & 15))) << 4) + (sc & 7) * 2) = (bf16_t)pk2h(-X[i], 0.f); }
          if (tg5 == 0) *(GAS float*)(blk + OFF_HDR) = __expf(CG[63]);
        }
        __syncthreads(); PRB_E(24, PRB); PRB_B(25, PRB);
        { int tgf = tg; asm volatile("" : "+v"(tgf));
#pragma unroll
          for (int i = 0; i < 4; ++i) *(GAS v4u*)(blk + OFF_NEGW + tgf * 16 + i * 4096) = *(const LAS v4u*)(gb + G_QN + tgf * 16 + i * 4096); }
        __syncthreads(); PRB_E(25, PRB); PRB_E(26, PRB);
    }
#undef GDN_S0LOAD
}

__device__ __forceinline__ void glds16(const void* gsrc, unsigned lds_dst) { unsigned keep;
    asm volatile("s_mov_b32 %0, m0\n\ts_mov_b32 m0, %2\n\ts_nop 0\n\tglobal_load_lds_dwordx4 %1, off\n\ts_mov_b32 m0, %0" : "=&s"(keep) : "v"(gsrc), "s"(lds_dst) : "memory"); }
__device__ __forceinline__ bf16x8 pack8(const f32x16& v, int s) { v4u o; o.x = pk2h(v[8 * s], v[8 * s + 1]); o.y = pk2h(v[8 * s + 2], v[8 * s + 3]); o.z = pk2h(v[8 * s + 4], v[8 * s + 5]); o.w = pk2h(v[8 * s + 6], v[8 * s + 7]); return __builtin_bit_cast(bf16x8, o); }
#define GDN_WAITL(n) asm volatile("s_waitcnt lgkmcnt(" #n ")" ::: "memory")
#define GDN_SBAR() __builtin_amdgcn_sched_barrier(0)
__device__ __forceinline__ void scan(unsigned char* lds_generic, int tid, int bh, const unsigned char* r2, bf16_t* OB) {
    const int lane = tid & 63; const int wave = __builtin_amdgcn_readfirstlane(tid >> 6);
    const int h = bh & 7, b = bh >> 3;
    const unsigned char* blk0 = r2 + (size_t)bh * 128 * BLK;
    const unsigned lds0 = (unsigned)(uintptr_t)lds_generic;
    const LAS unsigned char* L = (const LAS unsigned char*)lds_generic;
#define GDN_DMA(n, buf) do { const unsigned char* gsrc_ = blk0 + (size_t)(n) * BLK + lane * 16; _Pragma("unroll") for (int i_ = 0; i_ < 10; ++i_) { const int p_ = wave + 8 * i_; if (p_ < 74) glds16(gsrc_ + p_ * 1024, (unsigned)__builtin_amdgcn_readfirstlane(lds0 + (buf) * BLK + p_ * 1024)); } } while (0)
    f32x16 S[4];
    { float zz; asm volatile("v_mov_b32 %0, 0" : "=v"(zz));
#pragma unroll
      for (int kt = 0; kt < 4; ++kt)
#pragma unroll
          for (int r = 0; r < 16; ++r) S[kt][r] = zz; }
    GDN_DMA(0, 0);
    asm volatile("s_waitcnt vmcnt(0) lgkmcnt(0)\n\ts_barrier" ::: "memory");
    for (int n = 0; n < 128; ++n) {
        const int buf = n & 1;
        if (n + 1 < 128) GDN_DMA(n + 1, buf ^ 1);
        if (wave < 4) {
            int lnc = lane; asm volatile("" : "+v"(lnc)); const int r32 = lnc & 31, hi = lnc >> 5;
            const int base = (int)(lds0 + buf * BLK);
            const float gl = *(const LAS float*)(L + buf * BLK + OFF_HDR);
            bf16x8 Sb[4][2];
#pragma unroll
            for (int kt = 0; kt < 4; ++kt) { Sb[kt][0] = pack8(S[kt], 0); Sb[kt][1] = pack8(S[kt], 1); }
            f32x16 av[2], ao[2];
#pragma unroll
            for (int mt = 0; mt < 2; ++mt) {
#pragma unroll
                for (int rp = 0; rp < 8; ++rp) { const unsigned w = *(const LAS unsigned*)(L + buf * BLK + OFF_U + ((((wave * 2 + mt) * 8 + rp) * 64) + lnc) * 4); av[mt][2 * rp] = __uint_as_float(w << 16); av[mt][2 * rp + 1] = __uint_as_float(w & 0xffff0000u); }
#pragma unroll
                for (int r = 0; r < 16; ++r) ao[mt][r] = 0.f; }
            const int a8_0 = base + r32 * 256 + (((0 + hi) ^ (r32 & 15)) << 4), a8_1 = base + r32 * 256 + (((2 + hi) ^ (r32 & 15)) << 4), a8_2 = base + r32 * 256 + (((4 + hi) ^ (r32 & 15)) << 4), a8_3 = base + r32 * 256 + (((6 + hi) ^ (r32 & 15)) << 4),
                      a8_4 = base + r32 * 256 + (((8 + hi) ^ (r32 & 15)) << 4), a8_5 = base + r32 * 256 + (((10 + hi) ^ (r32 & 15)) << 4), a8_6 = base + r32 * 256 + (((12 + hi) ^ (r32 & 15)) << 4), a8_7 = base + r32 * 256 + (((14 + hi) ^ (r32 & 15)) << 4);
            const int a4_0 = base + r32 * 128 + (((0 + hi) ^ ((r32 >> 1) & 7)) << 4), a4_1 = base + r32 * 128 + (((2 + hi) ^ ((r32 >> 1) & 7)) << 4), a4_2 = base + r32 * 128 + (((4 + hi) ^ ((r32 >> 1) & 7)) << 4), a4_3 = base + r32 * 128 + (((6 + hi) ^ ((r32 >> 1) & 7)) << 4);
            bf16x8 Vb[2][2]; bf16x8 f0, f1, f2, f3, f4;
            asm volatile("s_waitcnt lgkmcnt(0)" ::: "memory"); GDN_SBAR();
#define GDN_RDA(F, A, OFF) asm volatile("ds_read_b128 %0,%1 offset:%c2" : "=&v"(F) : "v"(A), "i"(OFF) : "memory")
            GDN_RDA(f0, a8_0, OFF_NEGW + 0); GDN_RDA(f1, a8_0, OFF_QDEC + 0); GDN_RDA(f2, a8_1, OFF_NEGW + 0); GDN_RDA(f3, a8_1, OFF_QDEC + 0);
            GDN_RDA(f4, a8_2, OFF_NEGW + 0); GDN_WAITL(4); GDN_SBAR(); av[0] = __builtin_amdgcn_mfma_f32_32x32x16_bf16(f0, Sb[0][0], av[0], 0, 0, 0);
            GDN_RDA(f0, a8_2, OFF_QDEC + 0); GDN_WAITL(4); GDN_SBAR(); ao[0] = __builtin_amdgcn_mfma_f32_32x32x16_bf16(f1, Sb[0][0], ao[0], 0, 0, 0);
            GDN_RDA(f1, a8_3, OFF_NEGW + 0); GDN_WAITL(4); GDN_SBAR(); av[0] = __builtin_amdgcn_mfma_f32_32x32x16_bf16(f2, Sb[0][1], av[0], 0, 0, 0);
            GDN_RDA(f2, a8_3, OFF_QDEC + 0); GDN_WAITL(4); GDN_SBAR(); ao[0] = __builtin_amdgcn_mfma_f32_32x32x16_bf16(f3, Sb[0][1], ao[0], 0, 0, 0);
            GDN_RDA(f3, a8_4, OFF_NEGW + 0); GDN_WAITL(4); GDN_SBAR(); av[0] = __builtin_amdgcn_mfma_f32_32x32x16_bf16(f4, Sb[1][0], av[0], 0, 0, 0);
            GDN_RDA(f4, a8_4, OFF_QDEC + 0); GDN_WAITL(4); GDN_SBAR(); ao[0] = __builtin_amdgcn_mfma_f32_32x32x16_bf16(f0, Sb[1][0], ao[0], 0, 0, 0);
            GDN_RDA(f0, a8_5, OFF_NEGW + 0); GDN_WAITL(4); GDN_SBAR(); av[0] = __builtin_amdgcn_mfma_f32_32x32x16_bf16(f1, Sb[1][1], av[0], 0, 0, 0);
            GDN_RDA(f1, a8_5, OFF_QDEC + 0); GDN_WAITL(4); GDN_SBAR(); ao[0] = __builtin_amdgcn_mfma_f32_32x32x16_bf16(f2, Sb[1][1], ao[0], 0, 0, 0);
            GDN_RDA(f2, a8_6, OFF_NEGW + 0); GDN_WAITL(4); GDN_SBAR(); av[0] = __builtin_amdgcn_mfma_f32_32x32x16_bf16(f3, Sb[2][0], av[0], 0, 0, 0);
            GDN_RDA(f3, a8_6, OFF_QDEC + 0); GDN_WAITL(4); GDN_SBAR(); ao[0] = __builtin_amdgcn_mfma_f32_32x32x16_bf16(f4, Sb[2][0], ao[0], 0, 0, 0);
            GDN_RDA(f4, a8_7, OFF_NEGW + 0); GDN_WAITL(4); GDN_SBAR(); av[0] = __builtin_amdgcn_mfma_f32_32x32x16_bf16(f0, Sb[2][1], av[0], 0, 0, 0);
            GDN_RDA(f0, a8_7, OFF_QDEC + 0); GDN_WAITL(4); GDN_SBAR(); ao[0] = __builtin_amdgcn_mfma_f32_32x32x16_bf16(f1, Sb[2][1], ao[0], 0, 0, 0);
            GDN_RDA(f1, a8_0, OFF_NEGW + 8192); GDN_WAITL(4); GDN_SBAR(); av[0] = __builtin_amdgcn_mfma_f32_32x32x16_bf16(f2, Sb[3][0], av[0], 0, 0, 0);
            GDN_RDA(f2, a8_0, OFF_QDEC + 8192); GDN_WAITL(4); GDN_SBAR(); ao[0] = __builtin_amdgcn_mfma_f32_32x32x16_bf16(f3, Sb[3][0], ao[0], 0, 0, 0);
            GDN_RDA(f3, a8_1, OFF_NEGW + 8192); GDN_WAITL(4); GDN_SBAR(); av[0] = __builtin_amdgcn_mfma_f32_32x32x16_bf16(f4, Sb[3][1], av[0], 0, 0, 0);
            GDN_RDA(f4, a8_1, OFF_QDEC + 8192); GDN_WAITL(4); GDN_SBAR(); ao[0] = __builtin_amdgcn_mfma_f32_32x32x16_bf16(f0, Sb[3][1], ao[0], 0, 0, 0);
            GDN_RDA(f0, a8_2, OFF_NEGW + 8192); GDN_WAITL(4); GDN_SBAR(); av[1] = __builtin_amdgcn_mfma_f32_32x32x16_bf16(f1, Sb[0][0], av[1], 0, 0, 0);
            GDN_RDA(f1, a8_2, OFF_QDEC + 8192); GDN_WAITL(4); GDN_SBAR(); ao[1] = __builtin_amdgcn_mfma_f32_32x32x16_bf16(f2, Sb[0][0], ao[1], 0, 0, 0);
            GDN_RDA(f2, a8_3, OFF_NEGW + 8192); GDN_WAITL(4); GDN_SBAR(); av[1] = __builtin_amdgcn_mfma_f32_32x32x16_bf16(f3, Sb[0][1], av[1], 0, 0, 0);
            GDN_RDA(f3, a8_3, OFF_QDEC + 8192); GDN_WAITL(4); GDN_SBAR(); ao[1] = __builtin_amdgcn_mfma_f32_32x32x16_bf16(f4, Sb[0][1], ao[1], 0, 0, 0);
            GDN_RDA(f4, a8_4, OFF_NEGW + 8192); GDN_WAITL(4); GDN_SBAR(); av[1] = __builtin_amdgcn_mfma_f32_32x32x16_bf16(f0, Sb[1][0], av[1], 0, 0, 0);
            GDN_RDA(f0, a8_4, OFF_QDEC + 8192); GDN_WAITL(4); GDN_SBAR(); ao[1] = __builtin_amdgcn_mfma_f32_32x32x16_bf16(f1, Sb[1][0], ao[1], 0, 0, 0);
            GDN_RDA(f1, a8_5, OFF_NEGW + 8192); GDN_WAITL(4); GDN_SBAR(); av[1] = __builtin_amdgcn_mfma_f32_32x32x16_bf16(f2, Sb[1][1], av[1], 0, 0, 0);
            GDN_RDA(f2, a8_5, OFF_QDEC + 8192); GDN_WAITL(4); GDN_SBAR(); ao[1] = __builtin_amdgcn_mfma_f32_32x32x16_bf16(f3, Sb[1][1], ao[1], 0, 0, 0);
            GDN_RDA(f3, a8_6, OFF_NEGW + 8192); GDN_WAITL(4); GDN_SBAR(); av[1] = __builtin_amdgcn_mfma_f32_32x32x16_bf16(f4, Sb[2][0], av[1], 0, 0, 0);
            GDN_RDA(f4, a8_6, OFF_QDEC + 8192); GDN_WAITL(4); GDN_SBAR(); ao[1] = __builtin_amdgcn_mfma_f32_32x32x16_bf16(f0, Sb[2][0], ao[1], 0, 0, 0);
            GDN_RDA(f0, a8_7, OFF_NEGW + 8192); GDN_WAITL(4); GDN_SBAR(); av[1] = __builtin_amdgcn_mfma_f32_32x32x16_bf16(f1, Sb[2][1], av[1], 0, 0, 0);
            GDN_RDA(f1, a8_7, OFF_QDEC + 8192); GDN_WAITL(4); GDN_SBAR(); ao[1] = __builtin_amdgcn_mfma_f32_32x32x16_bf16(f2, Sb[2][1], ao[1], 0, 0, 0);
            GDN_RDA(f2, a4_0, OFF_AQK + 0); GDN_WAITL(4); GDN_SBAR(); av[1] = __builtin_amdgcn_mfma_f32_32x32x16_bf16(f3, Sb[3][0], av[1], 0, 0, 0);
            GDN_RDA(f3, a4_1, OFF_AQK + 0); GDN_WAITL(4); GDN_SBAR(); ao[1] = __builtin_amdgcn_mfma_f32_32x32x16_bf16(f4, Sb[3][0], ao[1], 0, 0, 0);
            GDN_RDA(f4, a4_0, OFF_AQK + 4096); GDN_WAITL(4); GDN_SBAR(); av[1] = __builtin_amdgcn_mfma_f32_32x32x16_bf16(f0, Sb[3][1], av[1], 0, 0, 0);
            GDN_RDA(f0, a4_1, OFF_AQK + 4096); GDN_WAITL(4); GDN_SBAR(); ao[1] = __builtin_amdgcn_mfma_f32_32x32x16_bf16(f1, Sb[3][1], ao[1], 0, 0, 0);
            Vb[0][0] = pack8(av[0], 0); Vb[0][1] = pack8(av[0], 1); Vb[1][0] = pack8(av[1], 0); Vb[1][1] = pack8(av[1], 1);
            GDN_RDA(f1, a4_2, OFF_AQK + 4096); GDN_WAITL(4); GDN_SBAR(); ao[0] = __builtin_amdgcn_mfma_f32_32x32x16_bf16(f2, Vb[0][0], ao[0], 0, 0, 0);
            GDN_RDA(f2, a4_3, OFF_AQK + 4096); GDN_WAITL(4); GDN_SBAR(); ao[0] = __builtin_amdgcn_mfma_f32_32x32x16_bf16(f3, Vb[0][1], ao[0], 0, 0, 0);
            GDN_RDA(f3, a4_0, OFF_KDT + 0); GDN_WAITL(4); GDN_SBAR(); ao[1] = __builtin_amdgcn_mfma_f32_32x32x16_bf16(f4, Vb[0][0], ao[1], 0, 0, 0);
            GDN_RDA(f4, a4_1, OFF_KDT + 0); GDN_WAITL(4); GDN_SBAR(); ao[1] = __builtin_amdgcn_mfma_f32_32x32x16_bf16(f0, Vb[0][1], ao[1], 0, 0, 0);
            GDN_RDA(f0, a4_2, OFF_KDT + 0); GDN_WAITL(4); GDN_SBAR(); ao[1] = __builtin_amdgcn_mfma_f32_32x32x16_bf16(f1, Vb[1][0], ao[1], 0, 0, 0);
            GDN_RDA(f1, a4_3, OFF_KDT + 0); GDN_WAITL(4); GDN_SBAR(); ao[1] = __builtin_amdgcn_mfma_f32_32x32x16_bf16(f2, Vb[1][1], ao[1], 0, 0, 0);
            { bf16_t* op = OB + ((size_t)b * SEQ + 64 * n) * DM + h * 128 + 32 * wave + r32;
#pragma unroll
              for (int mt = 0; mt < 2; ++mt)
#pragma unroll
                  for (int r = 0; r < 16; ++r) *(GAS bf16_t*)(op + (size_t)(32 * mt + crow(r, hi)) * DM) = (bf16_t)pk2h(ao[mt][r], 0.f); }
            S[0] = S[0] * gl; S[1] = S[1] * gl; S[2] = S[2] * gl; S[3] = S[3] * gl;
            GDN_RDA(f2, a4_0, OFF_KDT + 4096); GDN_WAITL(4); GDN_SBAR(); S[0] = __builtin_amdgcn_mfma_f32_32x32x16_bf16(f3, Vb[0][0], S[0], 0, 0, 0);
            GDN_RDA(f3, a4_1, OFF_KDT + 4096); GDN_WAITL(4); GDN_SBAR(); S[0] = __builtin_amdgcn_mfma_f32_32x32x16_bf16(f4, Vb[0][1], S[0], 0, 0, 0);
            GDN_RDA(f4, a4_2, OFF_KDT + 4096); GDN_WAITL(4); GDN_SBAR(); S[0] = __builtin_amdgcn_mfma_f32_32x32x16_bf16(f0, Vb[1][0], S[0], 0, 0, 0);
            GDN_RDA(f0, a4_3, OFF_KDT + 4096); GDN_WAITL(4); GDN_SBAR(); S[0] = __builtin_amdgcn_mfma_f32_32x32x16_bf16(f1, Vb[1][1], S[0], 0, 0, 0);
            GDN_RDA(f1, a4_0, OFF_KDT + 8192); GDN_WAITL(4); GDN_SBAR(); S[1] = __builtin_amdgcn_mfma_f32_32x32x16_bf16(f2, Vb[0][0], S[1], 0, 0, 0);
            GDN_RDA(f2, a4_1, OFF_KDT + 8192); GDN_WAITL(4); GDN_SBAR(); S[1] = __builtin_amdgcn_mfma_f32_32x32x16_bf16(f3, Vb[0][1], S[1], 0, 0, 0);
            GDN_RDA(f3, a4_2, OFF_KDT + 8192); GDN_WAITL(4); GDN_SBAR(); S[1] = __builtin_amdgcn_mfma_f32_32x32x16_bf16(f4, Vb[1][0], S[1], 0, 0, 0);
            GDN_RDA(f4, a4_3, OFF_KDT + 8192); GDN_WAITL(4); GDN_SBAR(); S[1] = __builtin_amdgcn_mfma_f32_32x32x16_bf16(f0, Vb[1][1], S[1], 0, 0, 0);
            GDN_RDA(f0, a4_0, OFF_KDT + 12288); GDN_WAITL(4); GDN_SBAR(); S[2] = __builtin_amdgcn_mfma_f32_32x32x16_bf16(f1, Vb[0][0], S[2], 0, 0, 0);
            GDN_RDA(f1, a4_1, OFF_KDT + 12288); GDN_WAITL(4); GDN_SBAR(); S[2] = __builtin_amdgcn_mfma_f32_32x32x16_bf16(f2, Vb[0][1], S[2], 0, 0, 0);
            GDN_RDA(f2, a4_2, OFF_KDT + 12288); GDN_WAITL(4); GDN_SBAR(); S[2] = __builtin_amdgcn_mfma_f32_32x32x16_bf16(f3, Vb[1][0], S[2], 0, 0, 0);
            GDN_RDA(f3, a4_3, OFF_KDT + 12288); GDN_WAITL(4); GDN_SBAR(); S[2] = __builtin_amdgcn_mfma_f32_32x32x16_bf16(f4, Vb[1][1], S[2], 0, 0, 0);
            GDN_WAITL(3); GDN_SBAR(); S[3] = __builtin_amdgcn_mfma_f32_32x32x16_bf16(f0, Vb[0][0], S[3], 0, 0, 0);
            GDN_WAITL(2); GDN_SBAR(); S[3] = __builtin_amdgcn_mfma_f32_32x32x16_bf16(f1, Vb[0][1], S[3], 0, 0, 0);
            GDN_WAITL(1); GDN_SBAR(); S[3] = __builtin_amdgcn_mfma_f32_32x32x16_bf16(f2, Vb[1][0], S[3], 0, 0, 0);
            GDN_WAITL(0); GDN_SBAR(); S[3] = __builtin_amdgcn_mfma_f32_32x32x16_bf16(f3, Vb[1][1], S[3], 0, 0, 0);
#undef GDN_RDA
        }
        asm volatile("s_waitcnt vmcnt(0) lgkmcnt(0)\n\ts_barrier" ::: "memory");
    }
#undef GDN_DMA
}
}

constexpr int NWAVES = 8;
constexpr int RING_OFF = 0, RING_BYTES = 152576;
constexpr int LDSCTL_OFF = RING_BYTES, MISC_OFF = LDSCTL_OFF + 320;
constexpr int LDS_BYTES = 153600;
constexpr int NPHASE = 11;

#define FTID (tid_now((const void*)(uintptr_t)(unsigned)(uintptr_t)F.lds))
struct Frame {
    LAS unsigned char* lds;
    volatile LAS unsigned* MISC;
    gu32* ctl;
    int vcu, G;
    unsigned char* ws; float* out;
};
typedef unsigned v2u __attribute__((ext_vector_type(2)));

template <class ColMap>
__device__ __forceinline__ void transpose_item(const float* W, int ldw, bf16* WT, int dst_row0, int k0, const ColMap& cm, LAS float* scr, int lane) {
    const int n4 = (lane & 7) * 4, kr = lane >> 3; const int sc = cm(dst_row0 + n4);
    f32x4 v[8];
#pragma unroll
    for (int i = 0; i < 8; ++i) v[i] = *(const GAS f32x4*)(W + (size_t)(k0 + kr + 8 * i) * ldw + sc);
#pragma unroll
    for (int i = 0; i < 8; ++i) { const int kk = kr + 8 * i; scr[(n4 + 0) * 65 + kk] = v[i].x; scr[(n4 + 1) * 65 + kk] = v[i].y; scr[(n4 + 2) * 65 + kk] = v[i].z; scr[(n4 + 3) * 65 + kk] = v[i].w; }
    LDS_WAIT(); asm volatile("" ::: "memory");
    const int c = lane & 7;
#pragma unroll
    for (int j = 0; j < 4; ++j) { const int nn = (lane >> 3) + 8 * j; const LAS float* s = scr + nn * 65 + 8 * c;
        v4u o; o.x = pk2(s[0], s[1]); o.y = pk2(s[2], s[3]); o.z = pk2(s[4], s[5]); o.w = pk2(s[6], s[7]);
        *(GAS v4u*)(WT + (size_t)(dst_row0 + nn) * DM + k0 + 8 * c) = o; }
    LDS_WAIT(); asm volatile("" ::: "memory");
}
struct CmIdent { __device__ __forceinline__ int operator()(int r) const { return r; } };
struct CmWin {
    __device__ __forceinline__ int operator()(int R) const {
        const int pn = R >> 8, tc = R & 255;
        if (pn < 8) { const int bj = tc >> 7, wc = (tc >> 5) & 3, fq = (tc >> 3) & 3, n = (tc >> 2) & 1, e = tc & 3; return 256 * pn + 64 * (2 * bj + (wc >> 1)) + 32 * n + 16 * (wc & 1) + 4 * fq + e; }
        return (R < 7168) ? R : R + 16;
    }
};
struct CmOff { int off; __device__ __forceinline__ int operator()(int r) const { return r + off; } };

__device__ __forceinline__ void p0_prologue(Frame& F, const float* x, const float* mix_g, const float* w_in, const float* w_out, const float* a_log, const float* dt_bias) {
    int tid_ = FTID; asm volatile("" : "+v"(tid_)); const int lane_ = tid_ & 63; const int wave_ = __builtin_amdgcn_readfirstlane(tid_ >> 6); (void)lane_; (void)wave_;
    LAS float* scr = (LAS float*)(F.lds + RING_OFF + wave_ * 16384);
    const int gw = F.vcu * NWAVES + wave_, NGW = F.G * NWAVES;
    bf16* Win_t = (bf16*)((unsigned char*)F.out + 32 * MiB); bf16* Wout_t = (bf16*)(F.ws + WS_WOUT); bf16* XN = (bf16*)F.out;
    constexpr int I_IN = (9216 / 32) * 16, I_OUT = (1024 / 32) * 16;
    for (int it = gw; it < I_IN + I_OUT; it += NGW) {
        if (it < I_IN) transpose_item(w_in, IN_DIM, Win_t, 32 * (it >> 4), 64 * (it & 15), CmWin(), scr, lane_);
        else { const int r = it - I_IN; transpose_item(w_out, DM, Wout_t, 32 * (r >> 4), 64 * (r & 15), CmIdent(), scr, lane_); }
    }
    float* rope = (float*)(F.ws + WS_ROPE);
    for (int idx = (F.vcu * NWAVES + wave_) * 64 + lane_; idx < SEQ * 32; idx += NGW * 64) { const int pos = idx >> 5, i = idx & 31;
        const float inv_freq = 1.0f / powf(10000.0f, (float)(2 * i) / 64.0f); const float ang = (float)pos * inv_freq; rope[idx] = cosf(ang); rope[SEQ * 32 + idx] = sinf(ang); }
    __syncthreads();
    LAS float* w16 = (LAS float*)(F.lds + RING_OFF);
    { f32x4 t[8];
#pragma unroll
      for (int i = 0; i < 8; ++i) { const int i4 = tid_ + 512 * i; t[i] = *(const GAS f32x4*)(w_in + (size_t)(i4 >> 2) * IN_DIM + 7168 + (i4 & 3) * 4); }
#pragma unroll
      for (int i = 0; i < 8; ++i) { const int i4 = tid_ + 512 * i; const int k = i4 >> 2, e0 = (i4 & 3) * 4;
          w16[(e0 + 0) * 1028 + k] = t[i].x; w16[(e0 + 1) * 1028 + k] = t[i].y; w16[(e0 + 2) * 1028 + k] = t[i].z; w16[(e0 + 3) * 1028 + k] = t[i].w; } }
    __syncthreads();
    float* bg = (float*)(F.ws + WS_BG);
    const int me = (lane_ >> 2) & 15;
    const float mydt = dt_bias[me & 7], myal = a_log[me & 7];
    f32x4 vnext[4];
    if (gw < T_) { const GAS f32x4* x0 = (const GAS f32x4*)(x + (size_t)gw * DM) + lane_;
#pragma unroll
        for (int j = 0; j < 4; ++j) vnext[j] = x0[64 * j]; }
#pragma unroll 1
    for (int m = gw; m < T_; m += NGW) {
        f32x4 v[4]; float s = 0.f;
#pragma unroll
        for (int j = 0; j < 4; ++j) v[j] = vnext[j];
        { const int mn = (m + NGW < T_) ? m + NGW : m; const GAS f32x4* xn = (const GAS f32x4*)(x + (size_t)mn * DM) + lane_;
#pragma unroll
          for (int j = 0; j < 4; ++j) vnext[j] = xn[64 * j]; }
#pragma unroll
        for (int j = 0; j < 4; ++j) s += (v[j].x * v[j].x + v[j].y * v[j].y) + (v[j].z * v[j].z + v[j].w * v[j].w);
        s = wave_sum(s);
        const float rstd = 1.0f / sqrtf(s * (1.0f / DM) + NORM_EPS);
        GAS unsigned long long* o8 = (GAS unsigned long long*)(XN + (size_t)m * DM) + lane_;
#pragma unroll
        for (int j = 0; j < 4; ++j) { const f32x4 gg = ((const GAS f32x4*)mix_g)[lane_ + 64 * j]; v[j] = v[j] * rstd * gg;
            o8[64 * j] = (unsigned long long)pk2(v[j].x, v[j].y) | ((unsigned long long)pk2(v[j].z, v[j].w) << 32); }
        float a16[16];
#pragma unroll
        for (int e = 0; e < 16; ++e) { f32x2 a2 = {0.f, 0.f};
#pragma unroll
            for (int j = 0; j < 4; ++j) { const f32x4 w4 = *(const LAS f32x4*)(w16 + e * 1028 + 4 * (lane_ + 64 * j)); a2 += (f32x2){v[j].x, v[j].y} * (f32x2){w4.x, w4.y}; a2 += (f32x2){v[j].z, v[j].w} * (f32x2){w4.z, w4.w}; }
            a16[e] = a2.x + a2.y; if ((e & 3) == 3) __builtin_amdgcn_sched_barrier(0); }
        float r8[8], r4[4], r2[2];
        { const bool up = (lane_ & 32) != 0;
#pragma unroll
          for (int e = 0; e < 8; ++e) { const float send = up ? a16[e] : a16[e + 8], keep = up ? a16[e + 8] : a16[e]; r8[e] = keep + __shfl_xor(send, 32); } }
        { const bool up = (lane_ & 16) != 0;
#pragma unroll
          for (int e = 0; e < 4; ++e) { const float send = up ? r8[e] : r8[e + 4], keep = up ? r8[e + 4] : r8[e]; r4[e] = keep + __shfl_xor(send, 16); } }
        { const bool up = (lane_ & 8) != 0;
#pragma unroll
          for (int e = 0; e < 2; ++e) { const float send = up ? r4[e] : r4[e + 2], keep = up ? r4[e + 2] : r4[e]; r2[e] = keep + __shfl_xor(send, 8); } }
        float val; { const bool up = (lane_ & 4) != 0; const float send = up ? r2[0] : r2[1], keep = up ? r2[1] : r2[0]; val = keep + __shfl_xor(send, 4); }
        val += __shfl_xor(val, 2); val += __shfl_xor(val, 1);
        float res;
        if (me < 8) res = 1.0f / (1.0f + expf(-val));
        else { const float z = val + mydt; const float sp = (z > 20.f) ? z : log1pf(expf(z)); res = -expf(myal) * sp; }
        if ((lane_ & 3) == 0) bg[(size_t)m * 16 + me] = res;
    }
    __syncthreads();
}

__device__ __forceinline__ int dequeue(Frame& F, int qword) {
    if (FTID == 0) F.MISC[16] = __hip_atomic_fetch_add(F.ctl + qword, 1u, __ATOMIC_RELAXED, __HIP_MEMORY_SCOPE_AGENT);
    __syncthreads();
    const int idx = __builtin_amdgcn_readfirstlane((int)F.MISC[16]);
    __syncthreads();
    return idx;
}
__device__ __forceinline__ void p2_scans(Frame& F, unsigned char* lds_generic, int qbase) {
    bf16* OB = (bf16*)(F.ws + WS_SLAB) + 3 * (SLAB / 2);
    const int x = (int)(xb_xcc_id() & 7u);
    for (int qi = 0; qi < 8; ++qi) {
        const int q = (x + qi) & 7;
        for (;;) { const int idx = dequeue(F, qbase + 64 * (8 + q)); if (idx >= 2) break; gdn::scan(lds_generic + RING_OFF, FTID, 2 * q + idx, F.ws + WS_R2, OB); }
    }
}
__device__ __forceinline__ void p2_attention(Frame& F, unsigned char* lds_generic, int qbase) {
    const bf16* QA = (const bf16*)(F.ws + WS_SLAB); const bf16* KA = QA + (SLAB / 2); const bf16* VA = KA + (SLAB / 2);
    bf16* O1 = (bf16*)F.out;
    const int x = (int)(xb_xcc_id() & 7u);
    for (int qi = 0; qi < 8; ++qi) {
        const int q = (x + qi) & 7;
        for (;;) {
            const int u = dequeue(F, qbase + 64 * q);
            if (u >= 128) break;
            const int bh = 2 * q + (u >> 6), rem = u & 63; const int qb = 31 - (rem >> 1), c = rem & 1; const int b = bh >> 3, h = bh & 7;
            attn128::unit4<8>(b, 2 * h + c, 2 * h, qb, (const attn_body::bf16*)QA, (const attn_body::bf16*)KA, (const attn_body::bf16*)VA, (attn_body::bf16*)(O1 + (size_t)c * T_ * DM), (char*)lds_generic + RING_OFF, F.MISC + 24);
        }
    }
}

__device__ __forceinline__ void p2b_merge(Frame& F, const float* lq1, const float* lk1, const float* lq2, const float* lk2, const float* subln_g, const float* gdn_g) {
    int tid_ = FTID; asm volatile("" : "+v"(tid_)); const int lane_ = tid_ & 63; const int wave_ = __builtin_amdgcn_readfirstlane(tid_ >> 6); (void)lane_; (void)wave_;
    const bf16* O1 = (const bf16*)F.out; const bf16* O2 = O1 + (size_t)T_ * DM;
    bf16* slab = (bf16*)(F.ws + WS_SLAB); bf16* MG = slab; const bf16* OB = slab + 3 * (SLAB / 2); const bf16* GZ = slab + 6 * (SLAB / 2); const bf16* GA = slab + 7 * (SLAB / 2); const bf16* GB = slab + 8 * (SLAB / 2);
    const int gw = F.vcu * NWAVES + wave_, NGW = F.G * NWAVES, lane = lane_;
    const float lam = expf(wave_sum(lq1[lane] * lk1[lane])) - expf(wave_sum(lq2[lane] * lk2[lane])) + 0.2f;
    const float sg0 = subln_g[2 * lane] * 0.8f, sg1 = subln_g[2 * lane + 1] * 0.8f, gg0 = gdn_g[2 * lane], gg1 = gdn_g[2 * lane + 1];
#pragma unroll 1
    for (int row = gw; row < T_; row += NGW) {
        unsigned u1[8], u2[8], ub[8], uz[8], ua[8], ugb[8];
#pragma unroll
        for (int h = 0; h < 8; ++h) { const size_t off = (size_t)row * DM + h * 128 + 2 * lane;
            u1[h] = *(const GAS unsigned*)(O1 + off); u2[h] = *(const GAS unsigned*)(O2 + off); ub[h] = *(const GAS unsigned*)(OB + off); uz[h] = *(const GAS unsigned*)(GZ + off); ua[h] = *(const GAS unsigned*)(GA + off); ugb[h] = *(const GAS unsigned*)(GB + off); }
#pragma unroll
        for (int h = 0; h < 8; ++h) { const size_t off = (size_t)row * DM + h * 128 + 2 * lane;
            const float d0 = __uint_as_float(u1[h] << 16) - lam * __uint_as_float(u2[h] << 16), d1 = __uint_as_float(u1[h] & 0xffff0000u) - lam * __uint_as_float(u2[h] & 0xffff0000u);
            const float ra = __builtin_amdgcn_rsqf(wave_sum(d0 * d0 + d1 * d1) * (1.0f / 128.0f) + NORM_EPS);
            const float ya0 = d0 * ra * sg0, ya1 = d1 * ra * sg1;
            const float b0 = __uint_as_float(ub[h] << 16), b1 = __uint_as_float(ub[h] & 0xffff0000u);
            const float rb = __builtin_amdgcn_rsqf(wave_sum(b0 * b0 + b1 * b1) * (1.0f / 128.0f) + NORM_EPS);
            const float z0 = __uint_as_float(uz[h] << 16), z1 = __uint_as_float(uz[h] & 0xffff0000u);
            const float yb0 = b0 * rb * gg0 * (z0 * sigmoidf_(z0)), yb1 = b1 * rb * gg1 * (z1 * sigmoidf_(z1));
            const float m0 = sigmoidf_(__uint_as_float(ua[h] << 16)) * ya0 + sigmoidf_(__uint_as_float(ugb[h] << 16)) * yb0;
            const float m1 = sigmoidf_(__uint_as_float(ua[h] & 0xffff0000u)) * ya1 + sigmoidf_(__uint_as_float(ugb[h] & 0xffff0000u)) * yb1;
            *(GAS unsigned*)(MG + off) = pk2(m0, m1); }
    }
}

__device__ __forceinline__ void p3b_router(Frame& F, const float* g2, const float* rw, const float* rb, bool lists) {
    int tid_ = FTID; asm volatile("" : "+v"(tid_)); const int lane = tid_ & 63; const int wave_ = __builtin_amdgcn_readfirstlane(tid_ >> 6);
    const float* x1 = F.out; bf16* H2 = (bf16*)(F.ws + WS_H2); int* tope = (int*)(F.ws + WS_TOPE); float* topw = (float*)(F.ws + WS_TOPW); int* cnt = (int*)(F.ws + WS_CTL) + CW_CNT; int* list = (int*)(F.ws + WS_LIST);
    LAS float* rwT = (LAS float*)(F.lds + RING_OFF);
    {
        const GAS f32x4* rw4 = (const GAS f32x4*)rw;
#pragma unroll 1
        for (int b0 = 0; b0 < 16; b0 += 8) { f32x4 t[8];
#pragma unroll
            for (int i = 0; i < 8; ++i) t[i] = rw4[tid_ + 512 * (b0 + i)];
#pragma unroll
            for (int i = 0; i < 8; ++i) { const int i4 = tid_ + 512 * (b0 + i); const int k = i4 >> 3, e0 = (i4 & 7) * 4;
                rwT[(e0 + 0) * 1028 + k] = t[i].x; rwT[(e0 + 1) * 1028 + k] = t[i].y; rwT[(e0 + 2) * 1028 + k] = t[i].z; rwT[(e0 + 3) * 1028 + k] = t[i].w; } } }
    __syncthreads();
    const int gw = F.vcu * NWAVES + wave_, NGW = F.G * NWAVES;
    const float myb = rb[(lane >> 1) & 31];
    LAS int* lcnt = (LAS int*)(F.lds + RING_OFF + 131584); LAS int* gbase = lcnt + 32; LAS int* rec = lcnt + 64;
    for (int rowb = gw; rowb < T_; rowb += 8 * NGW) {
        if (tid_ < 32) lcnt[tid_] = 0;
        __syncthreads();
        f32x4 vnA[4], vnB[4];
        { const GAS f32x4* x0 = (const GAS f32x4*)(x1 + (size_t)rowb * DM); const int rb1 = (rowb + NGW < T_) ? rowb + NGW : rowb; const GAS f32x4* x1p = (const GAS f32x4*)(x1 + (size_t)rb1 * DM);
#pragma unroll
          for (int j = 0; j < 4; ++j) { vnA[j] = x0[lane + 64 * j]; vnB[j] = x1p[lane + 64 * j]; } }
#pragma unroll 1
        for (int it = 0; it < 8; it += 2) { const int rowA = rowb + it * NGW; if (rowA >= T_) break;
        const bool hasB = rowA + NGW < T_; const int rowB = hasB ? rowA + NGW : rowA;
        f32x4 vA[4], vB[4]; float sA = 0.f, sB = 0.f;
#pragma unroll
        for (int j = 0; j < 4; ++j) { vA[j] = vnA[j]; vB[j] = vnB[j]; }
        { int ra = rowA + 2 * NGW, rb_ = rowA + 3 * NGW; if (!(ra < T_ && it + 2 < 8)) ra = rowA; if (!(rb_ < T_ && it + 2 < 8)) rb_ = ra;
          const GAS f32x4* xa = (const GAS f32x4*)(x1 + (size_t)ra * DM); const GAS f32x4* xb = (const GAS f32x4*)(x1 + (size_t)rb_ * DM);
#pragma unroll
          for (int j = 0; j < 4; ++j) { vnA[j] = xa[lane + 64 * j]; vnB[j] = xb[lane + 64 * j]; } }
#pragma unroll
        for (int j = 0; j < 4; ++j) { sA += (vA[j].x * vA[j].x + vA[j].y * vA[j].y) + (vA[j].z * vA[j].z + vA[j].w * vA[j].w); sB += (vB[j].x * vB[j].x + vB[j].y * vB[j].y) + (vB[j].z * vB[j].z + vB[j].w * vB[j].w); }
        sA = wave_sum(sA); sB = wave_sum(sB);
        const float rA = 1.0f / sqrtf(sA * (1.0f / DM) + NORM_EPS), rB = 1.0f / sqrtf(sB * (1.0f / DM) + NORM_EPS);
#pragma unroll
        for (int j = 0; j < 4; ++j) { const f32x4 gg = ((const GAS f32x4*)g2)[lane + 64 * j]; vA[j] = vA[j] * rA * gg; vB[j] = vB[j] * rB * gg;
            *(GAS unsigned long long*)(H2 + (size_t)rowA * DM + 4 * (lane + 64 * j)) = (unsigned long long)pk2(vA[j].x, vA[j].y) | ((unsigned long long)pk2(vA[j].z, vA[j].w) << 32);
            if (hasB) *(GAS unsigned long long*)(H2 + (size_t)rowB * DM + 4 * (lane + 64 * j)) = (unsigned long long)pk2(vB[j].x, vB[j].y) | ((unsigned long long)pk2(vB[j].z, vB[j].w) << 32); }
        float lgA[32], lgB[32];
#pragma unroll
        for (int e = 0; e < 32; ++e) { f32x2 a2 = {0.f, 0.f}, b2 = {0.f, 0.f};
#pragma unroll
            for (int j = 0; j < 4; ++j) { const f32x4 w4 = *(const LAS f32x4*)(rwT + e * 1028 + 4 * (lane + 64 * j)); const f32x2 wl = {w4.x, w4.y}, wh = {w4.z, w4.w};
                a2 += (f32x2){vA[j].x, vA[j].y} * wl; a2 += (f32x2){vA[j].z, vA[j].w} * wh; b2 += (f32x2){vB[j].x, vB[j].y} * wl; b2 += (f32x2){vB[j].z, vB[j].w} * wh; }
            lgA[e] = a2.x + a2.y; lgB[e] = b2.x + b2.y; if ((e & 3) == 3) __builtin_amdgcn_sched_barrier(0); }
        float r32_[32], r16[16], r8[8], r4[4], r2[2];
        { const bool odd = (lane & 1) != 0;
#pragma unroll
          for (int e = 0; e < 32; ++e) { const float send = odd ? lgA[e] : lgB[e], keep = odd ? lgB[e] : lgA[e]; r32_[e] = keep + __shfl_xor(send, 1); } }
        { const bool up = (lane & 32) != 0;
#pragma unroll
          for (int e = 0; e < 16; ++e) { const float send = up ? r32_[e] : r32_[e + 16], keep = up ? r32_[e + 16] : r32_[e]; r16[e] = keep + __shfl_xor(send, 32); } }
        { const bool up = (lane & 16) != 0;
#pragma unroll
          for (int e = 0; e < 8; ++e) { const float send = up ? r16[e] : r16[e + 8], keep = up ? r16[e + 8] : r16[e]; r8[e] = keep + __shfl_xor(send, 16); } }
        { const bool up = (lane & 8) != 0;
#pragma unroll
          for (int e = 0; e < 4; ++e) { const float send = up ? r8[e] : r8[e + 4], keep = up ? r8[e + 4] : r8[e]; r4[e] = keep + __shfl_xor(send, 8); } }
        { const bool up = (lane & 4) != 0;
#pragma unroll
          for (int e = 0; e < 2; ++e) { const float send = up ? r4[e] : r4[e + 2], keep = up ? r4[e + 2] : r4[e]; r2[e] = keep + __shfl_xor(send, 4); } }
        float val; { const bool up = (lane & 2) != 0; const float send = up ? r2[0] : r2[1], keep = up ? r2[1] : r2[0]; val = keep + __shfl_xor(send, 2); }
        val += myb;
        const unsigned long long par = (lane & 1) ? 0xAAAAAAAAAAAAAAAAull : 0x5555555555555555ull;
        int sel[4]; float sv[4];
#pragma unroll
        for (int k = 0; k < 4; ++k) { float m = val;
#pragma unroll
            for (int o = 2; o < 64; o <<= 1) m = fmaxf(m, __shfl_xor(m, o));
            const unsigned long long mk = __ballot(val == m) & par; const int e = (int)(__builtin_ctzll(mk) >> 1); sel[k] = e; sv[k] = m; if (((lane >> 1) & 31) == e) val = -INFINITY; }
        const float e0 = 1.0f, e1 = expf(sv[1] - sv[0]), e2 = expf(sv[2] - sv[0]), e3 = expf(sv[3] - sv[0]); const float inv = 1.0f / (e0 + e1 + e2 + e3);
        if (lane < 8 && (hasB || !(lane & 1))) { const int k = lane >> 1; const int row = (lane & 1) ? rowB : rowA; const int ex = (k == 0) ? sel[0] : (k == 1) ? sel[1] : (k == 2) ? sel[2] : sel[3]; const float wv = ((k == 0) ? e0 : (k == 1) ? e1 : (k == 2) ? e2 : e3) * inv;
            tope[row * 4 + k] = ex; topw[row * 4 + k] = wv;
            if (lists) { const int lp = atomicAdd((int*)(lcnt + ex), 1); rec[(wave_ * 8 + it + (lane & 1)) * 4 + k] = ex | (lp << 8); } }
        }
        __syncthreads();
        if (lists) {
            if (tid_ < 32) { const int c = lcnt[tid_]; gbase[tid_] = c ? atomicAdd(cnt + 64 * tid_, c) : 0; }
            __syncthreads();
            if (lane < 32) { const int it = lane >> 2, k = lane & 3; const int row = rowb + it * NGW;
                if (row < T_) { const int rc = rec[(wave_ * 8 + it) * 4 + k]; const int ex = rc & 255, lp = rc >> 8; list[ex * 16384 + gbase[ex] + lp] = row * 4 + k; } }
            __syncthreads();
        }
    }
    __syncthreads();
}

constexpr size_t WS_W1T = WS_R2, WS_W2T = WS_R2 + 128 * MiB;
__device__ __forceinline__ void p_expert_weights(Frame& F, const float* wg, const float* wu, const float* wd) {
    int tid_ = FTID; asm volatile("" : "+v"(tid_)); const int lane_ = tid_ & 63; const int wave_ = __builtin_amdgcn_readfirstlane(tid_ >> 6); (void)lane_; (void)wave_;
    LAS float* scr = (LAS float*)(F.lds + RING_OFF + wave_ * 16384);
    const int gw = F.vcu * NWAVES + wave_, NGW = F.G * NWAVES;
    bf16* W1t = (bf16*)(F.ws + WS_W1T); bf16* W2t = (bf16*)(F.ws + WS_W2T);
    (void)gw; (void)NGW;
    for (;;) {
        int ck = 0; if (lane_ == 0) ck = (int)__hip_atomic_fetch_add(F.ctl + CW_Q + 64 * 40, 1u, __ATOMIC_RELAXED, __HIP_MEMORY_SCOPE_AGENT);
        ck = __builtin_amdgcn_readfirstlane(ck);
        if (ck >= NEXP * 1536 / 16) break;
#pragma unroll 1
      for (int ki = 0; ki < 16; ++ki) { const int it = ck * 16 + ki;
        const int e = it / 1536, r = it % 1536;
        if (r < 1024) { const int rbk = r >> 4, kb = r & 15; const int pn = rbk >> 3, tcb = rbk & 7; const int srccol0 = 128 * pn + 32 * (tcb & 3);
            const float* W = ((tcb >> 2) ? wu : wg) + (size_t)e * DM * DM;
            transpose_item(W, DM, W1t + (size_t)e * 2048 * DM, 32 * rbk, 64 * kb, CmOff{srccol0 - 32 * rbk}, scr, lane_); }
        else { const int r2 = r - 1024; transpose_item(wd + (size_t)e * DM * DM, DM, W2t + (size_t)e * DM * DM, 32 * (r2 >> 4), 64 * (r2 & 15), CmIdent(), scr, lane_); }
      }
    }
}
constexpr size_t TBL_NMT = WS_SLOT, TBL_TILEE = WS_SLOT + 1024, TBL_SLOTOF = WS_SLOT + 64 * 1024, TBL_WSLOT = WS_SLOT + 320 * 1024;
constexpr int MOE_LDS_TILEE = 131072, MOE_LDS_START = 131072 + 2048, MOE_LDS_CNT = 131072 + 2048 + 128;
__device__ __forceinline__ int p3c_gather(Frame& F) {
    int tid_ = FTID; asm volatile("" : "+v"(tid_)); const int lane_ = tid_ & 63; const int wave_ = __builtin_amdgcn_readfirstlane(tid_ >> 6); (void)lane_; (void)wave_;
    const int* cnt = (const int*)(F.ws + WS_CTL) + CW_CNT; const int* list = (const int*)(F.ws + WS_LIST); const float* topw = (const float*)(F.ws + WS_TOPW);
    int* nmt = (int*)(F.ws + TBL_NMT); int* tile_e = (int*)(F.ws + TBL_TILEE); int* slot_of = (int*)(F.ws + TBL_SLOTOF); float* wslot = (float*)(F.ws + TBL_WSLOT);
    const int lane = lane_, gw = F.vcu * NWAVES + wave_, NGW = F.G * NWAVES;
    const int c = (lane < 32) ? __hip_atomic_load(cnt + 64 * lane, __ATOMIC_RELAXED, __HIP_MEMORY_SCOPE_AGENT) : 0;
    const int pc = ((c + 255) >> 8) << 8;
    int incl = pc;
#pragma unroll
    for (int o = 1; o < 32; o <<= 1) { const int t = __shfl_up(incl, o); if (lane >= o) incl += t; }
    const int start = incl - pc; const int total = __shfl(incl, 31);
    if (wave_ == 0 && lane < 32) { LAS int* lt = (LAS int*)(F.lds + RING_OFF + MOE_LDS_TILEE); for (int t = start >> 8; t < (start + pc) >> 8; ++t) lt[t] = lane;
        ((LAS int*)(F.lds + RING_OFF + MOE_LDS_START))[lane] = start; ((LAS int*)(F.lds + RING_OFF + MOE_LDS_CNT))[lane] = c; }
    if (gw == 0) { if (lane == 0) nmt[0] = total >> 8; if (lane < 32) for (int t = start >> 8; t < (start + pc) >> 8; ++t) tile_e[t] = lane; }
    for (int g0 = gw * 64; g0 < total; g0 += NGW * 64) {
        const unsigned long long mk = __ballot(lane < 32 && g0 >= start && g0 < start + pc);
        const int e = __builtin_ctzll(mk); const int g = g0 + lane; const int pos = g - __shfl(start, e); const int ce = __shfl(c, e);
        float w = 0.f;
        if (pos < ce) { const int aid = __hip_atomic_load(list + e * 16384 + pos, __ATOMIC_RELAXED, __HIP_MEMORY_SCOPE_AGENT);
            slot_of[aid] = g; w = __hip_atomic_load(topw + aid, __ATOMIC_RELAXED, __HIP_MEMORY_SCOPE_AGENT); }
        wslot[g] = w;
    }
    __syncthreads();
    return __builtin_amdgcn_readfirstlane(total >> 8);
}

__device__ __forceinline__ void p6_final(Frame& F, const bf16* y, const int* slot_of, const float* g, float* dst) {
    int tid_ = FTID; asm volatile("" : "+v"(tid_)); const int lane_ = tid_ & 63; const int wave_ = __builtin_amdgcn_readfirstlane(tid_ >> 6); (void)lane_; (void)wave_;
    const int gw = F.vcu * NWAVES + wave_, NGW = F.G * NWAVES, lane = lane_;
    for (int row = gw; row < T_; row += NGW) {
        GAS f32x4* xr = (GAS f32x4*)(F.out + (size_t)row * DM);
        int sl[4];
#pragma unroll
        for (int k = 0; k < 4; ++k) sl[k] = slot_of ? __hip_atomic_load(slot_of + row * 4 + k, __ATOMIC_RELAXED, __HIP_MEMORY_SCOPE_AGENT) : row * 4 + k;
        f32x4 v[4]; float s = 0.f;
#pragma unroll
        for (int j = 0; j < 4; ++j) { v[j] = xr[lane + 64 * j];
#pragma unroll
            for (int k = 0; k < 4; ++k) { const v2u u = *(const GAS v2u*)(y + (size_t)sl[k] * DM + 4 * (lane + 64 * j));
                v[j].x += __uint_as_float(u.x << 16); v[j].y += __uint_as_float(u.x & 0xffff0000u); v[j].z += __uint_as_float(u.y << 16); v[j].w += __uint_as_float(u.y & 0xffff0000u); }
            s += (v[j].x * v[j].x + v[j].y * v[j].y) + (v[j].z * v[j].z + v[j].w * v[j].w); }
        s = wave_sum(s);
        const float r = 1.0f / sqrtf(s * (1.0f / DM) + NORM_EPS);
        GAS f32x4* dr = (GAS f32x4*)(dst + (size_t)row * DM);
#pragma unroll
        for (int j = 0; j < 4; ++j) { const f32x4 gg = ((const GAS f32x4*)g)[lane + 64 * j]; dr[lane + 64 * j] = v[j] * r * gg; }
    }
}

__device__ __forceinline__ const float* argp(int i) { const unsigned char* kp = (const unsigned char*)__builtin_amdgcn_kernarg_segment_ptr(); asm volatile("" : "+s"(kp)); return *(const float* const*)(kp + 8 * i); }
struct Args { const float* in[23]; float* out; unsigned char* ws; int ph_lo, ph_hi, li, pad; };
__global__ void __launch_bounds__(NWAVES * 64, 2) mega(Args args) {
    extern __shared__ __attribute__((aligned(16))) unsigned char lds[];
    Frame F;
    F.lds = (LAS unsigned char*)lds;
    F.MISC = (volatile LAS unsigned*)(F.lds + MISC_OFF);
    F.G = gridDim.x; { const int bx = blockIdx.x; F.vcu = (F.G % 8 == 0) ? (bx % 8) * (F.G / 8) + bx / 8 : bx; }
    F.ws = args.ws; F.out = args.out; F.ctl = (gu32*)(args.ws + WS_CTL);
    for (int u = threadIdx.x; u < (LDS_BYTES - LDSCTL_OFF) / 4; u += NWAVES * 64) ((LAS unsigned*)(F.lds + LDSCTL_OFF))[u] = 0u;
    __syncthreads();
    if ((threadIdx.x & 63) == 0) ((LAS unsigned*)(F.lds + TID_TBL_OFF))[hw_slot()] = threadIdx.x >> 6;
    __syncthreads();

    XcdBarrier bar = xcd_barrier_post((unsigned*)(F.ctl + CW_BAR) + args.li * XCD_BAR_WORDS, F.MISC + 8);
    const int lo = args.ph_lo, hi = args.ph_hi;
#define IN(k) (lo <= (k) && (k) < hi)
#define SEAM(k) do { PRB_E(k, F.MISC + 24); if (IN(k) && IN((k) + 1)) { PRB_B(100 + (k), F.MISC + 24); xcd_barrier(bar); PRB_E(100 + (k), F.MISC + 24); } PRB_B((k) + 1, F.MISC + 24); } while (0)
#ifndef REP_PHASE
#define REP_PHASE -1
#endif

    PRB_B(0, F.MISC + 24);
    if (IN(0)) { { const int rep_ = 0; (void)rep_;  p0_prologue(F, argp(0), argp(1), argp(2), argp(12), argp(9), argp(10));  }
        if (REP_PHASE == 0) { xcd_barrier(bar); const int rep_ = 1; (void)rep_;  p0_prologue(F, argp(0), argp(1), argp(2), argp(12), argp(9), argp(10));  } }
    SEAM(0);
    if (IN(1)) { { const int rep_ = 0; (void)rep_;
        pg8::Gemm g{(const pg8::bf16_t*)F.out, (const pg8::bf16_t*)((unsigned char*)F.out + 32 * MiB), T_, 9216, DM}; pg8::StaticOrder S; S.init(T_, 9216, F.G, (int)blockIdx.x);
        pg8::EpiProj E{((bf16*)(F.ws + WS_SLAB)), (const float*)(F.ws + WS_ROPE)};
        pg8::gemm_phase<pg8::EpiProj, pg8::StaticOrder, true, true>(F.lds + RING_OFF, g, S, E);
     }
        if (REP_PHASE == 1) { xcd_barrier(bar); const int rep_ = 1; (void)rep_;
        pg8::Gemm g{(const pg8::bf16_t*)F.out, (const pg8::bf16_t*)((unsigned char*)F.out + 32 * MiB), T_, 9216, DM}; pg8::StaticOrder S; S.init(T_, 9216, F.G, (int)blockIdx.x);
        pg8::EpiProj E{((bf16*)(F.ws + WS_SLAB)), (const float*)(F.ws + WS_ROPE)};
        pg8::gemm_phase<pg8::EpiProj, pg8::StaticOrder, true, true>(F.lds + RING_OFF, g, S, E);
     } }
    SEAM(1);
    if (IN(2)) { { const int rep_ = 0; (void)rep_;  gdn::stageA(F.lds + RING_OFF, FTID, F.vcu, F.G, ((bf16*)(F.ws + WS_SLAB)), argp(8), (const float*)(F.ws + WS_BG), F.ws + WS_R2, F.MISC + 24);  }
        if (REP_PHASE == 2) { xcd_barrier(bar); const int rep_ = 1; (void)rep_;  gdn::stageA(F.lds + RING_OFF, FTID, F.vcu, F.G, ((bf16*)(F.ws + WS_SLAB)), argp(8), (const float*)(F.ws + WS_BG), F.ws + WS_R2, F.MISC + 24);  } }
    SEAM(2);
    if (IN(3)) { { const int rep_ = 0; (void)rep_;  p2_scans(F, lds, CW_Q + 64 * 16 * rep_); p2_attention(F, lds, CW_Q + 64 * 16 * rep_);  }
        if (REP_PHASE == 3) { xcd_barrier(bar); const int rep_ = 1; (void)rep_;  p2_scans(F, lds, CW_Q + 64 * 16 * rep_); p2_attention(F, lds, CW_Q + 64 * 16 * rep_);  } }
    SEAM(3);
    if (IN(4)) { { const int rep_ = 0; (void)rep_;  p2b_merge(F, argp(3), argp(4), argp(5), argp(6), argp(7), argp(11)); p_expert_weights(F, argp(16), argp(18), argp(20));  }
        if (REP_PHASE == 4) { xcd_barrier(bar); const int rep_ = 1; (void)rep_;  p2b_merge(F, argp(3), argp(4), argp(5), argp(6), argp(7), argp(11)); p_expert_weights(F, argp(16), argp(18), argp(20));  } }
    SEAM(4);
    if (IN(5)) { { const int rep_ = 0; (void)rep_;
        pg8::Gemm g{(const pg8::bf16_t*)((bf16*)(F.ws + WS_SLAB)), (const pg8::bf16_t*)(F.ws + WS_WOUT), T_, DM, DM}; pg8::StaticOrder S; S.init(T_, DM, F.G, (int)blockIdx.x);
        pg8::EpiOutRes E{argp(0), F.out};
        pg8::gemm_phase<pg8::EpiOutRes, pg8::StaticOrder, true, true>(F.lds + RING_OFF, g, S, E);
     }
        if (REP_PHASE == 5) { xcd_barrier(bar); const int rep_ = 1; (void)rep_;
        pg8::Gemm g{(const pg8::bf16_t*)((bf16*)(F.ws + WS_SLAB)), (const pg8::bf16_t*)(F.ws + WS_WOUT), T_, DM, DM}; pg8::StaticOrder S; S.init(T_, DM, F.G, (int)blockIdx.x);
        pg8::EpiOutRes E{argp(0), F.out};
        pg8::gemm_phase<pg8::EpiOutRes, pg8::StaticOrder, true, true>(F.lds + RING_OFF, g, S, E);
     } }
    SEAM(5);
    if (IN(6)) { if (REP_PHASE == 6) { p3b_router(F, argp(13), argp(14), argp(15), false); xcd_barrier(bar); } p3b_router(F, argp(13), argp(14), argp(15), true); }
    SEAM(6);
    PRB_E(7, F.MISC + 24); PRB_B(8, F.MISC + 24);
    if (IN(8)) {
        const int nMt = p3c_gather(F);
        const unsigned lb = (unsigned)(uintptr_t)(F.lds + RING_OFF);
        pg8::Gemm g{(const pg8::bf16_t*)(F.ws + WS_H2), (const pg8::bf16_t*)(F.ws + WS_W1T), nMt * 256, 2048, DM, (const int*)(F.ws + WS_LIST), lb + MOE_LDS_START, lb + MOE_LDS_CNT};
        pg8::MoeOrderT<true> S; S.init(nMt, 2048, F.G, (int)blockIdx.x, (const int*)(uintptr_t)(lb + MOE_LDS_TILEE), (long)2048 * DM * 2);
        pg8::EpiAct E{(bf16*)(F.ws + WS_SLAB + 144 * MiB), argp(17), argp(19), (const int*)(F.ws + TBL_TILEE)};
        pg8::gemm_phase<pg8::EpiAct, pg8::MoeOrderT<true>, true, true, true>(F.lds + RING_OFF, g, S, E);
    }
    SEAM(8);
    if (IN(9)) { { const int rep_ = 0; (void)rep_;
        const int nMt = __hip_atomic_load((const int*)(F.ws + TBL_NMT), __ATOMIC_RELAXED, __HIP_MEMORY_SCOPE_AGENT);
        pg8::Gemm g{(const pg8::bf16_t*)(F.ws + WS_SLAB + 144 * MiB), (const pg8::bf16_t*)(F.ws + WS_W2T), nMt * 256, DM, DM}; pg8::MoeOrder S; S.init(nMt, DM, F.G, (int)blockIdx.x, (const int*)(F.ws + TBL_TILEE), (long)DM * DM * 2);
        pg8::EpiDown E{(bf16*)(F.ws + WS_SLAB), argp(21), (const float*)(F.ws + TBL_WSLOT), (const int*)(F.ws + TBL_TILEE)};
        pg8::gemm_phase<pg8::EpiDown, pg8::MoeOrder, true, true>(F.lds + RING_OFF, g, S, E);
     }
        if (REP_PHASE == 9) { xcd_barrier(bar); const int rep_ = 1; (void)rep_;
        const int nMt = __hip_atomic_load((const int*)(F.ws + TBL_NMT), __ATOMIC_RELAXED, __HIP_MEMORY_SCOPE_AGENT);
        pg8::Gemm g{(const pg8::bf16_t*)(F.ws + WS_SLAB + 144 * MiB), (const pg8::bf16_t*)(F.ws + WS_W2T), nMt * 256, DM, DM}; pg8::MoeOrder S; S.init(nMt, DM, F.G, (int)blockIdx.x, (const int*)(F.ws + TBL_TILEE), (long)DM * DM * 2);
        pg8::EpiDown E{(bf16*)(F.ws + WS_SLAB), argp(21), (const float*)(F.ws + TBL_WSLOT), (const int*)(F.ws + TBL_TILEE)};
        pg8::gemm_phase<pg8::EpiDown, pg8::MoeOrder, true, true>(F.lds + RING_OFF, g, S, E);
     } }
    SEAM(9);
    if (IN(10)) { if (REP_PHASE == 10) { p6_final(F, (const bf16*)(F.ws + WS_SLAB), (const int*)(F.ws + TBL_SLOTOF), argp(22), (float*)(F.ws + WS_SLAB + 144 * MiB)); xcd_barrier(bar); } p6_final(F, (const bf16*)(F.ws + WS_SLAB), (const int*)(F.ws + TBL_SLOTOF), argp(22), F.out); }
    PRB_E(10, F.MISC + 24);
    if (PROBE_ID >= 0 && IN(10) && blockIdx.x == 0 && FTID == 0) { asm volatile("s_waitcnt vmcnt(0)" ::: "memory"); F.out[0] += (float)F.MISC[24] * 0.0003f; }
#undef IN
#undef SEAM
}


static void launch_mega(Args a, int lo, int hi, int li, int grid, hipStream_t stream) { a.ph_lo = lo; a.ph_hi = hi; a.li = li; a.pad = 0; hipLaunchKernelGGL(mega, dim3(grid), dim3(NWAVES * 64), LDS_BYTES, stream, a);
    const hipError_t le = hipPeekAtLastError(); if (le != hipSuccess) fprintf(stderr, "kernel_launch: mega launch [%d,%d) failed: %s\n", lo, hi, hipGetErrorName(le)); }
extern "C" void kernel_launch(void* const* d_in, const int* in_sizes, int n_in, void* d_out, int out_size, void* d_ws, size_t ws_size, hipStream_t stream) {
    static int grid = 0;
    if (grid == 0) {
        if (n_in != 23 || ws_size < WS_END || out_size != T_ * DM) { fprintf(stderr, "kernel_launch: unexpected shapes n_in %d ws %zu out %d\n", n_in, ws_size, out_size); grid = -1; return; }
        int dev = 0, cus = 0;
        if (hipGetDevice(&dev) != hipSuccess || hipDeviceGetAttribute(&cus, hipDeviceAttributeMultiprocessorCount, dev) != hipSuccess) { grid = -1; return; }
        if (hipFuncSetAttribute((const void*)mega, hipFuncAttributeMaxDynamicSharedMemorySize, LDS_BYTES) != hipSuccess) { fprintf(stderr, "kernel_launch: hipFuncSetAttribute failed\n"); grid = -1; return; }
        (void)hipGetLastError();
        grid = cus;
        fprintf(stderr, "kernel_launch: grid %d ws_size %zu MiB\n", grid, ws_size >> 20);
    }
    if (grid < 0) return;
    const float* conv_w = (const float*)d_in[8];
    const float *wg = (const float*)d_in[16], *bgate = (const float*)d_in[17], *wu = (const float*)d_in[18], *bup = (const float*)d_in[19], *wd = (const float*)d_in[20], *bdown = (const float*)d_in[21];
    unsigned char* ws = (unsigned char*)d_ws;
    int* cnt = (int*)(ws + WS_CTL); float* bg = (float*)(ws + WS_BG); float* topw = (float*)(ws + WS_TOPW); int* list = (int*)(ws + WS_LIST);
    bf16_t* slab = (bf16_t*)(ws + WS_SLAB);
    bf16_t *VA = slab + 2 * (SLAB / 2), *GQ = slab + 3 * (SLAB / 2);
    float *cq = (float*)(ws + WS_R2), *ck = (float*)(ws + WS_R2 + 64 * MiB), *cv = (float*)(ws + WS_R2 + 128 * MiB);
    bf16_t* act = (bf16_t*)(ws + WS_R2); bf16_t* ybuf = VA; bf16_t* H2 = (bf16_t*)(ws + WS_H2);
    (void)hipMemsetAsync(ws + WS_CTL, 0, CTL_ZERO_BYTES, stream);
    Args a; memset(&a, 0, sizeof a);
    for (int i = 0; i < 23; ++i) a.in[i] = (const float*)d_in[i];
    a.out = (float*)d_out; a.ws = ws;
    launch_mega(a, 0, 11, 0, grid, stream);
}
```

```cpp
#include <hip/hip_runtime.h>
#include <hip/hip_bf16.h>
#include <cstdio>
#include <cstdint>
#include <cmath>
#include <cstring>

constexpr int T_ = 16384, SEQ = 8192, DM = 1024, IN_DIM = 9232, NEXP = 32;
constexpr float NORM_EPS = 1e-6f;
constexpr float C2 = 0.125f * 1.4426950408889634f;
typedef unsigned short bf16_t;

constexpr size_t MiB = 1u << 20;
constexpr size_t WS_CTL = 0, CTL_ZERO_BYTES = 64 * 1024;
constexpr size_t WS_BG = 2 * MiB;
constexpr size_t WS_ROPE = 3 * MiB;
constexpr size_t WS_TOPE = 5 * MiB;
constexpr size_t WS_TOPW = 5 * MiB + 512 * 1024;
constexpr size_t WS_LIST = 6 * MiB;
constexpr size_t WS_SLAB = 8 * MiB;
constexpr size_t SLAB = 32 * MiB;
constexpr size_t WS_H2 = WS_SLAB;
constexpr size_t WS_R2 = WS_SLAB + 9 * SLAB;
constexpr size_t WS_WOUT = WS_R2 + 192 * MiB;
constexpr size_t WS_SLOT = WS_WOUT + 2 * MiB;
constexpr size_t WS_END = WS_SLOT + 4 * MiB;
constexpr int CW_CNT = 8192;
constexpr int CW_Q = 64;
constexpr int CW_BAR = 4096;

__device__ __forceinline__ float bf2f(bf16_t v) { return __uint_as_float((unsigned)v << 16); }
__device__ __forceinline__ bf16_t f2bf(float f) { unsigned u = __float_as_uint(f); return (bf16_t)((u + 0x7fffu + ((u >> 16) & 1u)) >> 16); }
#define WAVE_DPP(x, ctrl, rmask, old) __int_as_float(__builtin_amdgcn_update_dpp(__float_as_int(old), __float_as_int(x), ctrl, rmask, 0xF, false))
__device__ __forceinline__ float wave_sum(float v) {
    v += WAVE_DPP(v, 0xB1, 0xF, 0.f); v += WAVE_DPP(v, 0x4E, 0xF, 0.f); v += WAVE_DPP(v, 0x141, 0xF, 0.f); v += WAVE_DPP(v, 0x140, 0xF, 0.f);
    v += WAVE_DPP(v, 0x142, 0xA, 0.f); v += WAVE_DPP(v, 0x143, 0xC, 0.f);
    return __int_as_float(__builtin_amdgcn_readlane(__float_as_int(v), 63));
}
__device__ __forceinline__ float wave_max(float v) {
    v = fmaxf(v, WAVE_DPP(v, 0xB1, 0xF, v)); v = fmaxf(v, WAVE_DPP(v, 0x4E, 0xF, v)); v = fmaxf(v, WAVE_DPP(v, 0x141, 0xF, v)); v = fmaxf(v, WAVE_DPP(v, 0x140, 0xF, v));
    v = fmaxf(v, WAVE_DPP(v, 0x142, 0xA, v)); v = fmaxf(v, WAVE_DPP(v, 0x143, 0xC, v));
    return __int_as_float(__builtin_amdgcn_readlane(__float_as_int(v), 63));
}
__device__ __forceinline__ float sigmoidf_(float x) { return __builtin_amdgcn_rcpf(1.0f + __expf(-x)); }

constexpr int TID_TBL_OFF = 152576 + 320 + 256;
__device__ __forceinline__ int hw_slot() { return (int)(__builtin_amdgcn_s_getreg((5 << 11) | 4) & 63u); }
__device__ __forceinline__ int lane_now() { unsigned z; asm volatile("v_mov_b32 %0, 0" : "=v"(z)); return (int)__builtin_amdgcn_mbcnt_hi(~0u, __builtin_amdgcn_mbcnt_lo(~0u, z)); }
__device__ __forceinline__ int wave_now(const void* ring_base) { const __attribute__((address_space(3))) unsigned* T = (const __attribute__((address_space(3))) unsigned*)((const __attribute__((address_space(3))) unsigned char*)(unsigned)(uintptr_t)ring_base + TID_TBL_OFF);
    return __builtin_amdgcn_readfirstlane((int)T[hw_slot()]); }
__device__ __forceinline__ int tid_now(const void* ring_base) { return wave_now(ring_base) * 64 + lane_now(); }

#ifndef PROBE_ID
#define PROBE_ID -1
#endif
#define PRB4_B(id, PRB) do { if (PROBE_ID == (id) && blockIdx.x == 0 && threadIdx.x == 256) (PRB)[1] = (unsigned)__builtin_amdgcn_s_memrealtime(); } while (0)
#define PRB4_E(id, PRB) do { if (PROBE_ID == (id) && blockIdx.x == 0 && threadIdx.x == 256) (PRB)[0] += (unsigned)__builtin_amdgcn_s_memrealtime() - (PRB)[1]; } while (0)
#ifndef PROBE_TID
#define PROBE_TID 0
#endif
#define PRB_B(id, PRB) do { if (PROBE_ID == (id) && blockIdx.x == 0 && threadIdx.x == PROBE_TID) (PRB)[1] = (unsigned)__builtin_amdgcn_s_memrealtime(); } while (0)
#define PRBC_B(id, PRB) do { if (PROBE_ID == (id) && blockIdx.x == 0 && threadIdx.x == 0) (PRB)[1] = (unsigned)__builtin_amdgcn_s_memtime(); } while (0)
#define PRBC_E(id, PRB) do { if (PROBE_ID == (id) && blockIdx.x == 0 && threadIdx.x == 0) (PRB)[0] += ((unsigned)__builtin_amdgcn_s_memtime() - (PRB)[1]) >> 4; } while (0)
#define PRB_E(id, PRB) do { if (PROBE_ID == (id) && blockIdx.x == 0 && threadIdx.x == PROBE_TID) (PRB)[0] += (unsigned)__builtin_amdgcn_s_memrealtime() - (PRB)[1]; } while (0)

namespace pg8 {
#define PG8_LAS __attribute__((address_space(3)))
typedef unsigned short bf16_t;
typedef short bf16x8 __attribute__((ext_vector_type(8)));
typedef float f32x4 __attribute__((ext_vector_type(4)));
typedef unsigned u32x4 __attribute__((ext_vector_type(4)));
constexpr int BM = 256, BK = 64, HALF = 128, HTB = HALF * BK * 2  , STAGE_BYTES = 8 * HTB, NXCD = 8, WGM = 8;

__host__ __device__ __forceinline__ int lds_byte(int r, int c) { const int st = (r >> 4) * 2 + (c >> 5), rr = r & 15, cc = c & 31, ob = rr * 64 + cc * 2; return st * 1024 + (ob ^ (((ob >> 9) & 1) << 5)); }
__host__ __device__ __forceinline__ void stage_rc(int b, int& R, int& C) { const int st = b / 1024, sb = b % 1024, swz = sb ^ (((sb >> 9) & 1) << 5); R = (st >> 1) * 16 + swz / 64; C = (st & 1) * 32 + (swz % 64) / 2; }
__host__ __device__ __forceinline__ int perm32(int rho) { const int n = rho >> 4, i = rho & 15; return 8 * (i >> 2) + 4 * n + (i & 3); }

struct Unit { int pm, pn; long boff; int e; int half, rofs; };
struct Gemm { const bf16_t* A; const bf16_t* Bt; int M, N, K; const int* list; unsigned ldsStart, ldsCnt; };

struct StaticOrder {
    int nM, nN, nwg, G, c;
    __host__ __device__ void init(int M, int N, int G_, int c_) { nM = M / BM; nN = N / BM; nwg = nM * nN; G = G_; c = c_; }
    __host__ __device__ bool next(int i, Unit& u) const { const long L = (long)i * G + c; if (L >= nwg) return false; map((int)L, u); return true; }
    __host__ __device__ void map(int L, Unit& u) const {
        int wgid = L; { const int q = nwg / NXCD, r = nwg % NXCD, xcd = wgid % NXCD, off = wgid / NXCD; wgid = (xcd < r ? xcd * (q + 1) : r * (q + 1) + (xcd - r) * q) + off; }
        const int nig = WGM * nN, gid = wgid / nig, fm = gid * WGM, gsz = (nM - fm) < WGM ? (nM - fm) : WGM;
        u.pm = fm + ((wgid % nig) % gsz); u.pn = (wgid % nig) / gsz; u.boff = 0; u.e = 0; u.half = 0; u.rofs = 0;
    }
    __device__ __forceinline__ void a_ready(const Unit&) const {}
    __device__ __forceinline__ void done(const Unit&) const {}
};


#ifndef GAS
#define GAS __attribute__((address_space(1)))
#endif
__device__ __forceinline__ unsigned cvt_pk_bf16(float lo, float hi) { unsigned r; asm volatile("v_cvt_pk_bf16_f32 %0, %1, %2" : "=v"(r) : "v"(lo), "v"(hi)); return r; }
typedef unsigned u32x2 __attribute__((ext_vector_type(2)));

struct EpiProj {
    static constexpr bool PERM = true, AFTER_DRAIN = false;
    bf16_t* slab; const float* rope;
    __device__ __forceinline__ void operator()(const f32x4 (&acc)[2][2][4][2], const Unit& u, int wr, int wc, int fr, int fq) const {
        const int s = u.pn >> 2; bf16_t* base = slab + (size_t)s * (SLAB / 2); const int colt = (u.pn & 3) * 256;
        const int row0 = u.pm * BM + wr * 64 + fr;
        if (s < 2) {
            const float sc = (s == 0) ? C2 : 1.0f; const int i0 = 16 * (wc & 1) + 4 * fq;
            f32x4 csv[2][4], snv[2][4];
#pragma unroll
            for (int ai = 0; ai < 2; ++ai)
#pragma unroll
                for (int m = 0; m < 4; ++m) { const int pos = (row0 + ai * HALF + m * 16) & (SEQ - 1);
                    csv[ai][m] = *(const GAS f32x4*)(rope + pos * 32 + i0); snv[ai][m] = *(const GAS f32x4*)(rope + SEQ * 32 + pos * 32 + i0); }
#pragma unroll
            for (int ai = 0; ai < 2; ++ai)
#pragma unroll
                for (int m = 0; m < 4; ++m) { const int row = row0 + ai * HALF + m * 16;
                    const f32x4 cs = csv[ai][m] * sc, sn = snv[ai][m] * sc;
#pragma unroll
                    for (int bj = 0; bj < 2; ++bj) { const f32x4 v0 = acc[ai][bj][m][0], v1 = acc[ai][bj][m][1];
                        const f32x4 lo = v0 * cs - v1 * sn, hi = v1 * cs + v0 * sn;
                        bf16_t* p = base + (size_t)row * DM + colt + 64 * (2 * bj + (wc >> 1)) + i0;
                        u32x2 w0, w1; w0.x = cvt_pk_bf16(lo[0], lo[1]); w0.y = cvt_pk_bf16(lo[2], lo[3]); w1.x = cvt_pk_bf16(hi[0], hi[1]); w1.y = cvt_pk_bf16(hi[2], hi[3]);
                        *(GAS u32x2*)p = w0; *(GAS u32x2*)(p + 32) = w1; } }
        } else {
            const int col0 = colt + wc * 32 + 8 * fq;
#pragma unroll
            for (int ai = 0; ai < 2; ++ai)
#pragma unroll
                for (int m = 0; m < 4; ++m) { bf16_t* rowp = base + (size_t)(row0 + ai * HALF + m * 16) * DM + col0;
#pragma unroll
                    for (int bj = 0; bj < 2; ++bj) { const f32x4 v0 = acc[ai][bj][m][0], v1 = acc[ai][bj][m][1];
                        u32x4 w; w.x = cvt_pk_bf16(v0[0], v0[1]); w.y = cvt_pk_bf16(v0[2], v0[3]); w.z = cvt_pk_bf16(v1[0], v1[1]); w.w = cvt_pk_bf16(v1[2], v1[3]);
                        *(GAS u32x4*)(rowp + bj * HALF) = w; } }
        }
    }
};
struct EpiOutRes {
    static constexpr bool PERM = false, AFTER_DRAIN = false;
    const float* x; float* x1;
    __device__ __forceinline__ void operator()(const f32x4 (&acc)[2][2][4][2], const Unit& u, int wr, int wc, int fr, int fq) const {
        const int col0 = u.pn * BM + wc * 32 + 4 * fq;
#pragma unroll
        for (int ai = 0; ai < 2; ++ai) { f32x4 bs[4][2][2];
#pragma unroll
            for (int m = 0; m < 4; ++m) { const size_t off = (size_t)(u.pm * BM + ai * HALF + wr * 64 + m * 16 + fr) * DM + col0;
#pragma unroll
                for (int bj = 0; bj < 2; ++bj)
#pragma unroll
                    for (int n = 0; n < 2; ++n) bs[m][bj][n] = *(const GAS f32x4*)(x + off + bj * HALF + n * 16); }
#pragma unroll
            for (int m = 0; m < 4; ++m) { const size_t off = (size_t)(u.pm * BM + ai * HALF + wr * 64 + m * 16 + fr) * DM + col0;
#pragma unroll
                for (int bj = 0; bj < 2; ++bj)
#pragma unroll
                    for (int n = 0; n < 2; ++n) *(GAS f32x4*)(x1 + off + bj * HALF + n * 16) = bs[m][bj][n] + acc[ai][bj][m][n]; } }
    }
};
struct EpiAct {
    static constexpr bool PERM = true, AFTER_DRAIN = false;
    bf16_t* act; const float* bgate; const float* bup; const int* tile_e;
    __device__ __forceinline__ void operator()(const f32x4 (&acc)[2][2][4][2], const Unit& u, int wr, int wc, int fr, int fq) const {
        const int e = u.e;
        const int col0 = u.pn * HALF + wc * 32 + 8 * fq; const int row0 = u.pm * BM + u.rofs + wr * 64 + fr;
        const f32x4 bg0 = *(const GAS f32x4*)(bgate + e * 1024 + col0), bg1 = *(const GAS f32x4*)(bgate + e * 1024 + col0 + 4), bu0 = *(const GAS f32x4*)(bup + e * 1024 + col0), bu1 = *(const GAS f32x4*)(bup + e * 1024 + col0 + 4);
#pragma unroll
        for (int ai = 0; ai < 2; ++ai) { if (ai == 1 && u.half) break;
#pragma unroll
            for (int m = 0; m < 4; ++m) { f32x4 o[2];
#pragma unroll
                for (int n = 0; n < 2; ++n) { const f32x4 g = acc[ai][0][m][n] + (n ? bg1 : bg0), up = acc[ai][1][m][n] + (n ? bu1 : bu0);
                    f32x4 gate, uu, ex;
#pragma unroll
                    for (int q = 0; q < 4; ++q) { gate[q] = fminf(g[q], 7.0f); uu[q] = fminf(fmaxf(up[q], -7.0f), 7.0f); }
                    const f32x4 tt = gate * (-1.702f * 1.4426950408889634f);
#pragma unroll
                    for (int q = 0; q < 4; ++q) ex[q] = __builtin_amdgcn_exp2f(tt[q]);
                    const f32x4 den = ex + 1.0f; f32x4 rc;
#pragma unroll
                    for (int q = 0; q < 4; ++q) rc[q] = __builtin_amdgcn_rcpf(den[q]);
                    o[n] = (uu + 1.0f) * gate * rc; }
                u32x4 w; w.x = cvt_pk_bf16(o[0][0], o[0][1]); w.y = cvt_pk_bf16(o[0][2], o[0][3]); w.z = cvt_pk_bf16(o[1][0], o[1][1]); w.w = cvt_pk_bf16(o[1][2], o[1][3]);
                *(GAS u32x4*)(act + (size_t)(row0 + ai * HALF + m * 16) * DM + col0) = w; } }
    }
};
struct EpiDown {
    static constexpr bool PERM = true, AFTER_DRAIN = false;
    bf16_t* y; const float* bdown; const float* wslot; const int* tile_e;
    __device__ __forceinline__ void operator()(const f32x4 (&acc)[2][2][4][2], const Unit& u, int wr, int wc, int fr, int fq) const {
        const int e = u.e;
        const int col0 = u.pn * BM + wc * 32 + 8 * fq; const int row0 = u.pm * BM + u.rofs + wr * 64 + fr;
        f32x4 bv[2][2]; float wsv[2][4];
#pragma unroll
        for (int bj = 0; bj < 2; ++bj)
#pragma unroll
            for (int n = 0; n < 2; ++n) bv[bj][n] = *(const GAS f32x4*)(bdown + e * 1024 + col0 + bj * HALF + 4 * n);
#pragma unroll
        for (int ai = 0; ai < 2; ++ai)
#pragma unroll
            for (int m = 0; m < 4; ++m) wsv[ai][m] = *(const GAS float*)(wslot + row0 + (u.half ? 0 : ai * HALF) + m * 16);
#pragma unroll
        for (int ai = 0; ai < 2; ++ai) { if (ai == 1 && u.half) break;
#pragma unroll
            for (int m = 0; m < 4; ++m) { const int row = row0 + ai * HALF + m * 16; const float ws = wsv[ai][m];
#pragma unroll
                for (int bj = 0; bj < 2; ++bj) { const f32x4 v0 = (acc[ai][bj][m][0] + bv[bj][0]) * ws, v1 = (acc[ai][bj][m][1] + bv[bj][1]) * ws;
                    u32x4 w; w.x = cvt_pk_bf16(v0[0], v0[1]); w.y = cvt_pk_bf16(v0[2], v0[3]); w.z = cvt_pk_bf16(v1[0], v1[1]); w.w = cvt_pk_bf16(v1[2], v1[3]);
                    *(GAS u32x4*)(y + (size_t)row * DM + col0 + bj * HALF) = w; } } }
    }
};
template <bool LDS_TBL> struct MoeOrderT {
    StaticOrder so; const int* tile_e; long estride; int nfull, rem;
    __device__ void init(int nMt, int N, int G_, int c_, const int* te, long es) { so.nM = nMt; so.nN = N / BM; so.nwg = so.nM * so.nN; so.G = G_; so.c = c_; tile_e = te; estride = es;
        nfull = (so.nwg / G_) * G_; rem = so.nwg - nfull; }
    __device__ bool next(int i, Unit& u) const { const long L = (long)i * so.G + so.c; int idx, half = 0, rofs = 0;
        if (L < nfull) idx = (int)L;
        else { const int j = (int)(L - nfull); if (2 * rem <= so.G) { if (j >= 2 * rem) return false; idx = nfull + (j >> 1); half = 1; rofs = (j & 1) * HALF; } else { if (j >= rem) return false; idx = nfull + j; } }
        so.map(idx, u); int e; if constexpr (LDS_TBL) e = *(const PG8_LAS int*)(uintptr_t)((unsigned)(uintptr_t)tile_e + 4u * (unsigned)u.pm); else e = __hip_atomic_load(tile_e + u.pm, __ATOMIC_RELAXED, __HIP_MEMORY_SCOPE_AGENT);
        u.boff = (long)e * estride; u.e = e; u.half = half; u.rofs = rofs; return true; }
    __device__ __forceinline__ void a_ready(const Unit&) const {}
    __device__ __forceinline__ void done(const Unit&) const {}
};
typedef MoeOrderT<false> MoeOrder;
template <class Epi, class Sched, bool ALIGN_EPI = false, bool SP2 = false, bool GATHER = false>
__device__ __forceinline__ void gemm_phase(PG8_LAS unsigned char* lds, const Gemm g, const Sched& S, const Epi& E) {
    const int wid = wave_now((const void*)(uintptr_t)(unsigned)(uintptr_t)lds), lane = lane_now(), tid = wid * 64 + lane, wr = wid >> 2, wc = wid & 3, fr = lane & 15, fq = lane >> 4;
    const int K = g.K, nt = K / BK;
    unsigned voffA[2], voffB[2];
#pragma unroll
    for (int i = 0; i < 2; ++i) { int R, C; stage_rc(tid * 16 + i * 8192, R, C); const int Rb = Epi::PERM ? ((R & ~31) + perm32(R & 31)) : R;
        voffA[i] = (unsigned)(R * K + C) * 2u; voffB[i] = (unsigned)(Rb * K + C) * 2u; }
    const size_t kstep = (size_t)(BK * 2);
    const size_t hstep = (size_t)HALF * K * 2;
    const size_t tstep = 2 * hstep;
    const unsigned ldsw = (unsigned)wid * 1024u;
    const int aoff = lds_byte(wr * 64 + fr, fq * 8), boff = lds_byte(wc * 32 + fr, fq * 8);
#define PG8_SA(b, h) (((b) * 2 + (h)) * HTB)
#define PG8_SB(b, h) ((4 + (b) * 2 + (h)) * HTB)
#define PG8_STAGE(bufoff, gbase, voff) do { _Pragma("unroll") for (int _i = 0; _i < 2; ++_i) \
        __builtin_amdgcn_global_load_lds((const unsigned*)((const char*)(gbase) + (voff)[_i]), (PG8_LAS unsigned*)(lds + (bufoff) + ldsw + _i * 8192), 16, 0, 0); } while (0)
#define PG8_STA(bufoff, P, h, G) do { if constexpr (GATHER) { PG8_STAGE(bufoff, P, (G)[h]); } else { PG8_STAGE(bufoff, (P) + (h) * hstep, voffA); } } while (0)
#define PG8_LDA(dst, b, h) do { _Pragma("unroll") for (int m = 0; m < 4; ++m) _Pragma("unroll") for (int k = 0; k < 2; ++k) dst[m][k] = *(const PG8_LAS bf16x8*)(lds + PG8_SA(b, h) + aoff + m * 2048 + k * 1024); } while (0)
#define PG8_LDB(dst, b, h) do { _Pragma("unroll") for (int n = 0; n < 2; ++n) _Pragma("unroll") for (int k = 0; k < 2; ++k) dst[n][k] = *(const PG8_LAS bf16x8*)(lds + PG8_SB(b, h) + boff + n * 2048 + k * 1024); } while (0)
#define PG8_MMA(ai, bj, At, Bt) do { __builtin_amdgcn_s_setprio(1); _Pragma("unroll") for (int m = 0; m < 4; ++m) _Pragma("unroll") for (int n = 0; n < 2; ++n) _Pragma("unroll") for (int k = 0; k < 2; ++k) \
        acc[ai][bj][m][n] = __builtin_amdgcn_mfma_f32_16x16x32_bf16(Bt[n][k], At[m][k], acc[ai][bj][m][n], 0, 0, 0); __builtin_amdgcn_s_setprio(0); } while (0)
#define PG8_WAIT_V(n) asm volatile("s_waitcnt vmcnt(" #n ")" ::: "memory")
#define PG8_WAIT_L(n) asm volatile("s_waitcnt lgkmcnt(" #n ")" ::: "memory")
#define PG8_BAR __builtin_amdgcn_s_barrier()
#define PG8_SCHED __builtin_amdgcn_sched_barrier(0)
    Unit cur, nxt; int ui = 0;
    if (!S.next(0, cur)) return;
    f32x4 acc[2][2][4][2];
#pragma unroll
    for (int a = 0; a < 2; ++a)
#pragma unroll
        for (int b = 0; b < 2; ++b)
#pragma unroll
            for (int m = 0; m < 4; ++m)
#pragma unroll
                for (int n = 0; n < 2; ++n) acc[a][b][m][n] = (f32x4){0.f, 0.f, 0.f, 0.f};
    bf16x8 At[4][2], B0[2][2], B1[2][2];
    const char* cA = (const char*)g.A + (GATHER ? (size_t)0 : (size_t)cur.pm * tstep + (size_t)cur.rofs * K * 2); const char* cB = (const char*)g.Bt + cur.boff + (size_t)cur.pn * tstep;
    S.a_ready(cur);
    unsigned gC[2][2], gX[2][2];
#define PG8_ROWIDS(G, U_) do { const int se_ = *(const PG8_LAS int*)(uintptr_t)(g.ldsStart + 4u * (unsigned)(U_).e), ce_ = *(const PG8_LAS int*)(uintptr_t)(g.ldsCnt + 4u * (unsigned)(U_).e);   \
        const int* lb_ = g.list + (U_).e * 16384;                                                                                                       \
        _Pragma("unroll") for (int h_ = 0; h_ < 2; ++h_) _Pragma("unroll") for (int i_ = 0; i_ < 2; ++i_) {                                              \
            int pos_ = (U_).pm * 256 + (U_).rofs + ((U_).half ? 0 : h_ * 128) + (int)(voffA[i_] / (unsigned)(2 * K)) - se_; if (pos_ >= ce_) pos_ = 0;     \
            const int* rp_ = lb_ + pos_; unsigned v_; asm volatile("global_load_dword %0, %1, off" : "=v"(v_) : "v"(rp_) : "memory"); G[h_][i_] = v_; } } while (0)
#define PG8_ROWFIX(G) do { _Pragma("unroll") for (int h_ = 0; h_ < 2; ++h_) _Pragma("unroll") for (int i_ = 0; i_ < 2; ++i_) G[h_][i_] = (G[h_][i_] >> 2) * (unsigned)(2 * K) + voffA[i_] % (unsigned)(2 * K); } while (0)
    if constexpr (GATHER) { PG8_ROWIDS(gC, cur); asm volatile("s_waitcnt vmcnt(0)" ::: "memory"); PG8_ROWFIX(gC);
#pragma unroll
        for (int h_ = 0; h_ < 2; ++h_) { gX[h_][0] = gC[h_][0]; gX[h_][1] = gC[h_][1]; } }
    if constexpr (SP2) {
        PG8_STAGE(PG8_SB(0, 0), cB, voffB); PG8_STAGE(PG8_SB(0, 1), cB + hstep, voffB); PG8_STA(PG8_SA(0, 0), cA, 0, gC); PG8_STA(PG8_SA(0, 1), cA, 1, gC);
        if (wr == 1) PG8_BAR;
        PG8_WAIT_V(2); PG8_BAR;
        PG8_STAGE(PG8_SB(1, 0), cB + kstep, voffB); PG8_STA(PG8_SA(1, 0), cA + kstep, 0, gC); PG8_STAGE(PG8_SB(1, 1), cB + hstep + kstep, voffB);
        PG8_WAIT_V(6); PG8_BAR;
    } else {
        PG8_STAGE(PG8_SB(0, 0), cB, voffB); PG8_STA(PG8_SA(0, 0), cA, 0, gC); PG8_STAGE(PG8_SB(0, 1), cB + hstep, voffB); PG8_STA(PG8_SA(0, 1), cA, 1, gC);
        if (wr == 1) PG8_BAR;
        PG8_WAIT_V(4); PG8_BAR;
        PG8_STAGE(PG8_SB(1, 0), cB + kstep, voffB); PG8_STA(PG8_SA(1, 0), cA + kstep, 0, gC); PG8_STAGE(PG8_SB(1, 1), cB + hstep + kstep, voffB);
        PG8_WAIT_V(6); PG8_BAR;
    }
    for (;;) {
        const bool has_next = S.next(ui + 1, nxt);
        const char* nA = (has_next && !GATHER) ? (const char*)g.A + (size_t)nxt.pm * tstep + (size_t)nxt.rofs * K * 2 : cA; const char* nB = has_next ? (const char*)g.Bt + nxt.boff + (size_t)nxt.pn * tstep : cB;
        if constexpr (GATHER) { if (has_next) PG8_ROWIDS(gX, nxt); }
        for (int t = 0; t < nt; t += 2) {
            const bool last = (t == nt - 2);
            const char* a1 = cA + (size_t)(t + 1) * kstep;
            const char* a2 = last ? nA : cA + (size_t)(t + 2) * kstep; const char* b2 = last ? nB : cB + (size_t)(t + 2) * kstep;
            const char* a3 = a2 + kstep; const char* b3 = b2 + kstep;
            if (last && has_next) S.a_ready(nxt);
            unsigned g2[2][2];
            if constexpr (GATHER) { if (last && has_next) PG8_ROWFIX(gX);
#pragma unroll
                for (int h_ = 0; h_ < 2; ++h_) { g2[h_][0] = last ? gX[h_][0] : gC[h_][0]; g2[h_][1] = last ? gX[h_][1] : gC[h_][1]; } }
            if constexpr (SP2) {
            const bool hc = cur.half != 0, h2 = last ? (has_next ? nxt.half != 0 : hc) : hc;
            PG8_LDB(B0, 0, 0); PG8_LDB(B1, 0, 1); PG8_SCHED; PG8_LDA(At, 0, 0); if (!hc) PG8_STA(PG8_SA(1, 1), a1, 1, gC);
            PG8_WAIT_V(8); PG8_WAIT_L(0); PG8_BAR; PG8_MMA(0, 0, At, B0); PG8_MMA(0, 1, At, B1); PG8_BAR; PG8_SCHED;
            if (!hc) PG8_LDA(At, 0, 1); PG8_STAGE(PG8_SB(0, 0), b2, voffB); PG8_STAGE(PG8_SB(0, 1), b2 + hstep, voffB); PG8_STA(PG8_SA(0, 0), a2, 0, g2);
            if (hc) PG8_WAIT_V(6); else PG8_WAIT_V(8);
            PG8_WAIT_L(0); PG8_BAR; if (!hc) { PG8_MMA(1, 0, At, B0); PG8_MMA(1, 1, At, B1); } PG8_BAR; PG8_SCHED;
            PG8_LDB(B0, 1, 0); PG8_LDB(B1, 1, 1); PG8_SCHED; PG8_LDA(At, 1, 0); if (!h2) PG8_STA(PG8_SA(0, 1), a2, 1, g2);
            if (h2) PG8_WAIT_V(6); else PG8_WAIT_V(8);
            PG8_WAIT_L(0); PG8_BAR; PG8_MMA(0, 0, At, B0); PG8_MMA(0, 1, At, B1); PG8_BAR; PG8_SCHED;
            if (!hc) PG8_LDA(At, 1, 1); PG8_STAGE(PG8_SB(1, 0), b3, voffB); PG8_STAGE(PG8_SB(1, 1), b3 + hstep, voffB); PG8_STA(PG8_SA(1, 0), a3, 0, g2);
            if (h2) PG8_WAIT_V(6); else PG8_WAIT_V(8);
            PG8_WAIT_L(0); PG8_BAR; if (!hc) { PG8_MMA(1, 0, At, B0); PG8_MMA(1, 1, At, B1); } PG8_BAR; PG8_SCHED;
            } else {
            PG8_LDB(B0, 0, 0); PG8_SCHED; PG8_LDA(At, 0, 0); PG8_STA(PG8_SA(1, 1), a1, 1, gC);
            PG8_WAIT_L(8); PG8_BAR; PG8_WAIT_L(0); PG8_MMA(0, 0, At, B0); PG8_BAR; PG8_SCHED;
            PG8_LDB(B1, 0, 1); PG8_STAGE(PG8_SB(0, 0), b2, voffB);
            PG8_BAR; PG8_WAIT_L(0); PG8_MMA(0, 1, At, B1); PG8_BAR;
            PG8_LDA(At, 0, 1); PG8_STA(PG8_SA(0, 0), a2, 0, g2);
            PG8_BAR; PG8_WAIT_L(0); PG8_MMA(1, 0, At, B0); PG8_BAR; PG8_SCHED;
            PG8_STAGE(PG8_SB(0, 1), b2 + hstep, voffB);
            PG8_WAIT_V(6); PG8_BAR; PG8_MMA(1, 1, At, B1); PG8_BAR;
            PG8_LDB(B0, 1, 0); PG8_SCHED; PG8_LDA(At, 1, 0); PG8_STA(PG8_SA(0, 1), a2, 1, g2);
            PG8_WAIT_L(8); PG8_BAR; PG8_WAIT_L(0); PG8_MMA(0, 0, At, B0); PG8_BAR; PG8_SCHED;
            PG8_LDB(B1, 1, 1); PG8_STAGE(PG8_SB(1, 0), b3, voffB);
            PG8_BAR; PG8_WAIT_L(0); PG8_MMA(0, 1, At, B1); PG8_BAR;
            PG8_LDA(At, 1, 1); PG8_STA(PG8_SA(1, 0), a3, 0, g2);
            PG8_BAR; PG8_WAIT_L(0); PG8_MMA(1, 0, At, B0); PG8_BAR; PG8_SCHED;
            PG8_STAGE(PG8_SB(1, 1), b3 + hstep, voffB);
            PG8_WAIT_V(6); PG8_BAR; PG8_MMA(1, 1, At, B1); PG8_BAR;
            }
        }
        if constexpr (ALIGN_EPI) { if (wr == 0) PG8_BAR; }
        if constexpr (!Epi::AFTER_DRAIN) { E(acc, cur, wr, wc, fr, fq); S.done(cur); }
        if (!has_next) break;
#pragma unroll
        for (int a = 0; a < 2; ++a)
#pragma unroll
            for (int b = 0; b < 2; ++b)
#pragma unroll
                for (int m = 0; m < 4; ++m)
#pragma unroll
                    for (int n = 0; n < 2; ++n) acc[a][b][m][n] = (f32x4){0.f, 0.f, 0.f, 0.f};
        cur = nxt; cA = nA; cB = nB; ++ui;
        if constexpr (GATHER) {
#pragma unroll
            for (int h_ = 0; h_ < 2; ++h_) { gC[h_][0] = gX[h_][0]; gC[h_][1] = gX[h_][1]; } }
        if constexpr (ALIGN_EPI) { if (wr == 1) PG8_BAR; }
    }
    PG8_WAIT_V(0);
    if constexpr (!ALIGN_EPI) { if (wr == 0) PG8_BAR; }
    PG8_BAR;
    if constexpr (Epi::AFTER_DRAIN) { E.fused(acc, cur, wr, wc, fr, fq, lds, wid, lane); S.done(cur); }
#undef PG8_SA
#undef PG8_STA
#undef PG8_ROWIDS
#undef PG8_ROWFIX
#undef PG8_SB
#undef PG8_STAGE
#undef PG8_LDA
#undef PG8_LDB
#undef PG8_MMA
#undef PG8_WAIT_V
#undef PG8_WAIT_L
#undef PG8_BAR
#undef PG8_SCHED
}
}

#include <hip/hip_bf16.h>
#include <cmath>
namespace attn_body {
using bf16=__hip_bfloat16;
using bf16x8=__attribute__((ext_vector_type(8)))short;
using s16x4=__attribute__((ext_vector_type(4)))short;
using f32x16=__attribute__((ext_vector_type(16)))float;
using u32x4=__attribute__((ext_vector_type(4)))unsigned;
constexpr int BATCH=2,NHEAD=16,SEQ=8192,D=64,DM=NHEAD*D;
constexpr int NW=8,QBLK=32,QB=QBLK*NW,KVBLK=64,NQB=SEQ/QB;
constexpr int ATTN_PITCH=DM, ATTN_UNIT_ROWS=QB;
__device__ __forceinline__ int crow(int r,int hi){return (r&3)+8*(r>>2)+4*hi;}
#define SBAR() __builtin_amdgcn_sched_barrier(0)
__device__ __forceinline__ void cmask(f32x16&p0,f32x16&p1,int jb,int qrel,int hi){
  const float NEG=-INFINITY; int kb=64*jb+4*hi;
  #pragma unroll
  for(int r=0;r<16;++r){int kv=kb+(r&3)+8*(r>>2); if(kv>qrel)p0[r]=NEG; if(kv+32>qrel)p1[r]=NEG;}
}

constexpr int NSLOT=3, SLOTB=8192;
constexpr int LDS_K=0, LDS_V=NSLOT*SLOTB, LDS_WS=2*NSLOT*SLOTB, LDS_OST=LDS_WS+NW*64*4, LDS_BYTES=LDS_OST+NW*4096;
constexpr float C2=0.125f*1.4426950408889634f;
__device__ __forceinline__ void glds16(const void*gsrc,unsigned lds_dst){unsigned keep;
  asm volatile("s_mov_b32 %0, m0\n\ts_mov_b32 m0, %2\n\ts_nop 0\n\tglobal_load_lds_dwordx4 %1, off\n\ts_mov_b32 m0, %0":"=&s"(keep):"v"(gsrc),"s"(lds_dst):"memory");}
__device__ __forceinline__ float max3f(float a,float b,float c){float r;asm("v_max3_f32 %0, %1, %2, %3":"=v"(r):"v"(a),"v"(b),"v"(c));return r;}
__device__ __forceinline__ float max2f(float a,float b){float r;asm("v_max_f32_e32 %0, %1, %2":"=v"(r):"v"(a),"v"(b));return r;}
__device__ __forceinline__ float fadd_s(float a,float b){float r;asm("v_add_f32_e32 %0, %1, %2":"=v"(r):"v"(a),"v"(b));return r;}
__device__ __forceinline__ float fsub_s(float a,float b){float r;asm("v_sub_f32_e32 %0, %1, %2":"=v"(r):"v"(a),"v"(b));return r;}
typedef float f32x2_t __attribute__((ext_vector_type(2))); typedef __bf16 bf16x2_t __attribute__((ext_vector_type(2)));
__device__ __forceinline__ unsigned cvtpk_s(float lo,float hi){f32x2_t v={lo,hi};bf16x2_t b=__builtin_convertvector(v,bf16x2_t);return __builtin_bit_cast(unsigned,b);}
#define WAIT_BAR(N) asm volatile("s_waitcnt vmcnt(" #N ") lgkmcnt(0)\n\ts_barrier":::"memory")

__device__ __forceinline__ void qkt(f32x16&p0,f32x16&p1,const char*Kslot,const bf16x8*qr,const f32x16&negm,int r32,int hi){
  const char*kb=Kslot+hi*1024+r32*16;
  #pragma unroll
  for(int d0=0;d0<4;++d0){
    const bf16x8 b0=*reinterpret_cast<const bf16x8*>(kb+d0*2048);
    const bf16x8 b1=*reinterpret_cast<const bf16x8*>(kb+d0*2048+512);
    if(d0==0){p0=__builtin_amdgcn_mfma_f32_32x32x16_bf16(b0,qr[0],negm,0,0,0);p1=__builtin_amdgcn_mfma_f32_32x32x16_bf16(b1,qr[0],negm,0,0,0);}
    else{p0=__builtin_amdgcn_mfma_f32_32x32x16_bf16(b0,qr[d0],p0,0,0,0);p1=__builtin_amdgcn_mfma_f32_32x32x16_bf16(b1,qr[d0],p1,0,0,0);}}
}
typedef __attribute__((address_space(3))) const char* lds_cptr;
typedef short v4i16_t __attribute__((ext_vector_type(4)));
__device__ __forceinline__ void kload8(bf16x8*kf,lds_cptr kp){
  kf[0]=*(const __attribute__((address_space(3))) bf16x8*)(kp);      kf[1]=*(const __attribute__((address_space(3))) bf16x8*)(kp+512);
  kf[2]=*(const __attribute__((address_space(3))) bf16x8*)(kp+2048); kf[3]=*(const __attribute__((address_space(3))) bf16x8*)(kp+2560);
  kf[4]=*(const __attribute__((address_space(3))) bf16x8*)(kp+4096); kf[5]=*(const __attribute__((address_space(3))) bf16x8*)(kp+4608);
  kf[6]=*(const __attribute__((address_space(3))) bf16x8*)(kp+6144); kf[7]=*(const __attribute__((address_space(3))) bf16x8*)(kp+6656);
}
__device__ __forceinline__ void kload2(bf16x8*kf,lds_cptr kp,int j){ kf[2*j]=*(const __attribute__((address_space(3))) bf16x8*)(kp+j*2048); kf[2*j+1]=*(const __attribute__((address_space(3))) bf16x8*)(kp+j*2048+512); }
__device__ __forceinline__ s16x4 vtr(lds_cptr p){ return __builtin_bit_cast(s16x4,__builtin_amdgcn_ds_read_tr16_b64_v4i16((__attribute__((address_space(3))) v4i16_t*)p)); }
__device__ __forceinline__ float rowmax(const f32x16&p0,const f32x16&p1){
  float a=max3f(p0[0],p0[1],p1[0]),b=max3f(p0[2],p0[3],p1[1]);a=max3f(a,p1[2],p1[3]);
  #pragma unroll
  for(int r=4;r<16;r+=4){a=max3f(a,p0[r],p0[r+1]);b=max3f(b,p0[r+2],p0[r+3]);a=max3f(a,p1[r],p1[r+1]);b=max3f(b,p1[r+2],p1[r+3]);}
  const float m=max2f(a,b);
  auto rr=__builtin_amdgcn_permlane32_swap(__float_as_uint(m),__float_as_uint(m),false,false);
  return max2f(__uint_as_float(rr[0]),__uint_as_float(rr[1]));
}
__device__ __forceinline__ void pv(f32x16*o,int vb,bf16x8 pa0,bf16x8 pa1,bf16x8 pa2,bf16x8 pa3){
  #pragma unroll
  for(int d0=0;d0<2;++d0){s16x4 lo[4],hi[4];
    #pragma unroll
    for(int ks=0;ks<4;++ks){
      asm volatile("ds_read_b64_tr_b16 %0,%1 offset:%c2":"=&v"(lo[ks]):"v"(vb),"i"(d0*4096+ks*1024):"memory");
      asm volatile("ds_read_b64_tr_b16 %0,%1 offset:%c2":"=&v"(hi[ks]):"v"(vb),"i"(d0*4096+ks*1024+512):"memory");}
    asm volatile("s_waitcnt lgkmcnt(0)":::"memory");SBAR();
    #define PK(k) (bf16x8){lo[k][0],lo[k][1],lo[k][2],lo[k][3],hi[k][0],hi[k][1],hi[k][2],hi[k][3]}
    o[d0]=__builtin_amdgcn_mfma_f32_32x32x16_bf16(pa0,PK(0),o[d0],0,0,0);
    o[d0]=__builtin_amdgcn_mfma_f32_32x32x16_bf16(pa1,PK(1),o[d0],0,0,0);
    o[d0]=__builtin_amdgcn_mfma_f32_32x32x16_bf16(pa2,PK(2),o[d0],0,0,0);
    o[d0]=__builtin_amdgcn_mfma_f32_32x32x16_bf16(pa3,PK(3),o[d0],0,0,0);
    #undef PK
  }
}

#ifndef ATTN_STORE16
#define ATTN_STORE16(p,v) (*(u32x4*)(p)=(v))
#endif
template<int THRL> __device__ __forceinline__ void attn_unit(int b,int h,int qb,int hv,const bf16*Q,const bf16*__restrict__ K,const bf16*__restrict__ V,bf16*O,char*shm){
  const int lane=lane_now(),r32=lane&31,hi=lane>>5; const int wid=wave_now(shm);
  const long rowbase=(long)b*SEQ; const int q0=qb*QB;
  const bf16*Qw=Q+(rowbase+q0+wid*QBLK)*DM+h*D;
  const bf16*Kh=K+rowbase*DM+h*D,*Vh=V+rowbase*DM+hv*D;
  const unsigned lds0=(unsigned)(uintptr_t)shm;
  float*wsf=(float*)(shm+LDS_WS)+wid*64;
  const bf16*ksrc=Kh+(long)lane*DM+wid*8;
  const bf16*vsrc=Vh+(long)(16*(wid&3)+(lane>>2))*DM+(wid>>2)*32+(lane&3)*8;
  const unsigned kdst=lds0+LDS_K+wid*1024, vdst=lds0+LDS_V+wid*1024;
  #define DMA_K(t,slot) glds16(ksrc+(long)(t)*KVBLK*DM,(unsigned)__builtin_amdgcn_readfirstlane(kdst+(slot)))
  #define DMA_V(t,slot) glds16(vsrc+(long)(t)*KVBLK*DM,(unsigned)__builtin_amdgcn_readfirstlane(vdst+(slot)))
  const int vb0=(int)(lds0+LDS_V)+((lane>>4)&1)*32+(lane&3)*8+(4*hi+((lane&15)>>2))*64;
  const char*Kbase=shm+LDS_K; bf16x8 kf[8];
  const lds_cptr shm3=(lds_cptr)shm; const lds_cptr kp0=shm3+LDS_K+hi*1024+r32*16; const lds_cptr vp0=shm3+LDS_V+((lane>>4)&1)*32+(lane&3)*8+(4*hi+((lane&15)>>2))*64;
  const int NT=(q0+QB)/KVBLK;
  DMA_K(0,0);DMA_V(0,0);DMA_K(1,SLOTB);
  bf16x8 qr[4];
  #pragma unroll
  for(int d0=0;d0<4;++d0)qr[d0]=*reinterpret_cast<const bf16x8*>(&Qw[(long)r32*DM+d0*16+hi*8]);
  float mhat=0.f,l_reg=0.f;f32x16 o[2];f32x16 negm; { float zz; asm volatile("v_mov_b32 %0, 0":"=v"(zz)); _Pragma("unroll") for(int r=0;r<16;++r){o[0][r]=zz;o[1][r]=zz;negm[r]=zz;} } asm volatile("":"+v"(negm));
  const int qrel=wid*QBLK+r32;
  #define CMASK(P0,P1,t) do{int jb_=(t)-(NT-4); if(jb_>=0)cmask(P0,P1,jb_,qrel,hi);}while(0)
  bool resc=false;
  #define START(P0,P1) do{ const float rm=rowmax(P0,P1); resc=false; \
    { const float dl=rm; mhat=fadd_s(mhat,dl); \
      _Pragma("unroll") for(int r=0;r<16;++r){P0[r]=fsub_s(P0[r],dl);P1[r]=fsub_s(P1[r],dl);} \
      _Pragma("unroll") for(int r=0;r<16;++r)negm[r]=-mhat; asm volatile("":"+v"(negm)); } \
    _Pragma("unroll") for(int r=0;r<16;++r)P0[r]=__builtin_amdgcn_exp2f(P0[r]); }while(0)
  #define RESC() do{ if(resc){ asm volatile("s_waitcnt lgkmcnt(0)":::"memory"); \
      _Pragma("unroll") for(int d_=0;d_<2;++d_) _Pragma("unroll") for(int r=0;r<16;++r)o[d_][r]*=wsf[crow(r,hi)]; } }while(0)
  f32x16 pA0,pA1,pB0,pB1;
  int sl_prev=0,sl_cur=0,sl_next=SLOTB;
  #define ROT() do{sl_prev=sl_cur;sl_cur=sl_next;sl_next=(sl_next==(NSLOT-1)*SLOTB)?0:sl_next+SLOTB;}while(0)
  DMA_K(2,2*SLOTB);
  WAIT_BAR(3);
  qkt(pA0,pA1,Kbase,qr,negm,r32,hi);asm volatile("s_nop 15\n\ts_nop 7":"+v"(pA0),"+v"(pA1));CMASK(pA0,pA1,0);
  START(pA0,pA1);
  _Pragma("unroll") for(int r=0;r<16;++r)pA1[r]=__builtin_amdgcn_exp2f(pA1[r]);
  WAIT_BAR(0);
  DMA_K(3,0);DMA_V(1,SLOTB);
  ROT();
  kload8(kf,kp0+sl_cur);
  WAIT_BAR(2);
  s16x4 vlo[8],vhi[8]; u32x4 pw0,pw1,pw2,pw3;
  #define PKW(P,B) cvtpk_s(P[B],P[B+1])
  #define PAF(k) __builtin_bit_cast(bf16x8,pw##k)
  #define VFR(i) (bf16x8){vlo[i][0],vlo[i][1],vlo[i][2],vlo[i][3],vhi[i][0],vhi[i][1],vhi[i][2],vhi[i][3]}
  #define PIN(x) asm volatile("":"+v"(x))
  #define MX3(a,b,c) __builtin_fmaxf(__builtin_fmaxf((a),(b)),(c))
  #define GAPA(MF,A0,A1,A2,A3,W0,W1,PW) do{ MF; sacc+=A0; sacc+=A1; sacc+=A2; sacc+=A3; PIN(sacc); W0; W1; PIN(PW); SBAR(); }while(0)
  #define EX(v) __builtin_amdgcn_exp2f(v)
  #define GAPB(MF,X,B) do{ MF; X[B]=EX(X[B]); X[B+1]=EX(X[B+1]); X[B+2]=EX(X[B+2]); X[B+3]=EX(X[B+3]); PIN(X); SBAR(); }while(0)
  #define VRD(i) do{ vlo[i]=vtr(vp_+(((i)>>2)*4096+((i)&3)*1024)); vhi[i]=vtr(vp_+(((i)>>2)*4096+((i)&3)*1024+512)); }while(0)
  #define KRD(G,j) do{ if(G){ kload2(kf,kp0+sl_next,j); SBAR(); } }while(0)
  #define STEP(C0,C1,P0,P1,t,GK,GV,GL) do{ SBAR(); \
    const lds_cptr vp_=vp0+sl_prev; \
    VRD(0); SBAR(); float sacc=(P0[0]+P0[1]); \
    GAPA(C0=__builtin_amdgcn_mfma_f32_32x32x16_bf16(kf[0],qr[0],negm,0,0,0), P0[2],P0[3],P0[4],P0[5],     pw0[0]=PKW(P0,0), pw0[1]=PKW(P0,2), pw0); \
    VRD(4); SBAR(); GAPA(C1=__builtin_amdgcn_mfma_f32_32x32x16_bf16(kf[1],qr[0],negm,0,0,0), P0[6],P0[7],P0[8],P0[9],     pw0[2]=PKW(P0,4), pw0[3]=PKW(P0,6), pw0); \
    VRD(1); SBAR(); GAPA(C0=__builtin_amdgcn_mfma_f32_32x32x16_bf16(kf[2],qr[1],C0,0,0,0),   P0[10],P0[11],P0[12],P0[13], pw1[0]=PKW(P0,8), pw1[1]=PKW(P0,10), pw1); \
    VRD(5); SBAR(); GAPA(C1=__builtin_amdgcn_mfma_f32_32x32x16_bf16(kf[3],qr[1],C1,0,0,0),   P0[14],P0[15],P1[0],P1[1],   pw1[2]=PKW(P0,12),pw1[3]=PKW(P0,14), pw1); \
    VRD(2); SBAR(); GAPA(C0=__builtin_amdgcn_mfma_f32_32x32x16_bf16(kf[4],qr[2],C0,0,0,0),   P1[2],P1[3],P1[4],P1[5],     pw2[0]=PKW(P1,0), pw2[1]=PKW(P1,2), pw2); \
    VRD(6); SBAR(); GAPA(C1=__builtin_amdgcn_mfma_f32_32x32x16_bf16(kf[5],qr[2],C1,0,0,0),   P1[6],P1[7],P1[8],P1[9],     pw2[2]=PKW(P1,4), pw2[3]=PKW(P1,6), pw2); \
    VRD(3); SBAR(); GAPA(C0=__builtin_amdgcn_mfma_f32_32x32x16_bf16(kf[6],qr[3],C0,0,0,0),   P1[10],P1[11],P1[12],P1[13], pw3[0]=PKW(P1,8), pw3[1]=PKW(P1,10), pw3); \
    VRD(7); SBAR(); GAPA(C1=__builtin_amdgcn_mfma_f32_32x32x16_bf16(kf[7],qr[3],C1,0,0,0),   P1[14],P1[15],0.f,0.f,       pw3[2]=PKW(P1,12),pw3[3]=PKW(P1,14), pw3); \
    l_reg+=sacc; \
    if(GK){DMA_K((t)+3,sl_cur);} if(GV){DMA_V((t)+1,sl_next);} \
    CMASK(C0,C1,t); \
    { float a=MX3(C0[0],C0[1],C1[0]),b=MX3(C0[2],C0[3],C1[1]); a=MX3(a,C1[2],C1[3]); \
      _Pragma("unroll") for(int r=4;r<16;r+=4){a=MX3(a,C0[r],C0[r+1]);b=MX3(b,C0[r+2],C0[r+3]);a=MX3(a,C1[r],C1[r+1]);b=MX3(b,C1[r+2],C1[r+3]);} \
      float rm=__builtin_fmaxf(a,b); { auto rr=__builtin_amdgcn_permlane32_swap(__float_as_uint(rm),__float_as_uint(rm),false,false); rm=__builtin_fmaxf(__uint_as_float(rr[0]),__uint_as_float(rr[1])); } \
      resc=false; \
      if(__builtin_expect(__any(rm>(float)THRL),0)){ const float dl=__builtin_fmaxf(rm,0.f); mhat+=dl; \
        _Pragma("unroll") for(int r=0;r<16;++r){C0[r]-=dl;C1[r]-=dl;} \
        _Pragma("unroll") for(int r=0;r<16;++r)negm[r]=-mhat; asm volatile("":"+v"(negm)); \
        const float f=__builtin_amdgcn_exp2f(-dl); l_reg*=f; if(hi==0)wsf[r32]=f; resc=true; } } \
    SBAR(); \
    GAPB(o[0]=__builtin_amdgcn_mfma_f32_32x32x16_bf16(PAF(0),VFR(0),o[0],0,0,0), C0,0); \
    GAPB(o[1]=__builtin_amdgcn_mfma_f32_32x32x16_bf16(PAF(0),VFR(4),o[1],0,0,0), C0,4); \
    KRD(GL,0); GAPB(o[0]=__builtin_amdgcn_mfma_f32_32x32x16_bf16(PAF(1),VFR(1),o[0],0,0,0), C0,8); \
    KRD(GL,1); GAPB(o[1]=__builtin_amdgcn_mfma_f32_32x32x16_bf16(PAF(1),VFR(5),o[1],0,0,0), C0,12); \
    KRD(GL,2); GAPB(o[0]=__builtin_amdgcn_mfma_f32_32x32x16_bf16(PAF(2),VFR(2),o[0],0,0,0), C1,0); \
    KRD(GL,3); GAPB(o[1]=__builtin_amdgcn_mfma_f32_32x32x16_bf16(PAF(2),VFR(6),o[1],0,0,0), C1,4); \
    GAPB(o[0]=__builtin_amdgcn_mfma_f32_32x32x16_bf16(PAF(3),VFR(3),o[0],0,0,0), C1,8); \
    GAPB(o[1]=__builtin_amdgcn_mfma_f32_32x32x16_bf16(PAF(3),VFR(7),o[1],0,0,0), C1,12); \
    }while(0)
  int t=1;
  #undef CMASK
  #define CMASK(P0,P1,t) do{}while(0)
  for(;t+5<NT;t+=2){
    STEP(pB0,pB1,pA0,pA1,t,true,true,true);     WAIT_BAR(2); RESC(); ROT();
    STEP(pA0,pA1,pB0,pB1,t+1,true,true,true);   WAIT_BAR(2); RESC(); ROT();
  }
  #undef CMASK
  #define CMASK(P0,P1,t) do{int jb_=(t)-(NT-4); if(jb_>=0)cmask(P0,P1,jb_,qrel,hi);}while(0)
  #define ENDW(tt) do{ if((tt)+3<NT){WAIT_BAR(2);} else if((tt)+2<NT){WAIT_BAR(1);} else {WAIT_BAR(0);} }while(0)
  for(;t+1<NT;t+=2){
    STEP(pB0,pB1,pA0,pA1,t,(t+3<NT),(t+1<NT),(t+1<NT));       ENDW(t);   RESC(); ROT();
    STEP(pA0,pA1,pB0,pB1,t+1,(t+4<NT),(t+2<NT),(t+2<NT));     ENDW(t+1); RESC(); ROT();
  }
  STEP(pB0,pB1,pA0,pA1,NT-1,false,false,false); RESC();
  { float sacc=pB0[0]+pB0[1]; _Pragma("unroll") for(int r=2;r<16;++r)sacc+=pB0[r]; _Pragma("unroll") for(int r=0;r<16;++r)sacc+=pB1[r]; l_reg+=sacc;
    pw0=(u32x4){PKW(pB0,0),PKW(pB0,2),PKW(pB0,4),PKW(pB0,6)};pw1=(u32x4){PKW(pB0,8),PKW(pB0,10),PKW(pB0,12),PKW(pB0,14)};pw2=(u32x4){PKW(pB1,0),PKW(pB1,2),PKW(pB1,4),PKW(pB1,6)};pw3=(u32x4){PKW(pB1,8),PKW(pB1,10),PKW(pB1,12),PKW(pB1,14)};
    SBAR(); pv(o,vb0+sl_cur,PAF(0),PAF(1),PAF(2),PAF(3)); }
  #undef PKW
  #undef PAF
  #undef VFR
  #undef PIN
  #undef MX3
  #undef GAPA
  #undef GAPB
  #undef EX
  #undef VRD
  #undef KRD
  #undef STEP
  #undef ENDW
  {auto rr=__builtin_amdgcn_permlane32_swap(__float_as_uint(l_reg),__float_as_uint(l_reg),false,false);l_reg=__uint_as_float(rr[0])+__uint_as_float(rr[1]);}
  if(hi==0)wsf[32+r32]=l_reg;asm volatile("s_waitcnt lgkmcnt(0)":::"memory");
  float rli[16];
  #pragma unroll
  for(int r=0;r<16;++r)rli[r]=__builtin_amdgcn_rcpf(wsf[32+crow(r,hi)]);
  bf16*Ow=O+(rowbase+q0+wid*QBLK)*DM+hv*D;
  { bf16*stg=(bf16*)(shm+LDS_OST)+wid*2048;
    #pragma unroll
    for(int r=0;r<16;++r){const int orow=crow(r,hi);
      #pragma unroll
      for(int d0=0;d0<2;++d0)stg[orow*64+d0*32+r32]=__float2bfloat16(o[d0][r]*rli[r]);}
    asm volatile("s_waitcnt lgkmcnt(0)":::"memory");
    #pragma unroll
    for(int i=0;i<4;++i){const int row=i*8+(lane>>3),ch=lane&7; const u32x4 v=*(const u32x4*)(stg+row*64+ch*8); ATTN_STORE16(Ow+(long)row*DM+ch*8,v);} }
  asm volatile("s_waitcnt lgkmcnt(0)\n\ts_barrier":::"memory");
  #undef DMA_K
  #undef DMA_V
  #undef CMASK
  #undef START
  #undef RESC
  #undef ROT
}
constexpr int ATTN_LDS_BYTES=LDS_BYTES;
#undef SBAR
#undef WAIT_BAR
}

namespace attn128 {
using attn_body::bf16; using attn_body::bf16x8; using attn_body::s16x4; using attn_body::f32x16; using attn_body::u32x4;
constexpr int SEQ_ = 8192, DMP = 1024, NW = 8, QBLK = 32, QB = 256, KVBLK = 64;
constexpr int KSLOT = 8192, VSLOT = 16384, NBUF = 3;
constexpr int L_K = 0, L_V = NBUF * KSLOT, L_WS = L_V + NBUF * VSLOT, L_OST = L_WS + NW * 64 * 4, L_BYTES = L_OST + NW * 8192;
#define A128_SBAR() __builtin_amdgcn_sched_barrier(0)
#define A128_WAITL(n) asm volatile("s_waitcnt lgkmcnt(" #n ")" ::: "memory")
__device__ __forceinline__ void pv128(f32x16* o, int vb, bf16x8 pa0, bf16x8 pa1, bf16x8 pa2, bf16x8 pa3) {
    s16x4 lo0, hi0, lo1, hi1, lo2, hi2, lo3, hi3, lo4, hi4;
#define A128_RDF(i, LO, HI) do { asm volatile("ds_read_b64_tr_b16 %0,%1 offset:%c2" : "=&v"(LO) : "v"(vb), "i"(((i) & 3) * 4096 + ((i) >> 2) * 1024) : "memory"); \
                                 asm volatile("ds_read_b64_tr_b16 %0,%1 offset:%c2" : "=&v"(HI) : "v"(vb), "i"(((i) & 3) * 4096 + ((i) >> 2) * 1024 + 512) : "memory"); } while (0)
#define A128_FR(LO, HI) (bf16x8){LO[0], LO[1], LO[2], LO[3], HI[0], HI[1], HI[2], HI[3]}
#define A128_MF(i, PA, LO, HI) o[(i) & 3] = __builtin_amdgcn_mfma_f32_32x32x16_bf16(PA, A128_FR(LO, HI), o[(i) & 3], 0, 0, 0)
    A128_RDF(0, lo0, hi0); A128_RDF(1, lo1, hi1); A128_RDF(2, lo2, hi2); A128_RDF(3, lo3, hi3);
    A128_RDF(4, lo4, hi4); A128_WAITL(8); A128_SBAR(); A128_MF(0, pa0, lo0, hi0);
    A128_RDF(5, lo0, hi0); A128_WAITL(8); A128_SBAR(); A128_MF(1, pa0, lo1, hi1);
    A128_RDF(6, lo1, hi1); A128_WAITL(8); A128_SBAR(); A128_MF(2, pa0, lo2, hi2);
    A128_RDF(7, lo2, hi2); A128_WAITL(8); A128_SBAR(); A128_MF(3, pa0, lo3, hi3);
    A128_RDF(8, lo3, hi3); A128_WAITL(8); A128_SBAR(); A128_MF(4, pa1, lo4, hi4);
    A128_RDF(9, lo4, hi4); A128_WAITL(8); A128_SBAR(); A128_MF(5, pa1, lo0, hi0);
    A128_RDF(10, lo0, hi0); A128_WAITL(8); A128_SBAR(); A128_MF(6, pa1, lo1, hi1);
    A128_RDF(11, lo1, hi1); A128_WAITL(8); A128_SBAR(); A128_MF(7, pa1, lo2, hi2);
    A128_RDF(12, lo2, hi2); A128_WAITL(8); A128_SBAR(); A128_MF(8, pa2, lo3, hi3);
    A128_RDF(13, lo3, hi3); A128_WAITL(8); A128_SBAR(); A128_MF(9, pa2, lo4, hi4);
    A128_RDF(14, lo4, hi4); A128_WAITL(8); A128_SBAR(); A128_MF(10, pa2, lo0, hi0);
    A128_RDF(15, lo0, hi0); A128_WAITL(8); A128_SBAR(); A128_MF(11, pa2, lo1, hi1);
    A128_WAITL(6); A128_SBAR(); A128_MF(12, pa3, lo2, hi2);
    A128_WAITL(4); A128_SBAR(); A128_MF(13, pa3, lo3, hi3);
    A128_WAITL(2); A128_SBAR(); A128_MF(14, pa3, lo4, hi4);
    A128_WAITL(0); A128_SBAR(); A128_MF(15, pa3, lo0, hi0);
#undef A128_RDF
#undef A128_FR
#undef A128_MF
}
__device__ __forceinline__ void qkt128(f32x16& p0, f32x16& p1, int kb, const bf16x8* qr, const f32x16& negm) {
    bf16x8 k0, k1, k2, k3, k4, k5, k6, k7;
#define A128_RDK(K, OFF) asm volatile("ds_read_b128 %0,%1 offset:%c2" : "=&v"(K) : "v"(kb), "i"(OFF) : "memory")
    A128_RDK(k0, 0); A128_RDK(k1, 512); A128_RDK(k2, 2048); A128_RDK(k3, 2560); A128_RDK(k4, 4096); A128_RDK(k5, 4608); A128_RDK(k6, 6144); A128_RDK(k7, 6656);
    A128_WAITL(7); A128_SBAR(); p0 = __builtin_amdgcn_mfma_f32_32x32x16_bf16(k0, qr[0], negm, 0, 0, 0);
    A128_WAITL(6); A128_SBAR(); p1 = __builtin_amdgcn_mfma_f32_32x32x16_bf16(k1, qr[0], negm, 0, 0, 0);
    A128_WAITL(5); A128_SBAR(); p0 = __builtin_amdgcn_mfma_f32_32x32x16_bf16(k2, qr[1], p0, 0, 0, 0);
    A128_WAITL(4); A128_SBAR(); p1 = __builtin_amdgcn_mfma_f32_32x32x16_bf16(k3, qr[1], p1, 0, 0, 0);
    A128_WAITL(3); A128_SBAR(); p0 = __builtin_amdgcn_mfma_f32_32x32x16_bf16(k4, qr[2], p0, 0, 0, 0);
    A128_WAITL(2); A128_SBAR(); p1 = __builtin_amdgcn_mfma_f32_32x32x16_bf16(k5, qr[2], p1, 0, 0, 0);
    A128_WAITL(1); A128_SBAR(); p0 = __builtin_amdgcn_mfma_f32_32x32x16_bf16(k6, qr[3], p0, 0, 0, 0);
    A128_WAITL(0); A128_SBAR(); p1 = __builtin_amdgcn_mfma_f32_32x32x16_bf16(k7, qr[3], p1, 0, 0, 0);
#undef A128_RDK
    asm volatile("s_nop 15\n\ts_nop 7" : "+v"(p0), "+v"(p1));
}
constexpr int NB2 = 4, L2_K = 0, L2_V = NB2 * KSLOT, L2_WS = L2_V + NB2 * VSLOT, L2_OST = L2_WS + NW * 64 * 4, L2_BYTES = L2_OST + NW * 4096;
template <int THRL> __device__ __forceinline__ void unit2(int b, int hq, int hv, int qb, const bf16* Q, const bf16* __restrict__ K, const bf16* __restrict__ V, bf16* O, char* shm, volatile __attribute__((address_space(3))) unsigned* PRB = nullptr) {
    const int tid = threadIdx.x; int lane = tid & 63; asm volatile("" : "+v"(lane));
    const int r32 = lane & 31, hi = lane >> 5; const int wid = __builtin_amdgcn_readfirstlane(tid >> 6);
    const long rowbase = (long)b * SEQ_; const int q0 = qb * QB;
    const bf16* Qw = Q + (rowbase + q0 + wid * QBLK) * DMP + hq * 64;
    const bf16* Kh = K + rowbase * DMP + hq * 64, * Vh = V + rowbase * DMP + hv * 64;
    const unsigned lds0 = (unsigned)(uintptr_t)shm;
    float* wsf = (float*)(shm + L2_WS) + wid * 64;
    const bf16* ksrc = Kh + (long)lane * DMP + wid * 8;
    const bf16* vsrc = Vh + (long)(16 * (wid & 3) + (lane >> 2)) * DMP + (wid >> 2) * 32 + (lane & 3) * 8;
    const unsigned kdst = lds0 + L2_K + wid * 1024, vdst = lds0 + L2_V + wid * 1024;
#define A128_DMAK(t) attn_body::glds16(ksrc + (long)(t) * KVBLK * DMP, (unsigned)__builtin_amdgcn_readfirstlane(kdst + ((t) & 3) * KSLOT))
#define A128_DMAV(t) do { attn_body::glds16(vsrc + (long)(t) * KVBLK * DMP, (unsigned)__builtin_amdgcn_readfirstlane(vdst + ((t) & 3) * VSLOT)); \
        attn_body::glds16(vsrc + (long)(t) * KVBLK * DMP + 64, (unsigned)__builtin_amdgcn_readfirstlane(vdst + ((t) & 3) * VSLOT + 8192)); } while (0)
    const int vb0 = (int)(lds0 + L2_V) + ((lane >> 4) & 1) * 32 + (lane & 3) * 8 + (4 * hi + ((lane & 15) >> 2)) * 64;
    const int kb0 = (int)(lds0 + L2_K) + hi * 1024 + r32 * 16;
    const int NT = (q0 + QB) / KVBLK;
    A128_DMAK(0); A128_DMAV(0); A128_DMAK(1); A128_DMAV(1); A128_DMAK(2);
    bf16x8 qr[4];
#pragma unroll
    for (int d0 = 0; d0 < 4; ++d0) qr[d0] = *reinterpret_cast<const bf16x8*>(&Qw[(long)r32 * DMP + d0 * 16 + hi * 8]);
    float mhat = 0.f, l_reg = 0.f; f32x16 o[4]; f32x16 negm;
    { float zz; asm volatile("v_mov_b32 %0, 0" : "=v"(zz));
#pragma unroll
      for (int r = 0; r < 16; ++r) { o[0][r] = zz; o[1][r] = zz; o[2][r] = zz; o[3][r] = zz; negm[r] = zz; } }
    const int qrel = wid * QBLK + r32;
    asm volatile("s_waitcnt vmcnt(0) lgkmcnt(0)\n\ts_barrier" ::: "memory");
    u32x4 pw0, pw1, pw2, pw3;
#define A128_ROWMAX(rm) do { float a = fmaxf(fmaxf(c0[0], c0[1]), c1[0]), bb = fmaxf(fmaxf(c0[2], c0[3]), c1[1]); a = fmaxf(fmaxf(a, c1[2]), c1[3]);                    \
          _Pragma("unroll") for (int r = 4; r < 16; r += 4) { a = fmaxf(fmaxf(a, c0[r]), c0[r + 1]); bb = fmaxf(fmaxf(bb, c0[r + 2]), c0[r + 3]); a = fmaxf(fmaxf(a, c1[r]), c1[r + 1]); bb = fmaxf(fmaxf(bb, c1[r + 2]), c1[r + 3]); } \
          rm = fmaxf(a, bb); auto rr = __builtin_amdgcn_permlane32_swap(__float_as_uint(rm), __float_as_uint(rm), false, false); rm = fmaxf(__uint_as_float(rr[0]), __uint_as_float(rr[1])); } while (0)
    { A128_DMAK(3); A128_DMAV(2);
      f32x16 c0, c1; qkt128(c0, c1, kb0, qr, negm);
      { const int jb = 0 - (NT - 4); if (jb >= 0) attn_body::cmask(c0, c1, jb, qrel, hi); }
      float rm; A128_ROWMAX(rm); mhat = rm;
#pragma unroll
      for (int r = 0; r < 16; ++r) { c0[r] -= rm; c1[r] -= rm; negm[r] = -mhat; }
      float sacc = 0.f;
#pragma unroll
      for (int r = 0; r < 16; ++r) { c0[r] = __builtin_amdgcn_exp2f(c0[r]); c1[r] = __builtin_amdgcn_exp2f(c1[r]); }
#pragma unroll
      for (int r = 0; r < 16; ++r) sacc += c0[r] + c1[r];
      l_reg += sacc;
#define A128_PKW(P, B) attn_body::cvtpk_s(P[B], P[B + 1])
      pw0 = (u32x4){A128_PKW(c0, 0), A128_PKW(c0, 2), A128_PKW(c0, 4), A128_PKW(c0, 6)}; pw1 = (u32x4){A128_PKW(c0, 8), A128_PKW(c0, 10), A128_PKW(c0, 12), A128_PKW(c0, 14)};
      pw2 = (u32x4){A128_PKW(c1, 0), A128_PKW(c1, 2), A128_PKW(c1, 4), A128_PKW(c1, 6)}; pw3 = (u32x4){A128_PKW(c1, 8), A128_PKW(c1, 10), A128_PKW(c1, 12), A128_PKW(c1, 14)};
#undef A128_PKW
      asm volatile("s_waitcnt vmcnt(3) lgkmcnt(0)\n\ts_barrier" ::: "memory"); }
#define A128_RDF(i, LO, HI) do { asm volatile("ds_read_b64_tr_b16 %0,%1 offset:%c2" : "=&v"(LO) : "v"(vb), "i"(((i) >> 2) * 4096 + ((i) & 3) * 1024) : "memory"); \
                                 asm volatile("ds_read_b64_tr_b16 %0,%1 offset:%c2" : "=&v"(HI) : "v"(vb), "i"(((i) >> 2) * 4096 + ((i) & 3) * 1024 + 512) : "memory"); } while (0)
#define A128_FR(LO, HI) (bf16x8){LO[0], LO[1], LO[2], LO[3], HI[0], HI[1], HI[2], HI[3]}
#define A128_MF(i, PA, LO, HI) o[(i) >> 2] = __builtin_amdgcn_mfma_f32_32x32x16_bf16(PA, A128_FR(LO, HI), o[(i) >> 2], 0, 0, 0)
    PRB_B(36, PRB); PRBC_B(41, PRB);
    for (int t = 1; t < NT; ++t) {
        if (t + 3 < NT) A128_DMAK(t + 3);
        if (t + 2 < NT) A128_DMAV(t + 2);
        const bf16x8 pa0 = __builtin_bit_cast(bf16x8, pw0), pa1 = __builtin_bit_cast(bf16x8, pw1), pa2 = __builtin_bit_cast(bf16x8, pw2), pa3 = __builtin_bit_cast(bf16x8, pw3);
        u32x4 pn0, pn1, pn2, pn3; float sacc = 0.f; bool resc = false;
        const int vb = vb0 + ((t - 1) & 3) * VSLOT;
        s16x4 lo0, hi0, lo1, hi1, lo2, hi2, lo3, hi3, lo4, hi4;
        A128_RDF(0, lo0, hi0); A128_RDF(1, lo1, hi1); A128_RDF(2, lo2, hi2); A128_RDF(3, lo3, hi3);
        f32x16 c0, c1; qkt128(c0, c1, kb0 + (t & 3) * KSLOT, qr, negm);
        { const int jb = t - (NT - 4); if (__builtin_expect(jb >= 0, 0)) { asm volatile("" ::: "memory"); attn_body::cmask(c0, c1, jb, qrel, hi); } }
        float rmA, rmB, rm;
        A128_RDF(4, lo4, hi4); A128_WAITL(8); A128_SBAR(); A128_MF(0, pa0, lo0, hi0); rmA = fmaxf(fmaxf(c0[0], c0[1]), c1[0]); rmB = fmaxf(fmaxf(c0[2], c0[3]), c1[1]); rmA = fmaxf(fmaxf(rmA, c1[2]), c1[3]); rmA = fmaxf(fmaxf(rmA, c0[4]), c0[5]); rmB = fmaxf(fmaxf(rmB, c0[6]), c0[7]); asm volatile("" : "+v"(rmA), "+v"(rmB)); A128_SBAR();
        A128_RDF(5, lo0, hi0); A128_WAITL(8); A128_SBAR(); A128_MF(1, pa1, lo1, hi1); rmA = fmaxf(fmaxf(rmA, c1[4]), c1[5]); rmB = fmaxf(fmaxf(rmB, c1[6]), c1[7]); rmA = fmaxf(fmaxf(rmA, c0[8]), c0[9]); rmB = fmaxf(fmaxf(rmB, c0[10]), c0[11]); rmA = fmaxf(fmaxf(rmA, c1[8]), c1[9]); asm volatile("" : "+v"(rmA), "+v"(rmB)); A128_SBAR();
        A128_RDF(6, lo1, hi1); A128_WAITL(8); A128_SBAR(); A128_MF(2, pa2, lo2, hi2); rmB = fmaxf(fmaxf(rmB, c1[10]), c1[11]); rmA = fmaxf(fmaxf(rmA, c0[12]), c0[13]); rmB = fmaxf(fmaxf(rmB, c0[14]), c0[15]); rmA = fmaxf(fmaxf(rmA, c1[12]), c1[13]); rmB = fmaxf(fmaxf(rmB, c1[14]), c1[15]); asm volatile("" : "+v"(rmA), "+v"(rmB)); A128_SBAR();
        A128_RDF(7, lo2, hi2); A128_WAITL(8); A128_SBAR(); A128_MF(3, pa3, lo3, hi3); rm = fmaxf(rmA, rmB); { auto rr = __builtin_amdgcn_permlane32_swap(__float_as_uint(rm), __float_as_uint(rm), false, false); rm = fmaxf(__uint_as_float(rr[0]), __uint_as_float(rr[1])); } asm volatile("" : "+v"(rm)); A128_SBAR();
        if (__builtin_expect(__any(rm > (float)THRL), 0)) {
            const float dl = fmaxf(rm, 0.f); mhat += dl;
#pragma unroll
            for (int r = 0; r < 16; ++r) { c0[r] -= dl; c1[r] -= dl; negm[r] = -mhat; }
            const float f = __builtin_amdgcn_exp2f(-dl); l_reg *= f; if (hi == 0) wsf[r32] = f; resc = true; asm volatile("s_waitcnt lgkmcnt(0)" ::: "memory"); }
        A128_RDF(8, lo3, hi3); A128_WAITL(8); A128_SBAR(); A128_MF(4, pa0, lo4, hi4); { const float e0_ = __builtin_amdgcn_exp2f(c0[0]), e1_ = __builtin_amdgcn_exp2f(c0[1]); sacc += e0_; sacc += e1_; pn0[0] = attn_body::cvtpk_s(e0_, e1_); asm volatile("" : "+v"(sacc), "+v"(pn0)); } { const float e0_ = __builtin_amdgcn_exp2f(c0[2]), e1_ = __builtin_amdgcn_exp2f(c0[3]); sacc += e0_; sacc += e1_; pn0[1] = attn_body::cvtpk_s(e0_, e1_); asm volatile("" : "+v"(sacc), "+v"(pn0)); } A128_SBAR();
        A128_RDF(9, lo4, hi4); A128_WAITL(8); A128_SBAR(); A128_MF(5, pa1, lo0, hi0); { const float e0_ = __builtin_amdgcn_exp2f(c0[4]), e1_ = __builtin_amdgcn_exp2f(c0[5]); sacc += e0_; sacc += e1_; pn0[2] = attn_body::cvtpk_s(e0_, e1_); asm volatile("" : "+v"(sacc), "+v"(pn0)); } A128_SBAR();
        A128_RDF(10, lo0, hi0); A128_WAITL(8); A128_SBAR(); A128_MF(6, pa2, lo1, hi1); { const float e0_ = __builtin_amdgcn_exp2f(c0[6]), e1_ = __builtin_amdgcn_exp2f(c0[7]); sacc += e0_; sacc += e1_; pn0[3] = attn_body::cvtpk_s(e0_, e1_); asm volatile("" : "+v"(sacc), "+v"(pn0)); } A128_SBAR();
        A128_RDF(11, lo1, hi1); A128_WAITL(8); A128_SBAR(); A128_MF(7, pa3, lo2, hi2); { const float e0_ = __builtin_amdgcn_exp2f(c0[8]), e1_ = __builtin_amdgcn_exp2f(c0[9]); sacc += e0_; sacc += e1_; pn1[0] = attn_body::cvtpk_s(e0_, e1_); asm volatile("" : "+v"(sacc), "+v"(pn1)); } { const float e0_ = __builtin_amdgcn_exp2f(c0[10]), e1_ = __builtin_amdgcn_exp2f(c0[11]); sacc += e0_; sacc += e1_; pn1[1] = attn_body::cvtpk_s(e0_, e1_); asm volatile("" : "+v"(sacc), "+v"(pn1)); } A128_SBAR();
        A128_RDF(12, lo2, hi2); A128_WAITL(8); A128_SBAR(); A128_MF(8, pa0, lo3, hi3); { const float e0_ = __builtin_amdgcn_exp2f(c0[12]), e1_ = __builtin_amdgcn_exp2f(c0[13]); sacc += e0_; sacc += e1_; pn1[2] = attn_body::cvtpk_s(e0_, e1_); asm volatile("" : "+v"(sacc), "+v"(pn1)); } A128_SBAR();
        A128_RDF(13, lo3, hi3); A128_WAITL(8); A128_SBAR(); A128_MF(9, pa1, lo4, hi4); { const float e0_ = __builtin_amdgcn_exp2f(c0[14]), e1_ = __builtin_amdgcn_exp2f(c0[15]); sacc += e0_; sacc += e1_; pn1[3] = attn_body::cvtpk_s(e0_, e1_); asm volatile("" : "+v"(sacc), "+v"(pn1)); } A128_SBAR();
        A128_RDF(14, lo4, hi4); A128_WAITL(8); A128_SBAR(); A128_MF(10, pa2, lo0, hi0); { const float e0_ = __builtin_amdgcn_exp2f(c1[0]), e1_ = __builtin_amdgcn_exp2f(c1[1]); sacc += e0_; sacc += e1_; pn2[0] = attn_body::cvtpk_s(e0_, e1_); asm volatile("" : "+v"(sacc), "+v"(pn2)); } { const float e0_ = __builtin_amdgcn_exp2f(c1[2]), e1_ = __builtin_amdgcn_exp2f(c1[3]); sacc += e0_; sacc += e1_; pn2[1] = attn_body::cvtpk_s(e0_, e1_); asm volatile("" : "+v"(sacc), "+v"(pn2)); } A128_SBAR();
        A128_RDF(15, lo0, hi0); A128_WAITL(8); A128_SBAR(); A128_MF(11, pa3, lo1, hi1); { const float e0_ = __builtin_amdgcn_exp2f(c1[4]), e1_ = __builtin_amdgcn_exp2f(c1[5]); sacc += e0_; sacc += e1_; pn2[2] = attn_body::cvtpk_s(e0_, e1_); asm volatile("" : "+v"(sacc), "+v"(pn2)); } A128_SBAR();
        A128_WAITL(6); A128_SBAR(); A128_MF(12, pa0, lo2, hi2); { const float e0_ = __builtin_amdgcn_exp2f(c1[6]), e1_ = __builtin_amdgcn_exp2f(c1[7]); sacc += e0_; sacc += e1_; pn2[3] = attn_body::cvtpk_s(e0_, e1_); asm volatile("" : "+v"(sacc), "+v"(pn2)); } A128_SBAR();
        A128_WAITL(4); A128_SBAR(); A128_MF(13, pa1, lo3, hi3); { const float e0_ = __builtin_amdgcn_exp2f(c1[8]), e1_ = __builtin_amdgcn_exp2f(c1[9]); sacc += e0_; sacc += e1_; pn3[0] = attn_body::cvtpk_s(e0_, e1_); asm volatile("" : "+v"(sacc), "+v"(pn3)); } { const float e0_ = __builtin_amdgcn_exp2f(c1[10]), e1_ = __builtin_amdgcn_exp2f(c1[11]); sacc += e0_; sacc += e1_; pn3[1] = attn_body::cvtpk_s(e0_, e1_); asm volatile("" : "+v"(sacc), "+v"(pn3)); } A128_SBAR();
        A128_WAITL(2); A128_SBAR(); A128_MF(14, pa2, lo4, hi4); { const float e0_ = __builtin_amdgcn_exp2f(c1[12]), e1_ = __builtin_amdgcn_exp2f(c1[13]); sacc += e0_; sacc += e1_; pn3[2] = attn_body::cvtpk_s(e0_, e1_); asm volatile("" : "+v"(sacc), "+v"(pn3)); } A128_SBAR();
        A128_WAITL(0); A128_SBAR(); A128_MF(15, pa3, lo0, hi0); { const float e0_ = __builtin_amdgcn_exp2f(c1[14]), e1_ = __builtin_amdgcn_exp2f(c1[15]); sacc += e0_; sacc += e1_; pn3[3] = attn_body::cvtpk_s(e0_, e1_); asm volatile("" : "+v"(sacc), "+v"(pn3)); } A128_SBAR();
        l_reg += sacc;
        if (resc) { asm volatile("s_waitcnt lgkmcnt(0)" ::: "memory");
#pragma unroll
            for (int r = 0; r < 16; ++r) { const float fr = wsf[attn_body::crow(r, hi)]; o[0][r] *= fr; o[1][r] *= fr; o[2][r] *= fr; o[3][r] *= fr; } }
        pw0 = pn0; pw1 = pn1; pw2 = pn2; pw3 = pn3;
        if (t + 3 < NT) asm volatile("s_waitcnt vmcnt(6) lgkmcnt(0)\n\ts_barrier" ::: "memory");
        else if (t + 2 < NT) asm volatile("s_waitcnt vmcnt(5) lgkmcnt(0)\n\ts_barrier" ::: "memory");
        else if (t + 1 < NT) asm volatile("s_waitcnt vmcnt(2) lgkmcnt(0)\n\ts_barrier" ::: "memory");
        else asm volatile("s_waitcnt vmcnt(0) lgkmcnt(0)\n\ts_barrier" ::: "memory");
    }
    PRB_E(36, PRB); PRBC_E(41, PRB);
#undef A128_RDF
#undef A128_FR
#undef A128_MF
    pv128(o, vb0 + ((NT - 1) & 3) * VSLOT, __builtin_bit_cast(bf16x8, pw0), __builtin_bit_cast(bf16x8, pw1), __builtin_bit_cast(bf16x8, pw2), __builtin_bit_cast(bf16x8, pw3));
    { auto rr = __builtin_amdgcn_permlane32_swap(__float_as_uint(l_reg), __float_as_uint(l_reg), false, false); l_reg = __uint_as_float(rr[0]) + __uint_as_float(rr[1]); }
    int lne = lane; asm volatile("" : "+v"(lne));
    const int r32e = lne & 31, hie = lne >> 5;
    if (hie == 0) wsf[32 + r32e] = l_reg; asm volatile("s_waitcnt lgkmcnt(0)" ::: "memory");
    float rli[16];
#pragma unroll
    for (int r = 0; r < 16; ++r) rli[r] = __builtin_amdgcn_rcpf(wsf[32 + attn_body::crow(r, hie)]);
    bf16* Ow = O + (rowbase + q0 + wid * QBLK) * DMP + hv * 64;
    { bf16* stg = (bf16*)(shm + L2_OST) + wid * 2048;
#pragma unroll
      for (int half = 0; half < 2; ++half) {
#pragma unroll
          for (int r = 0; r < 16; ++r) { const int orow = attn_body::crow(r, hie);
#pragma unroll
              for (int d0 = 0; d0 < 2; ++d0) stg[orow * 64 + d0 * 32 + r32e] = __float2bfloat16(o[2 * half + d0][r] * rli[r]); }
          asm volatile("s_waitcnt lgkmcnt(0)" ::: "memory");
#pragma unroll
          for (int i = 0; i < 4; ++i) { const int row = i * 8 + (lne >> 3), ch = lne & 7; const u32x4 v = *(const u32x4*)(stg + row * 64 + ch * 8); *(u32x4*)(Ow + (long)row * DMP + half * 64 + ch * 8) = v; }
          asm volatile("s_waitcnt lgkmcnt(0)" ::: "memory"); } }
    asm volatile("s_waitcnt lgkmcnt(0)\n\ts_barrier" ::: "memory");
#undef A128_DMAK
#undef A128_DMAV
#undef A128_ROWMAX
}
constexpr int NB3_ = 4;
template <int THRL> __device__ __forceinline__ void unit3(int b, int hq, int hv, int qb, const bf16* Q, const bf16* __restrict__ K, const bf16* __restrict__ V, bf16* O, char* shm) {
    const int tid = threadIdx.x; int lane = tid & 63; asm volatile("" : "+v"(lane));
    const int r32 = lane & 31, hi = lane >> 5; const int wid = __builtin_amdgcn_readfirstlane(tid >> 6);
    const long rowbase = (long)b * SEQ_; const int q0 = qb * QB;
    const bf16* Qw = Q + (rowbase + q0 + wid * QBLK) * DMP + hq * 64;
    const bf16* Kh = K + rowbase * DMP + hq * 64, * Vh = V + rowbase * DMP + hv * 64;
    const unsigned lds0 = (unsigned)(uintptr_t)shm;
    float* wsf = (float*)(shm + L2_WS) + wid * 64;
    const bf16* ksrc = Kh + (long)lane * DMP + wid * 8;
    const bf16* vsrc = Vh + (long)(16 * (wid & 3) + (lane >> 2)) * DMP + (wid >> 2) * 32 + (lane & 3) * 8;
    const unsigned kdst = lds0 + L2_K + wid * 1024, vdst = lds0 + L2_V + wid * 1024;
#define A128_DMAK(t) attn_body::glds16(ksrc + (long)(t) * KVBLK * DMP, (unsigned)__builtin_amdgcn_readfirstlane(kdst + ((t) & 3) * KSLOT))
#define A128_DMAV(t) do { attn_body::glds16(vsrc + (long)(t) * KVBLK * DMP, (unsigned)__builtin_amdgcn_readfirstlane(vdst + ((t) & 3) * VSLOT)); \
        attn_body::glds16(vsrc + (long)(t) * KVBLK * DMP + 64, (unsigned)__builtin_amdgcn_readfirstlane(vdst + ((t) & 3) * VSLOT + 8192)); } while (0)
    const int vb0 = (int)(lds0 + L2_V) + ((lane >> 4) & 1) * 32 + (lane & 3) * 8 + (4 * hi + ((lane & 15) >> 2)) * 64;
    const int kb0 = (int)(lds0 + L2_K) + hi * 1024 + r32 * 16;
    const int NT = (q0 + QB) / KVBLK;
    A128_DMAV(0); A128_DMAK(0); A128_DMAK(1); A128_DMAK(2);
    bf16x8 qr[4];
#pragma unroll
    for (int d0 = 0; d0 < 4; ++d0) qr[d0] = *reinterpret_cast<const bf16x8*>(&Qw[(long)r32 * DMP + d0 * 16 + hi * 8]);
    float mhat = 0.f, l_reg = 0.f; f32x16 o[4]; f32x16 negm;
    { float zz; asm volatile("v_mov_b32 %0, 0" : "=v"(zz));
#pragma unroll
      for (int r = 0; r < 16; ++r) { o[0][r] = zz; o[1][r] = zz; o[2][r] = zz; o[3][r] = zz; negm[r] = zz; } }
    const int qrel = wid * QBLK + r32;
    asm volatile("s_waitcnt vmcnt(0) lgkmcnt(0)\n\ts_barrier" ::: "memory");
    u32x4 pw0, pw1, pw2, pw3;
#define A128_ROWMAX(rm) do { float a = fmaxf(fmaxf(c0[0], c0[1]), c1[0]), bb = fmaxf(fmaxf(c0[2], c0[3]), c1[1]); a = fmaxf(fmaxf(a, c1[2]), c1[3]);                    \
          _Pragma("unroll") for (int r = 4; r < 16; r += 4) { a = fmaxf(fmaxf(a, c0[r]), c0[r + 1]); bb = fmaxf(fmaxf(bb, c0[r + 2]), c0[r + 3]); a = fmaxf(fmaxf(a, c1[r]), c1[r + 1]); bb = fmaxf(fmaxf(bb, c1[r + 2]), c1[r + 3]); } \
          rm = fmaxf(a, bb); auto rr = __builtin_amdgcn_permlane32_swap(__float_as_uint(rm), __float_as_uint(rm), false, false); rm = fmaxf(__uint_as_float(rr[0]), __uint_as_float(rr[1])); } while (0)
    f32x16 c0, c1; bool resc = false;
#define A128_PKW(P, B) attn_body::cvtpk_s(P[B], P[B + 1])
#define A128_RDF(i, LO, HI) do { asm volatile("ds_read_b64_tr_b16 %0,%1 offset:%c2" : "=&v"(LO) : "v"(vb), "i"(((i) >> 2) * 4096 + ((i) & 3) * 1024) : "memory"); \
                                 asm volatile("ds_read_b64_tr_b16 %0,%1 offset:%c2" : "=&v"(HI) : "v"(vb), "i"(((i) >> 2) * 4096 + ((i) & 3) * 1024 + 512) : "memory"); } while (0)
#define A128_FR(LO, HI) (bf16x8){LO[0], LO[1], LO[2], LO[3], HI[0], HI[1], HI[2], HI[3]}
#define A128_MF(i, PA, LO, HI) o[(i) >> 2] = __builtin_amdgcn_mfma_f32_32x32x16_bf16(PA, A128_FR(LO, HI), o[(i) >> 2], 0, 0, 0)
#define A128_H1(t) do { qkt128(c0, c1, kb0 + ((t) & 3) * KSLOT, qr, negm);                                                                        \
        { const int jb = (t) - (NT - 4); if (__builtin_expect(jb >= 0, 0)) { asm volatile("" ::: "memory"); attn_body::cmask(c0, c1, jb, qrel, hi); } } \
        float rm; A128_ROWMAX(rm); resc = false;                                                                                                  \
        if ((t) == 0) { mhat = rm; _Pragma("unroll") for (int r = 0; r < 16; ++r) { c0[r] -= rm; c1[r] -= rm; negm[r] = -mhat; } }               \
        else if (__builtin_expect(__any(rm > (float)THRL), 0)) { const float dl = fmaxf(rm, 0.f); mhat += dl;                                     \
            _Pragma("unroll") for (int r = 0; r < 16; ++r) { c0[r] -= dl; c1[r] -= dl; negm[r] = -mhat; }                                         \
            const float f = __builtin_amdgcn_exp2f(-dl); l_reg *= f; if (hi == 0) wsf[r32] = f; resc = true; } } while (0)
#define A128_H2_0() do { float sacc = 0.f;                                                                                                          \
        _Pragma("unroll") for (int r = 0; r < 16; ++r) { c0[r] = __builtin_amdgcn_exp2f(c0[r]); c1[r] = __builtin_amdgcn_exp2f(c1[r]); }          \
        _Pragma("unroll") for (int r = 0; r < 16; ++r) sacc += c0[r] + c1[r];                                                                     \
        l_reg += sacc;                                                                                                                            \
        pw0 = (u32x4){A128_PKW(c0, 0), A128_PKW(c0, 2), A128_PKW(c0, 4), A128_PKW(c0, 6)}; pw1 = (u32x4){A128_PKW(c0, 8), A128_PKW(c0, 10), A128_PKW(c0, 12), A128_PKW(c0, 14)}; \
        pw2 = (u32x4){A128_PKW(c1, 0), A128_PKW(c1, 2), A128_PKW(c1, 4), A128_PKW(c1, 6)}; pw3 = (u32x4){A128_PKW(c1, 8), A128_PKW(c1, 10), A128_PKW(c1, 12), A128_PKW(c1, 14)}; } while (0)
#define A128_H2(t) do { const bf16x8 pa0 = __builtin_bit_cast(bf16x8, pw0), pa1 = __builtin_bit_cast(bf16x8, pw1), pa2 = __builtin_bit_cast(bf16x8, pw2), pa3 = __builtin_bit_cast(bf16x8, pw3); \
        u32x4 pn0, pn1, pn2, pn3; float sacc = 0.f; const int vb = vb0 + (((t) - 1) & 3) * VSLOT;                                                 \
        s16x4 lo0, hi0, lo1, hi1, lo2, hi2, lo3, hi3, lo4, hi4; A128_SBAR();                                                                      \
        A128_RDF(0, lo0, hi0); A128_RDF(1, lo1, hi1); A128_RDF(2, lo2, hi2); A128_RDF(3, lo3, hi3); \
        A128_RDF(4, lo4, hi4); A128_WAITL(8); A128_SBAR(); A128_MF(0, pa0, lo0, hi0); { const float e0_ = __builtin_amdgcn_exp2f(c0[0]), e1_ = __builtin_amdgcn_exp2f(c0[1]); sacc += e0_; sacc += e1_; pn0[0] = attn_body::cvtpk_s(e0_, e1_); asm volatile("" : "+v"(sacc), "+v"(pn0)); } A128_SBAR(); \
        A128_RDF(5, lo0, hi0); A128_WAITL(8); A128_SBAR(); A128_MF(1, pa1, lo1, hi1); { const float e0_ = __builtin_amdgcn_exp2f(c0[2]), e1_ = __builtin_amdgcn_exp2f(c0[3]); sacc += e0_; sacc += e1_; pn0[1] = attn_body::cvtpk_s(e0_, e1_); asm volatile("" : "+v"(sacc), "+v"(pn0)); } A128_SBAR(); \
        A128_RDF(6, lo1, hi1); A128_WAITL(8); A128_SBAR(); A128_MF(2, pa2, lo2, hi2); { const float e0_ = __builtin_amdgcn_exp2f(c0[4]), e1_ = __builtin_amdgcn_exp2f(c0[5]); sacc += e0_; sacc += e1_; pn0[2] = attn_body::cvtpk_s(e0_, e1_); asm volatile("" : "+v"(sacc), "+v"(pn0)); } A128_SBAR(); \
        A128_RDF(7, lo2, hi2); A128_WAITL(8); A128_SBAR(); A128_MF(3, pa3, lo3, hi3); { const float e0_ = __builtin_amdgcn_exp2f(c0[6]), e1_ = __builtin_amdgcn_exp2f(c0[7]); sacc += e0_; sacc += e1_; pn0[3] = attn_body::cvtpk_s(e0_, e1_); asm volatile("" : "+v"(sacc), "+v"(pn0)); } A128_SBAR(); \
        A128_RDF(8, lo3, hi3); A128_WAITL(8); A128_SBAR(); A128_MF(4, pa0, lo4, hi4); { const float e0_ = __builtin_amdgcn_exp2f(c0[8]), e1_ = __builtin_amdgcn_exp2f(c0[9]); sacc += e0_; sacc += e1_; pn1[0] = attn_body::cvtpk_s(e0_, e1_); asm volatile("" : "+v"(sacc), "+v"(pn1)); } A128_SBAR(); \
        A128_RDF(9, lo4, hi4); A128_WAITL(8); A128_SBAR(); A128_MF(5, pa1, lo0, hi0); { const float e0_ = __builtin_amdgcn_exp2f(c0[10]), e1_ = __builtin_amdgcn_exp2f(c0[11]); sacc += e0_; sacc += e1_; pn1[1] = attn_body::cvtpk_s(e0_, e1_); asm volatile("" : "+v"(sacc), "+v"(pn1)); } A128_SBAR(); \
        A128_RDF(10, lo0, hi0); A128_WAITL(8); A128_SBAR(); A128_MF(6, pa2, lo1, hi1); { const float e0_ = __builtin_amdgcn_exp2f(c0[12]), e1_ = __builtin_amdgcn_exp2f(c0[13]); sacc += e0_; sacc += e1_; pn1[2] = attn_body::cvtpk_s(e0_, e1_); asm volatile("" : "+v"(sacc), "+v"(pn1)); } A128_SBAR(); \
        A128_RDF(11, lo1, hi1); A128_WAITL(8); A128_SBAR(); A128_MF(7, pa3, lo2, hi2); { const float e0_ = __builtin_amdgcn_exp2f(c0[14]), e1_ = __builtin_amdgcn_exp2f(c0[15]); sacc += e0_; sacc += e1_; pn1[3] = attn_body::cvtpk_s(e0_, e1_); asm volatile("" : "+v"(sacc), "+v"(pn1)); } A128_SBAR(); \
        A128_RDF(12, lo2, hi2); A128_WAITL(8); A128_SBAR(); A128_MF(8, pa0, lo3, hi3); { const float e0_ = __builtin_amdgcn_exp2f(c1[0]), e1_ = __builtin_amdgcn_exp2f(c1[1]); sacc += e0_; sacc += e1_; pn2[0] = attn_body::cvtpk_s(e0_, e1_); asm volatile("" : "+v"(sacc), "+v"(pn2)); } A128_SBAR(); \
        A128_RDF(13, lo3, hi3); A128_WAITL(8); A128_SBAR(); A128_MF(9, pa1, lo4, hi4); { const float e0_ = __builtin_amdgcn_exp2f(c1[2]), e1_ = __builtin_amdgcn_exp2f(c1[3]); sacc += e0_; sacc += e1_; pn2[1] = attn_body::cvtpk_s(e0_, e1_); asm volatile("" : "+v"(sacc), "+v"(pn2)); } A128_SBAR(); \
        A128_RDF(14, lo4, hi4); A128_WAITL(8); A128_SBAR(); A128_MF(10, pa2, lo0, hi0); { const float e0_ = __builtin_amdgcn_exp2f(c1[4]), e1_ = __builtin_amdgcn_exp2f(c1[5]); sacc += e0_; sacc += e1_; pn2[2] = attn_body::cvtpk_s(e0_, e1_); asm volatile("" : "+v"(sacc), "+v"(pn2)); } A128_SBAR(); \
        A128_RDF(15, lo0, hi0); A128_WAITL(8); A128_SBAR(); A128_MF(11, pa3, lo1, hi1); { const float e0_ = __builtin_amdgcn_exp2f(c1[6]), e1_ = __builtin_amdgcn_exp2f(c1[7]); sacc += e0_; sacc += e1_; pn2[3] = attn_body::cvtpk_s(e0_, e1_); asm volatile("" : "+v"(sacc), "+v"(pn2)); } A128_SBAR(); \
        A128_WAITL(6); A128_SBAR(); A128_MF(12, pa0, lo2, hi2); { const float e0_ = __builtin_amdgcn_exp2f(c1[8]), e1_ = __builtin_amdgcn_exp2f(c1[9]); sacc += e0_; sacc += e1_; pn3[0] = attn_body::cvtpk_s(e0_, e1_); asm volatile("" : "+v"(sacc), "+v"(pn3)); } A128_SBAR(); \
        A128_WAITL(4); A128_SBAR(); A128_MF(13, pa1, lo3, hi3); { const float e0_ = __builtin_amdgcn_exp2f(c1[10]), e1_ = __builtin_amdgcn_exp2f(c1[11]); sacc += e0_; sacc += e1_; pn3[1] = attn_body::cvtpk_s(e0_, e1_); asm volatile("" : "+v"(sacc), "+v"(pn3)); } A128_SBAR(); \
        A128_WAITL(2); A128_SBAR(); A128_MF(14, pa2, lo4, hi4); { const float e0_ = __builtin_amdgcn_exp2f(c1[12]), e1_ = __builtin_amdgcn_exp2f(c1[13]); sacc += e0_; sacc += e1_; pn3[2] = attn_body::cvtpk_s(e0_, e1_); asm volatile("" : "+v"(sacc), "+v"(pn3)); } A128_SBAR(); \
        A128_WAITL(0); A128_SBAR(); A128_MF(15, pa3, lo0, hi0); { const float e0_ = __builtin_amdgcn_exp2f(c1[14]), e1_ = __builtin_amdgcn_exp2f(c1[15]); sacc += e0_; sacc += e1_; pn3[3] = attn_body::cvtpk_s(e0_, e1_); asm volatile("" : "+v"(sacc), "+v"(pn3)); } A128_SBAR(); \
        l_reg += sacc;                                                                                                                            \
        if (resc) { asm volatile("s_waitcnt lgkmcnt(0)" ::: "memory");                                                                            \
            _Pragma("unroll") for (int r = 0; r < 16; ++r) { const float fr = wsf[attn_body::crow(r, hi)]; o[0][r] *= fr; o[1][r] *= fr; o[2][r] *= fr; o[3][r] *= fr; } } \
        pw0 = pn0; pw1 = pn1; pw2 = pn2; pw3 = pn3; } while (0)
#define A128_ISSUE(t) do { if ((t) + 1 < NT) A128_DMAV((t) + 1); if ((t) + 3 < NT) A128_DMAK((t) + 3); } while (0)
#define A128_END(t) do { if ((t) + 3 < NT) asm volatile("s_waitcnt vmcnt(4) lgkmcnt(0)\n\ts_barrier" ::: "memory");                               \
        else if ((t) + 2 < NT) asm volatile("s_waitcnt vmcnt(3) lgkmcnt(0)\n\ts_barrier" ::: "memory");                                          \
        else if ((t) + 1 < NT) asm volatile("s_waitcnt vmcnt(2) lgkmcnt(0)\n\ts_barrier" ::: "memory");                                          \
        else asm volatile("s_waitcnt vmcnt(0) lgkmcnt(0)\n\ts_barrier" ::: "memory"); } while (0)
    if (wid < 4) {
        A128_ISSUE(0); A128_H1(0); A128_H2_0(); A128_END(0);
        for (int t = 1; t < NT; ++t) { A128_ISSUE(t); A128_H1(t); A128_H2(t); A128_END(t); }
    } else {
        A128_ISSUE(0); A128_H1(0); A128_END(0);
        A128_ISSUE(1); A128_H2_0(); A128_H1(1); A128_END(1);
        for (int t = 2; t < NT; ++t) { A128_ISSUE(t); A128_H2(t - 1); A128_H1(t); A128_END(t); }
        A128_H2(NT - 1);
    }
    asm volatile("s_waitcnt vmcnt(0) lgkmcnt(0)\n\ts_barrier" ::: "memory");
#undef A128_H1
#undef A128_H2_0
#undef A128_H2
#undef A128_ISSUE
#undef A128_END
#undef A128_PKW
#undef A128_RDF
#undef A128_FR
#undef A128_MF
    pv128(o, vb0 + ((NT - 1) & 3) * VSLOT, __builtin_bit_cast(bf16x8, pw0), __builtin_bit_cast(bf16x8, pw1), __builtin_bit_cast(bf16x8, pw2), __builtin_bit_cast(bf16x8, pw3));
    { auto rr = __builtin_amdgcn_permlane32_swap(__float_as_uint(l_reg), __float_as_uint(l_reg), false, false); l_reg = __uint_as_float(rr[0]) + __uint_as_float(rr[1]); }
    int lne = lane; asm volatile("" : "+v"(lne));
    const int r32e = lne & 31, hie = lne >> 5;
    if (hie == 0) wsf[32 + r32e] = l_reg; asm volatile("s_waitcnt lgkmcnt(0)" ::: "memory");
    float rli[16];
#pragma unroll
    for (int r = 0; r < 16; ++r) rli[r] = __builtin_amdgcn_rcpf(wsf[32 + attn_body::crow(r, hie)]);
    bf16* Ow = O + (rowbase + q0 + wid * QBLK) * DMP + hv * 64;
    { bf16* stg = (bf16*)(shm + L2_OST) + wid * 2048;
#pragma unroll
      for (int half = 0; half < 2; ++half) {
#pragma unroll
          for (int r = 0; r < 16; ++r) { const int orow = attn_body::crow(r, hie);
#pragma unroll
              for (int d0 = 0; d0 < 2; ++d0) stg[orow * 64 + d0 * 32 + r32e] = __float2bfloat16(o[2 * half + d0][r] * rli[r]); }
          asm volatile("s_waitcnt lgkmcnt(0)" ::: "memory");
#pragma unroll
          for (int i = 0; i < 4; ++i) { const int row = i * 8 + (lne >> 3), ch = lne & 7; const u32x4 v = *(const u32x4*)(stg + row * 64 + ch * 8); *(u32x4*)(Ow + (long)row * DMP + half * 64 + ch * 8) = v; }
          asm volatile("s_waitcnt lgkmcnt(0)" ::: "memory"); } }
    asm volatile("s_waitcnt lgkmcnt(0)\n\ts_barrier" ::: "memory");
#undef A128_DMAK
#undef A128_DMAV
#undef A128_ROWMAX
}
#define A128_ROWMAX(rm) do { float a = fmaxf(fmaxf(c0[0], c0[1]), c1[0]), bb = fmaxf(fmaxf(c0[2], c0[3]), c1[1]); a = fmaxf(fmaxf(a, c1[2]), c1[3]);                    \
          _Pragma("unroll") for (int r = 4; r < 16; r += 4) { a = fmaxf(fmaxf(a, c0[r]), c0[r + 1]); bb = fmaxf(fmaxf(bb, c0[r + 2]), c0[r + 3]); a = fmaxf(fmaxf(a, c1[r]), c1[r + 1]); bb = fmaxf(fmaxf(bb, c1[r + 2]), c1[r + 3]); } \
          rm = fmaxf(a, bb); auto rr = __builtin_amdgcn_permlane32_swap(__float_as_uint(rm), __float_as_uint(rm), false, false); rm = fmaxf(__uint_as_float(rr[0]), __uint_as_float(rr[1])); } while (0)

__device__ __forceinline__ void qkt128r(f32x16& p0, f32x16& p1, int kb, const bf16x8* qr, const f32x16& negm) {
    bf16x8 k0, k1, k2, k3;
#define A128_RDK(K, OFF) asm volatile("ds_read_b128 %0,%1 offset:%c2" : "=&v"(K) : "v"(kb), "i"(OFF) : "memory")
#define A128_RDK2(K, OFF) asm volatile("ds_read_b128 %0,%1 offset:%c2" : "+v"(K) : "v"(kb), "i"(OFF) : "memory")
    A128_RDK(k0, 0); A128_RDK(k1, 512); A128_RDK(k2, 2048); A128_RDK(k3, 2560);
    A128_WAITL(3); A128_SBAR(); p0 = __builtin_amdgcn_mfma_f32_32x32x16_bf16(k0, qr[0], negm, 0, 0, 0); A128_SBAR(); A128_RDK2(k0, 4096);
    A128_WAITL(3); A128_SBAR(); p1 = __builtin_amdgcn_mfma_f32_32x32x16_bf16(k1, qr[0], negm, 0, 0, 0); A128_SBAR(); A128_RDK2(k1, 4608);
    A128_WAITL(3); A128_SBAR(); p0 = __builtin_amdgcn_mfma_f32_32x32x16_bf16(k2, qr[1], p0, 0, 0, 0); A128_SBAR(); A128_RDK2(k2, 6144);
    A128_WAITL(3); A128_SBAR(); p1 = __builtin_amdgcn_mfma_f32_32x32x16_bf16(k3, qr[1], p1, 0, 0, 0); A128_SBAR(); A128_RDK2(k3, 6656);
    A128_WAITL(3); A128_SBAR(); p0 = __builtin_amdgcn_mfma_f32_32x32x16_bf16(k0, qr[2], p0, 0, 0, 0);
    A128_WAITL(2); A128_SBAR(); p1 = __builtin_amdgcn_mfma_f32_32x32x16_bf16(k1, qr[2], p1, 0, 0, 0);
    A128_WAITL(1); A128_SBAR(); p0 = __builtin_amdgcn_mfma_f32_32x32x16_bf16(k2, qr[3], p0, 0, 0, 0);
    A128_WAITL(0); A128_SBAR(); p1 = __builtin_amdgcn_mfma_f32_32x32x16_bf16(k3, qr[3], p1, 0, 0, 0);
#undef A128_RDK
#undef A128_RDK2
    asm volatile("s_nop 15\n\ts_nop 7" : "+v"(p0), "+v"(p1));
}
template <int THRL> __device__ __forceinline__ void unit4(int b, int hq, int hv, int qb, const bf16* Q, const bf16* __restrict__ K, const bf16* __restrict__ V, bf16* O, char* shm, volatile __attribute__((address_space(3))) unsigned* PRB = nullptr) {
    const int tid = threadIdx.x; int lane = tid & 63; asm volatile("" : "+v"(lane));
    const int r32 = lane & 31, hi = lane >> 5; const int wid = __builtin_amdgcn_readfirstlane(tid >> 6);
    const long rowbase = (long)b * SEQ_; const int q0 = qb * QB;
    const bf16* Qw = Q + (rowbase + q0 + wid * QBLK) * DMP + hq * 64;
    const bf16* Kh = K + rowbase * DMP + hq * 64, * Vh = V + rowbase * DMP + hv * 64;
    const unsigned lds0 = (unsigned)(uintptr_t)shm;
    float* wsf = (float*)(shm + L2_WS) + wid * 64;
    const bf16* ksrc = Kh + (long)lane * DMP + wid * 8;
    const bf16* vsrc = Vh + (long)(16 * (wid & 3) + (lane >> 2)) * DMP + (wid >> 2) * 32 + (lane & 3) * 8;
    const unsigned kdst = lds0 + L2_K + wid * 1024, vdst = lds0 + L2_V + wid * 1024;
#define A128_DMAK(t) attn_body::glds16(ksrc + (long)(t) * KVBLK * DMP, (unsigned)__builtin_amdgcn_readfirstlane(kdst + ((t) & 3) * KSLOT))
#define A128_DMAV(t) do { attn_body::glds16(vsrc + (long)(t) * KVBLK * DMP, (unsigned)__builtin_amdgcn_readfirstlane(vdst + ((t) & 3) * VSLOT)); \
        attn_body::glds16(vsrc + (long)(t) * KVBLK * DMP + 64, (unsigned)__builtin_amdgcn_readfirstlane(vdst + ((t) & 3) * VSLOT + 8192)); } while (0)
    const int vb0 = (int)(lds0 + L2_V) + ((lane >> 4) & 1) * 32 + (lane & 3) * 8 + (4 * hi + ((lane & 15) >> 2)) * 64;
    const int kb0 = (int)(lds0 + L2_K) + hi * 1024 + r32 * 16;
    const int NT = (q0 + QB) / KVBLK;
    A128_DMAK(0); A128_DMAV(0); A128_DMAK(1); A128_DMAV(1); A128_DMAK(2);
    bf16x8 qr[4];
#pragma unroll
    for (int d0 = 0; d0 < 4; ++d0) qr[d0] = *reinterpret_cast<const bf16x8*>(&Qw[(long)r32 * DMP + d0 * 16 + hi * 8]);
    float mhat = 0.f, l_reg = 0.f; f32x16 o[4]; f32x16 negm;
    { float zz; asm volatile("v_mov_b32 %0, 0" : "=v"(zz));
#pragma unroll
      for (int r = 0; r < 16; ++r) { o[0][r] = zz; o[1][r] = zz; o[2][r] = zz; o[3][r] = zz; negm[r] = zz; } }
    const int qrel = wid * QBLK + r32;
    asm volatile("s_waitcnt vmcnt(0) lgkmcnt(0)\n\ts_barrier" ::: "memory");
    u32x4 pw0, pw1, pw2, pw3; f32x16 c0, c1;
#define A128_PKW(P, B) attn_body::cvtpk_s(P[B], P[B + 1])
#define A128_ISSUE(s) do { if ((s) + 3 < NT) A128_DMAK((s) + 3); if ((s) + 2 < NT) A128_DMAV((s) + 2); } while (0)
#define A128_BARE() asm volatile("s_waitcnt lgkmcnt(0)\n\ts_barrier" ::: "memory")
#define A128_BARO(s) do { PRB_B(55, PRB); if ((s) + 3 < NT) asm volatile("s_waitcnt vmcnt(6) lgkmcnt(0)" ::: "memory");                               \
        else if ((s) + 2 < NT) asm volatile("s_waitcnt vmcnt(5) lgkmcnt(0)" ::: "memory");                                          \
        else if ((s) + 1 < NT) asm volatile("s_waitcnt vmcnt(2) lgkmcnt(0)" ::: "memory");                                          \
        else asm volatile("s_waitcnt vmcnt(0) lgkmcnt(0)" ::: "memory"); PRB_E(55, PRB); PRB_B(56, PRB); asm volatile("s_barrier" ::: "memory"); PRB_E(56, PRB); } while (0)
#define A128_MQK(t) qkt128r(c0, c1, kb0 + ((t) & 3) * KSLOT, qr, negm)
#define A128_MPV(t) pv128(o, vb0 + ((t) & 3) * VSLOT, __builtin_bit_cast(bf16x8, pw0), __builtin_bit_cast(bf16x8, pw1), __builtin_bit_cast(bf16x8, pw2), __builtin_bit_cast(bf16x8, pw3))
#define A128_VEC(t) do { int hv_ = hi, qrel_ = qrel, r32_ = r32; asm volatile("" : "+v"(hv_), "+v"(qrel_), "+v"(r32_));                                \
        { const int jb = (t) - (NT - 4); if (__builtin_expect(jb >= 0, 0)) { asm volatile("" ::: "memory"); attn_body::cmask(c0, c1, jb, qrel_, hv_); } } \
        float rm; A128_ROWMAX(rm);                                                                                                                 \
        if ((t) == 0) { mhat = rm; _Pragma("unroll") for (int r = 0; r < 16; ++r) { c0[r] -= rm; c1[r] -= rm; negm[r] = -mhat; } }                \
        else if (__builtin_expect(__any(rm > (float)THRL), 0)) { const float dl = fmaxf(rm, 0.f); mhat += dl;                                      \
            _Pragma("unroll") for (int r = 0; r < 16; ++r) { c0[r] -= dl; c1[r] -= dl; negm[r] = -mhat; }                                          \
            const float f = __builtin_amdgcn_exp2f(-dl); l_reg *= f; if (hv_ == 0) wsf[r32_] = f; asm volatile("s_waitcnt lgkmcnt(0)" ::: "memory"); \
            _Pragma("unroll") for (int r = 0; r < 16; ++r) { const float fr = wsf[attn_body::crow(r, hv_)]; o[0][r] *= fr; o[1][r] *= fr; o[2][r] *= fr; o[3][r] *= fr; } } \
        float sacc = 0.f;                                                                                                                          \
        _Pragma("unroll") for (int r = 0; r < 16; ++r) { c0[r] = __builtin_amdgcn_exp2f(c0[r]); c1[r] = __builtin_amdgcn_exp2f(c1[r]); }           \
        _Pragma("unroll") for (int r = 0; r < 16; ++r) sacc += c0[r] + c1[r];                                                                      \
        l_reg += sacc;                                                                                                                             \
        pw0 = (u32x4){A128_PKW(c0, 0), A128_PKW(c0, 2), A128_PKW(c0, 4), A128_PKW(c0, 6)}; pw1 = (u32x4){A128_PKW(c0, 8), A128_PKW(c0, 10), A128_PKW(c0, 12), A128_PKW(c0, 14)}; \
        pw2 = (u32x4){A128_PKW(c1, 0), A128_PKW(c1, 2), A128_PKW(c1, 4), A128_PKW(c1, 6)}; pw3 = (u32x4){A128_PKW(c1, 8), A128_PKW(c1, 10), A128_PKW(c1, 12), A128_PKW(c1, 14)}; } while (0)
    const bool isB = wid >= 4;
    A128_ISSUE(0); A128_MQK(0);
    if (isB) { A128_BARO(0); A128_ISSUE(1); }
    A128_VEC(0);
    if (!isB) { A128_BARO(0); }
    for (int s = 1; s < NT; ++s) {
        if (!isB) A128_ISSUE(s);
        __builtin_amdgcn_s_setprio(1); A128_MQK(s); A128_MPV(s - 1); __builtin_amdgcn_s_setprio(0);
        if (isB) { A128_BARO(s); A128_ISSUE(s + 1); }
        A128_VEC(s);
        if (!isB) { A128_BARO(s); }
    }
    A128_MPV(NT - 1);
#undef A128_PKW
#undef A128_ISSUE
#undef A128_BARE
#undef A128_BARO
#undef A128_MQK
#undef A128_MPV
#undef A128_VEC
    { auto rr = __builtin_amdgcn_permlane32_swap(__float_as_uint(l_reg), __float_as_uint(l_reg), false, false); l_reg = __uint_as_float(rr[0]) + __uint_as_float(rr[1]); }
    int lne = lane; asm volatile("" : "+v"(lne));
    const int r32e = lne & 31, hie = lne >> 5;
    if (hie == 0) wsf[32 + r32e] = l_reg; asm volatile("s_waitcnt lgkmcnt(0)" ::: "memory");
    float rli[16];
#pragma unroll
    for (int r = 0; r < 16; ++r) rli[r] = __builtin_amdgcn_rcpf(wsf[32 + attn_body::crow(r, hie)]);
    bf16* Ow = O + (rowbase + q0 + wid * QBLK) * DMP + hv * 64;
    { bf16* stg = (bf16*)(shm + L2_OST) + wid * 2048;
#pragma unroll
      for (int half = 0; half < 2; ++half) {
#pragma unroll
          for (int r = 0; r < 16; ++r) { const int orow = attn_body::crow(r, hie);
#pragma unroll
              for (int d0 = 0; d0 < 2; ++d0) stg[orow * 64 + d0 * 32 + r32e] = __float2bfloat16(o[2 * half + d0][r] * rli[r]); }
          asm volatile("s_waitcnt lgkmcnt(0)" ::: "memory");
#pragma unroll
          for (int i = 0; i < 4; ++i) { const int row = i * 8 + (lne >> 3), ch = lne & 7; const u32x4 v = *(const u32x4*)(stg + row * 64 + ch * 8); *(u32x4*)(Ow + (long)row * DMP + half * 64 + ch * 8) = v; }
          asm volatile("s_waitcnt lgkmcnt(0)" ::: "memory"); } }
    asm volatile("s_waitcnt lgkmcnt(0)\n\ts_barrier" ::: "memory");
#undef A128_DMAK
#undef A128_DMAV
}
#undef A128_ROWMAX

template <int THRL> __device__ __forceinline__ void unit6(int b, int hq, int hv, int qb, const bf16* Q, const bf16* __restrict__ K, const bf16* __restrict__ V, bf16* O, char* shm) {
    const unsigned lds0 = (unsigned)(uintptr_t)shm;
    int lane = lane_now(); asm volatile("" : "+v"(lane));
    const int r32 = lane & 31, hi = lane >> 5; const int wid = __builtin_amdgcn_readfirstlane(wave_now((const void*)(uintptr_t)lds0));
    const long rowbase = (long)b * SEQ_; const int q0 = qb * QB;
    const bf16* Qw = Q + (rowbase + q0 + wid * QBLK) * DMP + hq * 64;
    const bf16* Kh = K + rowbase * DMP + hq * 64, * Vh = V + rowbase * DMP + hv * 64;
    float* wsf = (float*)(shm + L2_WS) + wid * 64;
    const bf16* ksrc = Kh + (long)lane * DMP + wid * 8;
    const bf16* vsrc = Vh + (long)(16 * (wid & 3) + (lane >> 2)) * DMP + (wid >> 2) * 32 + (lane & 3) * 8;
    const unsigned kdst = lds0 + L2_K + wid * 1024, vdst = lds0 + L2_V + wid * 1024;
#define A128_DMAK(t) attn_body::glds16(ksrc + (long)(t) * KVBLK * DMP, (unsigned)__builtin_amdgcn_readfirstlane(kdst + ((t) & 3) * KSLOT))
#define A128_DMAV(t) do { attn_body::glds16(vsrc + (long)(t) * KVBLK * DMP, (unsigned)__builtin_amdgcn_readfirstlane(vdst + ((t) & 3) * VSLOT)); \
        attn_body::glds16(vsrc + (long)(t) * KVBLK * DMP + 64, (unsigned)__builtin_amdgcn_readfirstlane(vdst + ((t) & 3) * VSLOT + 8192)); } while (0)
    const int vb0 = (int)(lds0 + L2_V) + ((lane >> 4) & 1) * 32 + (lane & 3) * 8 + (4 * hi + ((lane & 15) >> 2)) * 64;
    const int kb0 = (int)(lds0 + L2_K) + hi * 1024 + r32 * 16;
    const int NT = (q0 + QB) / KVBLK;
    A128_DMAK(0); A128_DMAK(1); A128_DMAV(0); A128_DMAK(2); A128_DMAV(1); A128_DMAK(3);
    bf16x8 qr[4];
#pragma unroll
    for (int d0 = 0; d0 < 4; ++d0) qr[d0] = *reinterpret_cast<const bf16x8*>(&Qw[(long)r32 * DMP + d0 * 16 + hi * 8]);
    float mhat = 0.f, l_reg = 0.f; f32x16 o[4]; f32x16 negm;
    { float zz; asm volatile("v_mov_b32 %0, 0" : "=v"(zz));
#pragma unroll
      for (int r = 0; r < 16; ++r) { o[0][r] = zz; o[1][r] = zz; o[2][r] = zz; o[3][r] = zz; negm[r] = zz; } }
    const int qrel = wid * QBLK + r32;
    asm volatile("s_waitcnt vmcnt(0) lgkmcnt(0)\n\ts_barrier" ::: "memory");
    u32x4 pw0, pw1, pw2, pw3; f32x16 ca0, ca1, cb0, cb1;
#define U6_RDV(j, LO, HI) do { asm volatile("ds_read_b64_tr_b16 %0,%1 offset:%c2" : "=&v"(LO) : "v"(vb), "i"(((j) & 3) * 4096 + ((j) >> 2) * 1024) : "memory"); \
                               asm volatile("ds_read_b64_tr_b16 %0,%1 offset:%c2" : "=&v"(HI) : "v"(vb), "i"(((j) & 3) * 4096 + ((j) >> 2) * 1024 + 512) : "memory"); } while (0)
#define U6_MFV(j, PA, LO, HI) o[(j) & 3] = __builtin_amdgcn_mfma_f32_32x32x16_bf16(PA, (bf16x8){LO[0], LO[1], LO[2], LO[3], HI[0], HI[1], HI[2], HI[3]}, o[(j) & 3], 0, 0, 0)
#define U6_RDK(K_, OFF) asm volatile("ds_read_b128 %0,%1 offset:%c2" : "=&v"(K_) : "v"(kb), "i"(OFF) : "memory")
#define U6_RDK2(K_, OFF) asm volatile("ds_read_b128 %0,%1 offset:%c2" : "+v"(K_) : "v"(kb), "i"(OFF) : "memory")
    { qkt128r(ca0, ca1, kb0, qr, negm);
      asm volatile("s_waitcnt lgkmcnt(0)\n\ts_barrier" ::: "memory");
      if (4 < NT) A128_DMAK(4); A128_DMAV(2);
      { const int jb = 0 - (NT - 4); if (jb >= 0) attn_body::cmask(ca0, ca1, jb, qrel, hi); }
      float rm; { float a_ = fmaxf(fmaxf(ca0[0], ca0[1]), ca1[0]), b_ = fmaxf(fmaxf(ca0[2], ca0[3]), ca1[1]); a_ = fmaxf(fmaxf(a_, ca1[2]), ca1[3]);
#pragma unroll
          for (int r = 4; r < 16; r += 4) { a_ = fmaxf(fmaxf(a_, ca0[r]), ca0[r + 1]); b_ = fmaxf(fmaxf(b_, ca0[r + 2]), ca0[r + 3]); a_ = fmaxf(fmaxf(a_, ca1[r]), ca1[r + 1]); b_ = fmaxf(fmaxf(b_, ca1[r + 2]), ca1[r + 3]); }
          rm = fmaxf(a_, b_); auto rr = __builtin_amdgcn_permlane32_swap(__float_as_uint(rm), __float_as_uint(rm), false, false); rm = fmaxf(__uint_as_float(rr[0]), __uint_as_float(rr[1])); }
      mhat = rm;
#pragma unroll
      for (int r = 0; r < 16; ++r) { ca0[r] -= rm; ca1[r] -= rm; negm[r] = -mhat; }
      float sacc = 0.f;
#pragma unroll
      for (int r = 0; r < 16; ++r) { ca0[r] = __builtin_amdgcn_exp2f(ca0[r]); ca1[r] = __builtin_amdgcn_exp2f(ca1[r]); }
#pragma unroll
      for (int r = 0; r < 16; ++r) sacc += ca0[r] + ca1[r];
      l_reg += sacc;
#define A128_PKW(P, B) attn_body::cvtpk_s(P[B], P[B + 1])
      pw0 = (u32x4){A128_PKW(ca0, 0), A128_PKW(ca0, 2), A128_PKW(ca0, 4), A128_PKW(ca0, 6)}; pw1 = (u32x4){A128_PKW(ca0, 8), A128_PKW(ca0, 10), A128_PKW(ca0, 12), A128_PKW(ca0, 14)};
      pw2 = (u32x4){A128_PKW(ca1, 0), A128_PKW(ca1, 2), A128_PKW(ca1, 4), A128_PKW(ca1, 6)}; pw3 = (u32x4){A128_PKW(ca1, 8), A128_PKW(ca1, 10), A128_PKW(ca1, 12), A128_PKW(ca1, 14)};
#undef A128_PKW
      qkt128r(cb0, cb1, kb0 + KSLOT, qr, negm);
      asm volatile("s_waitcnt vmcnt(3) lgkmcnt(0)\n\ts_barrier" ::: "memory"); }
#define U6_STEP(C0, C1, N0, N1, t) do {                                                                                                                       \
        if ((t) + 4 < NT) A128_DMAK((t) + 4);                                                                                                                   \
        if ((t) + 2 < NT) A128_DMAV((t) + 2);                                                                                                                   \
        { const int jb = (t) - (NT - 4); if (__builtin_expect(jb >= 0, 0)) { asm volatile("" ::: "memory"); attn_body::cmask(C0, C1, jb, qrel, hi); } }         \
        const bf16x8 pa0 = __builtin_bit_cast(bf16x8, pw0), pa1 = __builtin_bit_cast(bf16x8, pw1), pa2 = __builtin_bit_cast(bf16x8, pw2), pa3 = __builtin_bit_cast(bf16x8, pw3); \
        u32x4 pn0, pn1, pn2, pn3; float sacc = 0.f; bool resc = false; float rmA, rmB, rm;                                                                       \
        const int vb = vb0 + (((t) - 1) & 3) * VSLOT, kb = kb0 + (((t) + 1) & 3) * KSLOT;                                                                          \
        s16x4 vl0, vh0, vl1, vh1, vl2, vh2, vl3, vh3; bf16x8 kf0, kf1, kf2;                                                                         \
        U6_RDV(0, vl0, vh0); U6_RDV(1, vl1, vh1); U6_RDV(2, vl2, vh2);    \
        U6_RDV(3, vl3, vh3); A128_WAITL(6); A128_SBAR(); U6_MFV(0, pa0, vl0, vh0); rmA = fmaxf(fmaxf(C0[0], C0[1]), C1[0]); rmB = fmaxf(fmaxf(C0[2], C0[3]), C1[1]); rmA = fmaxf(fmaxf(rmA, C1[2]), C1[3]); rmA = fmaxf(fmaxf(rmA, C0[4]), C0[5]); rmB = fmaxf(fmaxf(rmB, C0[6]), C0[7]); asm volatile("" : "+v"(rmA), "+v"(rmB)); A128_SBAR();    \
        U6_RDV(4, vl0, vh0); A128_WAITL(6); A128_SBAR(); U6_MFV(1, pa0, vl1, vh1); rmA = fmaxf(fmaxf(rmA, C1[4]), C1[5]); rmB = fmaxf(fmaxf(rmB, C1[6]), C1[7]); rmA = fmaxf(fmaxf(rmA, C0[8]), C0[9]); rmB = fmaxf(fmaxf(rmB, C0[10]), C0[11]); rmA = fmaxf(fmaxf(rmA, C1[8]), C1[9]); asm volatile("" : "+v"(rmA), "+v"(rmB)); A128_SBAR();    \
        U6_RDV(5, vl1, vh1); A128_WAITL(6); A128_SBAR(); U6_MFV(2, pa0, vl2, vh2); rmB = fmaxf(fmaxf(rmB, C1[10]), C1[11]); rmA = fmaxf(fmaxf(rmA, C0[12]), C0[13]); rmB = fmaxf(fmaxf(rmB, C0[14]), C0[15]); rmA = fmaxf(fmaxf(rmA, C1[12]), C1[13]); rmB = fmaxf(fmaxf(rmB, C1[14]), C1[15]); asm volatile("" : "+v"(rmA), "+v"(rmB)); A128_SBAR();    \
        U6_RDV(6, vl2, vh2); A128_WAITL(6); A128_SBAR(); U6_MFV(3, pa0, vl3, vh3); rm = fmaxf(rmA, rmB); { auto rr = __builtin_amdgcn_permlane32_swap(__float_as_uint(rm), __float_as_uint(rm), false, false); rm = fmaxf(__uint_as_float(rr[0]), __uint_as_float(rr[1])); } asm volatile("" : "+v"(rm)); A128_SBAR();    \
        if (__builtin_expect(__any(rm > (float)THRL), 0)) { const float dl = fmaxf(rm, 0.f); mhat += dl;                                                     \
            _Pragma("unroll") for (int r = 0; r < 16; ++r) { C0[r] -= dl; C1[r] -= dl; negm[r] = -mhat; }                                                  \
            const float f = __builtin_amdgcn_exp2f(-dl); l_reg *= f; if (hi == 0) wsf[r32] = f; resc = true; asm volatile("s_waitcnt lgkmcnt(0)" ::: "memory"); }  \
        U6_RDV(7, vl3, vh3); A128_WAITL(6); A128_SBAR(); U6_MFV(4, pa1, vl0, vh0); { const float e0_ = __builtin_amdgcn_exp2f(C0[0]), e1_ = __builtin_amdgcn_exp2f(C0[1]); sacc += e0_; sacc += e1_; pn0[0] = attn_body::cvtpk_s(e0_, e1_); asm volatile("" : "+v"(sacc), "+v"(pn0)); } A128_SBAR();    \
        U6_RDV(8, vl0, vh0); A128_WAITL(6); A128_SBAR(); U6_MFV(5, pa1, vl1, vh1); { const float e0_ = __builtin_amdgcn_exp2f(C0[2]), e1_ = __builtin_amdgcn_exp2f(C0[3]); sacc += e0_; sacc += e1_; pn0[1] = attn_body::cvtpk_s(e0_, e1_); asm volatile("" : "+v"(sacc), "+v"(pn0)); } A128_SBAR();    \
        U6_RDV(9, vl1, vh1); A128_WAITL(6); A128_SBAR(); U6_MFV(6, pa1, vl2, vh2); { const float e0_ = __builtin_amdgcn_exp2f(C0[4]), e1_ = __builtin_amdgcn_exp2f(C0[5]); sacc += e0_; sacc += e1_; pn0[2] = attn_body::cvtpk_s(e0_, e1_); asm volatile("" : "+v"(sacc), "+v"(pn0)); } A128_SBAR();    \
        U6_RDV(10, vl2, vh2); A128_WAITL(6); A128_SBAR(); U6_MFV(7, pa1, vl3, vh3); { const float e0_ = __builtin_amdgcn_exp2f(C0[6]), e1_ = __builtin_amdgcn_exp2f(C0[7]); sacc += e0_; sacc += e1_; pn0[3] = attn_body::cvtpk_s(e0_, e1_); asm volatile("" : "+v"(sacc), "+v"(pn0)); } A128_SBAR();    \
        U6_RDV(11, vl3, vh3); A128_WAITL(6); A128_SBAR(); U6_MFV(8, pa2, vl0, vh0); A128_SBAR();    \
        U6_RDV(12, vl0, vh0); A128_WAITL(6); A128_SBAR(); U6_MFV(9, pa2, vl1, vh1); { const float e0_ = __builtin_amdgcn_exp2f(C0[8]), e1_ = __builtin_amdgcn_exp2f(C0[9]); sacc += e0_; sacc += e1_; pn1[0] = attn_body::cvtpk_s(e0_, e1_); asm volatile("" : "+v"(sacc), "+v"(pn1)); } A128_SBAR();    \
        U6_RDV(13, vl1, vh1); A128_WAITL(6); A128_SBAR(); U6_MFV(10, pa2, vl2, vh2); { const float e0_ = __builtin_amdgcn_exp2f(C0[10]), e1_ = __builtin_amdgcn_exp2f(C0[11]); sacc += e0_; sacc += e1_; pn1[1] = attn_body::cvtpk_s(e0_, e1_); asm volatile("" : "+v"(sacc), "+v"(pn1)); } A128_SBAR();    \
        U6_RDV(14, vl2, vh2); A128_WAITL(6); A128_SBAR(); U6_MFV(11, pa2, vl3, vh3); { const float e0_ = __builtin_amdgcn_exp2f(C0[12]), e1_ = __builtin_amdgcn_exp2f(C0[13]); sacc += e0_; sacc += e1_; pn1[2] = attn_body::cvtpk_s(e0_, e1_); asm volatile("" : "+v"(sacc), "+v"(pn1)); } A128_SBAR();    \
        U6_RDV(15, vl3, vh3); A128_WAITL(6); A128_SBAR(); U6_MFV(12, pa3, vl0, vh0); { const float e0_ = __builtin_amdgcn_exp2f(C0[14]), e1_ = __builtin_amdgcn_exp2f(C0[15]); sacc += e0_; sacc += e1_; pn1[3] = attn_body::cvtpk_s(e0_, e1_); asm volatile("" : "+v"(sacc), "+v"(pn1)); } A128_SBAR();    \
        U6_RDK(kf0, 0); A128_WAITL(5); A128_SBAR(); U6_MFV(13, pa3, vl1, vh1); A128_SBAR();    \
        U6_RDK(kf1, 512); A128_WAITL(4); A128_SBAR(); U6_MFV(14, pa3, vl2, vh2); { const float e0_ = __builtin_amdgcn_exp2f(C1[0]), e1_ = __builtin_amdgcn_exp2f(C1[1]); sacc += e0_; sacc += e1_; pn2[0] = attn_body::cvtpk_s(e0_, e1_); asm volatile("" : "+v"(sacc), "+v"(pn2)); } A128_SBAR();    \
        U6_RDK(kf2, 2048); A128_WAITL(3); A128_SBAR(); U6_MFV(15, pa3, vl3, vh3); { const float e0_ = __builtin_amdgcn_exp2f(C1[2]), e1_ = __builtin_amdgcn_exp2f(C1[3]); sacc += e0_; sacc += e1_; pn2[1] = attn_body::cvtpk_s(e0_, e1_); asm volatile("" : "+v"(sacc), "+v"(pn2)); } A128_SBAR();    \
        A128_WAITL(2); A128_SBAR(); N0 = __builtin_amdgcn_mfma_f32_32x32x16_bf16(kf0, qr[0], negm, 0, 0, 0); A128_SBAR(); U6_RDK2(kf0, 2560); { const float e0_ = __builtin_amdgcn_exp2f(C1[4]), e1_ = __builtin_amdgcn_exp2f(C1[5]); sacc += e0_; sacc += e1_; pn2[2] = attn_body::cvtpk_s(e0_, e1_); asm volatile("" : "+v"(sacc), "+v"(pn2)); } A128_SBAR();    \
        A128_WAITL(2); A128_SBAR(); N1 = __builtin_amdgcn_mfma_f32_32x32x16_bf16(kf1, qr[0], negm, 0, 0, 0); A128_SBAR(); U6_RDK2(kf1, 4096); { const float e0_ = __builtin_amdgcn_exp2f(C1[6]), e1_ = __builtin_amdgcn_exp2f(C1[7]); sacc += e0_; sacc += e1_; pn2[3] = attn_body::cvtpk_s(e0_, e1_); asm volatile("" : "+v"(sacc), "+v"(pn2)); } A128_SBAR();    \
        A128_WAITL(2); A128_SBAR(); N0 = __builtin_amdgcn_mfma_f32_32x32x16_bf16(kf2, qr[1], N0, 0, 0, 0); A128_SBAR(); U6_RDK2(kf2, 4608); A128_SBAR();    \
        A128_WAITL(2); A128_SBAR(); N1 = __builtin_amdgcn_mfma_f32_32x32x16_bf16(kf0, qr[1], N1, 0, 0, 0); A128_SBAR(); U6_RDK2(kf0, 6144); { const float e0_ = __builtin_amdgcn_exp2f(C1[8]), e1_ = __builtin_amdgcn_exp2f(C1[9]); sacc += e0_; sacc += e1_; pn3[0] = attn_body::cvtpk_s(e0_, e1_); asm volatile("" : "+v"(sacc), "+v"(pn3)); } A128_SBAR();    \
        A128_WAITL(2); A128_SBAR(); N0 = __builtin_amdgcn_mfma_f32_32x32x16_bf16(kf1, qr[2], N0, 0, 0, 0); A128_SBAR(); U6_RDK2(kf1, 6656); { const float e0_ = __builtin_amdgcn_exp2f(C1[10]), e1_ = __builtin_amdgcn_exp2f(C1[11]); sacc += e0_; sacc += e1_; pn3[1] = attn_body::cvtpk_s(e0_, e1_); asm volatile("" : "+v"(sacc), "+v"(pn3)); } A128_SBAR();    \
        A128_WAITL(2); A128_SBAR(); N1 = __builtin_amdgcn_mfma_f32_32x32x16_bf16(kf2, qr[2], N1, 0, 0, 0); { const float e0_ = __builtin_amdgcn_exp2f(C1[12]), e1_ = __builtin_amdgcn_exp2f(C1[13]); sacc += e0_; sacc += e1_; pn3[2] = attn_body::cvtpk_s(e0_, e1_); asm volatile("" : "+v"(sacc), "+v"(pn3)); } A128_SBAR();    \
        A128_WAITL(1); A128_SBAR(); N0 = __builtin_amdgcn_mfma_f32_32x32x16_bf16(kf0, qr[3], N0, 0, 0, 0); { const float e0_ = __builtin_amdgcn_exp2f(C1[14]), e1_ = __builtin_amdgcn_exp2f(C1[15]); sacc += e0_; sacc += e1_; pn3[3] = attn_body::cvtpk_s(e0_, e1_); asm volatile("" : "+v"(sacc), "+v"(pn3)); } A128_SBAR();    \
        A128_WAITL(0); A128_SBAR(); N1 = __builtin_amdgcn_mfma_f32_32x32x16_bf16(kf1, qr[3], N1, 0, 0, 0); A128_SBAR();    \
        asm volatile("s_nop 7" : "+v"(N0), "+v"(N1));                                                                                                            \
        l_reg += sacc;                                                                                                                                            \
        if (resc) { asm volatile("s_waitcnt lgkmcnt(0)" ::: "memory");                                                                                             \
            _Pragma("unroll") for (int r = 0; r < 16; ++r) { const float fr = wsf[attn_body::crow(r, hi)]; o[0][r] *= fr; o[1][r] *= fr; o[2][r] *= fr; o[3][r] *= fr; } } \
        pw0 = pn0; pw1 = pn1; pw2 = pn2; pw3 = pn3;                                                                                                                \
        if ((t) + 4 < NT) asm volatile("s_waitcnt vmcnt(6) lgkmcnt(0)\n\ts_barrier" ::: "memory");                                                                 \
        else if ((t) + 3 < NT) asm volatile("s_waitcnt vmcnt(5) lgkmcnt(0)\n\ts_barrier" ::: "memory");                                                            \
        else if ((t) + 2 < NT) asm volatile("s_waitcnt vmcnt(4) lgkmcnt(0)\n\ts_barrier" ::: "memory");                                                            \
        else if ((t) + 1 < NT) asm volatile("s_waitcnt vmcnt(2) lgkmcnt(0)\n\ts_barrier" ::: "memory");                                                            \
        else asm volatile("s_waitcnt vmcnt(0) lgkmcnt(0)\n\ts_barrier" ::: "memory"); } while (0)

    for (int t = 1; t + 2 < NT; t += 2) { U6_STEP(cb0, cb1, ca0, ca1, t); U6_STEP(ca0, ca1, cb0, cb1, t + 1); }
    U6_STEP(cb0, cb1, ca0, ca1, NT - 1);
#undef U6_STEP
#undef U6_RDV
#undef U6_MFV
#undef U6_RDK
#undef U6_RDK2
    pv128(o, vb0 + ((NT - 1) & 3) * VSLOT, __builtin_bit_cast(bf16x8, pw0), __builtin_bit_cast(bf16x8, pw1), __builtin_bit_cast(bf16x8, pw2), __builtin_bit_cast(bf16x8, pw3));
    { auto rr = __builtin_amdgcn_permlane32_swap(__float_as_uint(l_reg), __float_as_uint(l_reg), false, false); l_reg = __uint_as_float(rr[0]) + __uint_as_float(rr[1]); }
    int lne = lane; asm volatile("" : "+v"(lne));
    const int r32e = lne & 31, hie = lne >> 5;
    if (hie == 0) wsf[32 + r32e] = l_reg; asm volatile("s_waitcnt lgkmcnt(0)" ::: "memory");
    float rli[16];
#pragma unroll
    for (int r = 0; r < 16; ++r) rli[r] = __builtin_amdgcn_rcpf(wsf[32 + attn_body::crow(r, hie)]);
    bf16* Ow = O + (rowbase + q0 + wid * QBLK) * DMP + hv * 64;
    { bf16* stg = (bf16*)(shm + L2_OST) + wid * 2048;
#pragma unroll
      for (int half = 0; half < 2; ++half) {
#pragma unroll
          for (int r = 0; r < 16; ++r) { const int orow = attn_body::crow(r, hie);
#pragma unroll
              for (int d0 = 0; d0 < 2; ++d0) stg[orow * 64 + d0 * 32 + r32e] = __float2bfloat16(o[2 * half + d0][r] * rli[r]); }
          asm volatile("s_waitcnt lgkmcnt(0)" ::: "memory");
#pragma unroll
          for (int i = 0; i < 4; ++i) { const int row = i * 8 + (lne >> 3), ch = lne & 7; const u32x4 v = *(const u32x4*)(stg + row * 64 + ch * 8); *(u32x4*)(Ow + (long)row * DMP + half * 64 + ch * 8) = v; }
          asm volatile("s_waitcnt lgkmcnt(0)" ::: "memory"); } }
    asm volatile("s_waitcnt lgkmcnt(0)\n\ts_barrier" ::: "memory");
#undef A128_DMAK
#undef A128_DMAV
}
#undef A128_SBAR
#undef A128_WAITL
}

#ifndef GAS
#define GAS __attribute__((address_space(1)))
#endif
#define LAS __attribute__((address_space(3)))
typedef unsigned short bf16;
typedef unsigned v4u __attribute__((ext_vector_type(4)));
typedef float f32x4 __attribute__((ext_vector_type(4)));
typedef float f32x2 __attribute__((ext_vector_type(2)));
typedef short bf16x8 __attribute__((ext_vector_type(8)));
typedef GAS unsigned gu32;
typedef GAS unsigned long long gu64;
#define RLX_AGENT __ATOMIC_RELAXED, __HIP_MEMORY_SCOPE_AGENT
#define LDS_WAIT() asm volatile("s_waitcnt lgkmcnt(0)" ::: "memory")
#define VM_WAIT() asm volatile("s_waitcnt vmcnt(0)" ::: "memory")
__device__ __forceinline__ unsigned long long rt() { return __builtin_amdgcn_s_memrealtime(); }
typedef float f32x2_pk __attribute__((ext_vector_type(2))); typedef __bf16 bf16x2_pk __attribute__((ext_vector_type(2)));
__device__ __forceinline__ unsigned pk2h(float lo, float hi) { f32x2_pk v = {lo, hi}; bf16x2_pk b = __builtin_convertvector(v, bf16x2_pk); return __builtin_bit_cast(unsigned, b); }
__device__ __forceinline__ unsigned pk2(float lo, float hi) { f32x2_pk v = {lo, hi}; bf16x2_pk b = __builtin_convertvector(v, bf16x2_pk); return __builtin_bit_cast(unsigned, b); }

#define XB_TMO      128
#define XB_XCNT(j)  (256  + 64 * (j))
#define XB_XSUB(j)  (1280 + 64 * (j))
#define XB_XGEN(j)  (2304 + 64 * (j))
#define XB_TOP      3328
#define XB_TOPGEN   3392
#define XCD_BAR_WORDS 3456
#define XB_SPIN_CAP (1u << 18)

__device__ __forceinline__ unsigned xb_ld(unsigned* p)              { return __hip_atomic_load(p, __ATOMIC_RELAXED, __HIP_MEMORY_SCOPE_AGENT); }
__device__ __forceinline__ unsigned xb_add(unsigned* p, unsigned v) { return __hip_atomic_fetch_add(p, v, __ATOMIC_RELAXED, __HIP_MEMORY_SCOPE_AGENT); }
__device__ __forceinline__ unsigned xb_xcc_id() { return (unsigned)__builtin_amdgcn_s_getreg((3 << 11) | 20) & 0xFu; }
#define XB_SPIN(cond, bar) do { unsigned _sp = 0; while (cond) { __builtin_amdgcn_s_sleep(1); \
    if ((++_sp & 255u) == 0u) { if (xb_ld(&(bar)[XB_TMO])) break; if (_sp > XB_SPIN_CAP) { atomicAdd(&(bar)[XB_TMO], 1u); break; } } } } while (0)

struct XcdBarrier {
    unsigned* bar; unsigned x;
    volatile LAS unsigned* st;
};

__device__ __forceinline__ XcdBarrier xcd_barrier_post(unsigned* bar, volatile LAS unsigned* st) {
    XcdBarrier b; b.bar = bar; b.x = xb_xcc_id(); b.st = st;
    if (threadIdx.x == 0) (void)xb_add(&bar[XB_XCNT(b.x)], 1u);
    return b;
}
__device__ __forceinline__ void xcd_barrier_complete(unsigned* bar, unsigned x, unsigned& nloc, unsigned& nx) {
    const unsigned G = gridDim.x * gridDim.y * gridDim.z;
    unsigned sum, cnt, mine, sp = 0u;
    for (;;) {
        sum = 0u; cnt = 0u; mine = 0u;
#pragma unroll
        for (unsigned j = 0; j < 16; ++j) { const unsigned c = xb_ld(&bar[XB_XCNT(j)]); sum += c; cnt += (c > 0u) ? 1u : 0u; mine = (j == x) ? c : mine; }
        if (sum == G) break;
        __builtin_amdgcn_s_sleep(1);
        if ((++sp & 255u) == 0u) { if (xb_ld(&bar[XB_TMO])) break; if (sp > XB_SPIN_CAP) { atomicAdd(&bar[XB_TMO], 1u); break; } }
    }
    nloc = mine > 0u ? mine : 1u; nx = cnt > 0u ? cnt : 1u;
}

__device__ __forceinline__ void xcd_barrier(const XcdBarrier& b) {
    asm volatile("s_waitcnt vmcnt(0)" ::: "memory");
    __syncthreads();
    if (tid_now((const void*)(uintptr_t)((unsigned)(uintptr_t)b.st - (320 + 32) - 152576)) == 0) {
        unsigned* bar = b.bar;
        __builtin_amdgcn_s_waitcnt(0);
        unsigned nloc = b.st[0], nx = b.st[1];
        if (nloc == 0u) { xcd_barrier_complete(bar, b.x, nloc, nx); b.st[0] = nloc; b.st[1] = nx; }
        const unsigned old = xb_add(&bar[XB_XSUB(b.x)], 1u);
        const unsigned gen = old / nloc;
        if (old + 1u == (gen + 1u) * nloc) {
            __builtin_amdgcn_fence(__ATOMIC_RELEASE, "agent");
            asm volatile("s_waitcnt vmcnt(0)" ::: "memory");
            const unsigned og = xb_add(&bar[XB_TOP], 1u);
            const unsigned tg = og / nx;
            if (og + 1u == (tg + 1u) * nx) xb_add(&bar[XB_TOPGEN], 1u);
            else XB_SPIN(xb_ld(&bar[XB_TOPGEN]) == tg, bar);
            __builtin_amdgcn_fence(__ATOMIC_ACQUIRE, "agent");
            xb_add(&bar[XB_XGEN(b.x)], 1u);
            asm volatile("s_waitcnt vmcnt(0)" ::: "memory");
        } else {
            XB_SPIN(xb_ld(&bar[XB_XGEN(b.x)]) == gen, bar);
            __builtin_amdgcn_fence(__ATOMIC_ACQUIRE, "agent");
            asm volatile("s_waitcnt vmcnt(0)" ::: "memory");
        }
    }
    __syncthreads();
}

namespace gdn {
constexpr int BLK = 75776, OFF_NEGW = 0, OFF_QDEC = 16384, OFF_KDT = 32768, OFF_AQK = 49152, OFF_U = 57344, OFF_HDR = 73728;
constexpr int GRP_BYTES = 74752, G_KN = 0, G_QN = 16384, G_VC = 32768, G_AM = 49152, G_AQS = 65536, G_CG = 73728, G_BT = 73984, G_FK = 74240;
typedef short bf16x8 __attribute__((ext_vector_type(8)));
typedef float f32x16 __attribute__((ext_vector_type(16)));
__device__ __forceinline__ int crow(int r, int hi) { return (r & 3) + 8 * (r >> 2) + 4 * hi; }
__device__ __forceinline__ int kperm(int k) { return (k & ~12) | ((k & 4) << 1) | ((k & 8) >> 1); }
__device__ __forceinline__ unsigned pk2h(float lo, float hi) { typedef float f2_ __attribute__((ext_vector_type(2))); typedef __bf16 b2_ __attribute__((ext_vector_type(2))); f2_ v = {lo, hi}; b2_ b = __builtin_convertvector(v, b2_); return __builtin_bit_cast(unsigned, b); }
__device__ __forceinline__ float silu(float a) { return a * __builtin_amdgcn_rcpf(1.0f + __expf(-a)); }

__device__ __forceinline__ void stageA(LAS unsigned char* lds, int tid, int vcu, int G, const bf16_t* slab, const float* conv_w, const float* bg, unsigned char* r2, volatile LAS unsigned* PRB) {
    const int grp = __builtin_amdgcn_readfirstlane(tid >> 8), tg = tid & 255, lane = tid & 63; const int wg = __builtin_amdgcn_readfirstlane((tid >> 6) & 3);
    LAS unsigned char* gb = lds + grp * GRP_BYTES;
    LAS float* CG = (LAS float*)(gb + G_CG); LAS float* BT = (LAS float*)(gb + G_BT); LAS float* FK = (LAS float*)(gb + G_FK); LAS float* AM = (LAS float*)(gb + G_AM);
    float pcw[6], pgv = 0.f, pbt = 0.f;
#define GDN_S0LOAD(IT) do { const int ch_ = 2 * (IT) + grp; const int n_ = ch_ & 127, bh_ = ch_ >> 7, h_ = bh_ & 7, b_ = bh_ >> 3; const size_t row0_ = (size_t)b_ * SEQ + 64 * n_; int tq_ = tg; asm volatile("" : "+v"(tq_)); \
        _Pragma("unroll") for (int i = 0; i < 6; ++i) { const int idx = tq_ + 256 * i; const int tj = idx >> 7, col = idx & 127; pcw[i] = *(const GAS float*)(conv_w + (tj & 3) * 3072 + (tj >> 2) * 1024 + h_ * 128 + col); } \
        if (wg == 0) { const int ln0_ = tq_ & 63; pgv = *(const GAS float*)(bg + (row0_ + ln0_) * 16 + 8 + h_); pbt = *(const GAS float*)(bg + (row0_ + ln0_) * 16 + h_); } } while (0)
    if (vcu < 1024) GDN_S0LOAD(vcu);
    for (int it = vcu; it < 1024; it += G) {
        const int ch = 2 * it + grp; const int n = ch & 127, bh = ch >> 7, h = bh & 7, b = bh >> 3;
        const size_t row0 = (size_t)b * SEQ + 64 * n;
        unsigned char* blk = r2 + (size_t)ch * BLK;
        PRB_B(26, PRB); PRB_B(20, PRB);
        int tg0 = tg; asm volatile("" : "+v"(tg0));
        { LAS float* CW = (LAS float*)(gb + G_AQS);
#pragma unroll
          for (int i = 0; i < 6; ++i) CW[tg0 + 256 * i] = pcw[i]; }
        if (wg == 0) { const int ln0 = tg0 & 63; const float gv = pgv, bt = pbt; float cg = gv;
#pragma unroll
            for (int o = 1; o < 64; o <<= 1) { const float t = __shfl_up(cg, o); if (ln0 >= o) cg += t; }
            CG[ln0] = cg; BT[ln0] = bt; FK[ln0] = bt * __expf(cg); }
        __syncthreads(); PRB_E(20, PRB); PRB_B(21, PRB);
        { int tg1 = tg; asm volatile("" : "+v"(tg1)); const int r = tg1 >> 2, seg = tg1 & 3; const float cgr = CG[r], cgl = CG[63];
          v4u raw[4][4], rawn[4][4];
#define GDN_LOADRAW(DST, TY) do { const bf16_t* src_ = slab + (size_t)(3 + (TY)) * (SLAB / 2) + h * 128 + seg * 32;                                          \
            _Pragma("unroll") for (int j = 0; j < 4; ++j) { const bool ok = (64 * n + r - 3 + j) >= 0;     \
                _Pragma("unroll") for (int sub = 0; sub < 4; ++sub) { DST[j][sub] = *(const GAS v4u*)(src_ + (row0 + (ok ? r - 3 + j : 0)) * DM + sub * 8); } } } while (0)
          GDN_LOADRAW(raw, 0);
#pragma unroll
          for (int ty = 0; ty < 3; ++ty) {
            float val[32];
            __builtin_amdgcn_sched_barrier(0);
#pragma unroll
            for (int sub = 0; sub < 4; ++sub) {
                float a8[8];
#pragma unroll
                for (int e = 0; e < 8; ++e) a8[e] = 0.f;
#pragma unroll
                for (int j = 0; j < 4; ++j) { const bool okj = (64 * n + r - 3 + j) >= 0; v4u rw_ = raw[j][sub]; if (!okj) rw_ = (v4u){0u, 0u, 0u, 0u};
                    const f32x4 w0 = *(const LAS f32x4*)(gb + G_AQS + ((ty * 4 + j) * 128 + seg * 32 + sub * 8) * 4), w1 = *(const LAS f32x4*)(gb + G_AQS + ((ty * 4 + j) * 128 + seg * 32 + sub * 8 + 4) * 4);
                    a8[0] += w0.x * __uint_as_float(rw_.x << 16); a8[1] += w0.y * __uint_as_float(rw_.x & 0xffff0000u); a8[2] += w0.z * __uint_as_float(rw_.y << 16); a8[3] += w0.w * __uint_as_float(rw_.y & 0xffff0000u);
                    a8[4] += w1.x * __uint_as_float(rw_.z << 16); a8[5] += w1.y * __uint_as_float(rw_.z & 0xffff0000u); a8[6] += w1.z * __uint_as_float(rw_.w << 16); a8[7] += w1.w * __uint_as_float(rw_.w & 0xffff0000u); }
#pragma unroll
                for (int e = 0; e < 8; ++e) val[sub * 8 + e] = silu(a8[e]);
                asm volatile("" : "+v"(val[sub * 8 + 0]), "+v"(val[sub * 8 + 1]), "+v"(val[sub * 8 + 2]), "+v"(val[sub * 8 + 3]), "+v"(val[sub * 8 + 4]), "+v"(val[sub * 8 + 5]), "+v"(val[sub * 8 + 6]), "+v"(val[sub * 8 + 7]) :: "memory");
            }
            __builtin_amdgcn_sched_barrier(0);
            if (ty < 2) { GDN_LOADRAW(rawn, ty + 1); }
            __builtin_amdgcn_sched_barrier(0);
            if (ty < 2) { float ss = 0.f;
#pragma unroll
                for (int e = 0; e < 32; ++e) ss += val[e] * val[e];
                ss += __shfl_xor(ss, 1); ss += __shfl_xor(ss, 2);
                float sc = __builtin_amdgcn_rsqf(ss + NORM_EPS); if (ty == 0) sc *= 0.08838834764831845f;
#pragma unroll
                for (int e = 0; e < 32; ++e) val[e] *= sc; }
            LAS unsigned char* img = gb + (ty == 0 ? G_QN : ty == 1 ? G_KN : G_VC);
#pragma unroll
            for (int sub = 0; sub < 4; ++sub) { v4u o; o.x = pk2h(val[sub * 8], val[sub * 8 + 1]); o.y = pk2h(val[sub * 8 + 2], val[sub * 8 + 3]); o.z = pk2h(val[sub * 8 + 4], val[sub * 8 + 5]); o.w = pk2h(val[sub * 8 + 6], val[sub * 8 + 7]);
                *(LAS v4u*)(img + r * 256 + (((4 * seg + sub) ^ (r & 15)) << 4)) = o; }
            if (ty == 0) {
                const float f = __expf(cgr);
#pragma unroll
                for (int kb = 0; kb < 2; ++kb)
#pragma unroll
                    for (int hh = 0; hh < 2; ++hh) { const int k0 = 16 * kb + 4 * hh; v4u o; o.x = pk2h(val[k0] * f, val[k0 + 1] * f); o.y = pk2h(val[k0 + 2] * f, val[k0 + 3] * f); o.z = pk2h(val[k0 + 8] * f, val[k0 + 9] * f); o.w = pk2h(val[k0 + 10] * f, val[k0 + 11] * f);
                        const int chunk = 2 * (2 * seg + kb) + hh; *(GAS v4u*)(blk + OFF_QDEC + r * 256 + ((chunk ^ (r & 15)) << 4)) = o; } }
            if (ty == 1) {
                const float f = __expf(cgl - cgr); const int sc = kperm(r);
#pragma unroll
                for (int e = 0; e < 32; ++e) { const int d = 32 * seg + e; *(LAS bf16_t*)(gb + G_AM + d * 128 + ((((sc >> 3) ^ ((d >> 1) & 7))) << 4) + (sc & 7) * 2) = (bf16_t)pk2h(val[e] * f, 0.f); } }
            __builtin_amdgcn_sched_barrier(0);
            if (ty < 2) {
#pragma unroll
                for (int j = 0; j < 4; ++j)
#pragma unroll
                    for (int sub = 0; sub < 4; ++sub) raw[j][sub] = rawn[j][sub]; }
          }
#undef GDN_LOADRAW
        }
        __syncthreads(); PRB_E(21, PRB); PRB_B(22, PRB);
        { int tgf = tg; asm volatile("" : "+v"(tgf));
#pragma unroll
          for (int i = 0; i < 4; ++i) *(GAS v4u*)(blk + OFF_KDT + tgf * 16 + i * 4096) = *(const LAS v4u*)(gb + G_AM + tgf * 16 + i * 4096); }
        __syncthreads(); PRB_E(22, PRB); PRB_B(23, PRB);
        if (wg < 3) { const int ib = (wg + 1) >> 1, jb = wg >> 1; int ln3 = lane; asm volatile("" : "+v"(ln3)); const int r32 = ln3 & 31, hi = ln3 >> 5; const int rowA = ib * 32 + r32, rowB = jb * 32 + r32;
            f32x16 ckk, cqk;
#pragma unroll
            for (int r = 0; r < 16; ++r) { ckk[r] = 0.f; cqk[r] = 0.f; }
#pragma unroll
            for (int ks = 0; ks < 8; ++ks) {
                const bf16x8 ak = *(const LAS bf16x8*)(gb + G_KN + rowA * 256 + (((2 * ks + hi) ^ (rowA & 15)) << 4));
                const bf16x8 aq = *(const LAS bf16x8*)(gb + G_QN + rowA * 256 + (((2 * ks + hi) ^ (rowA & 15)) << 4));
                const bf16x8 bk = *(const LAS bf16x8*)(gb + G_KN + rowB * 256 + (((2 * ks + hi) ^ (rowB & 15)) << 4));
                ckk = __builtin_amdgcn_mfma_f32_32x32x16_bf16(ak, bk, ckk, 0, 0, 0); cqk = __builtin_amdgcn_mfma_f32_32x32x16_bf16(aq, bk, cqk, 0, 0, 0); }
            const int j = jb * 32 + r32; const float cgj = CG[j]; const int scj = kperm(j);
#pragma unroll
            for (int r = 0; r < 16; ++r) { const int i = ib * 32 + crow(r, hi); const float dec = __expf(fminf(CG[i] - cgj, 0.f));
                AM[i * 64 + j] = (j < i) ? BT[i] * ckk[r] * dec : 0.f;
                *(LAS bf16_t*)(gb + G_AQS + i * 128 + ((((scj >> 3) ^ ((i >> 1) & 7))) << 4) + (scj & 7) * 2) = (bf16_t)pk2h((j <= i) ? cqk[r] * dec : 0.f, 0.f); } }
        else { int l3 = lane; asm volatile("" : "+v"(l3));
#pragma unroll
            for (int i = 0; i < 8; ++i) { const int row = 4 * i + (l3 >> 4), c4 = (l3 & 15) >> 2, w = l3 & 3; *(LAS unsigned*)(gb + G_AQS + row * 128 + (((4 + c4) ^ ((row >> 1) & 7)) << 4) + w * 4) = 0u; } }
        __syncthreads(); PRB_E(23, PRB); PRB_B(24, PRB);
        { int tgf = tg; asm volatile("" : "+v"(tgf));
#pragma unroll
          for (int i = 0; i < 2; ++i) *(GAS v4u*)(blk + OFF_AQK + tgf * 16 + i * 4096) = *(const LAS v4u*)(gb + G_AQS + tgf * 16 + i * 4096); }
        if (it + G < 1024) GDN_S0LOAD(it + G);
        { const bool isw = wg >= 2; int tg5 = tg; asm volatile("" : "+v"(tg5)); const int cc = tg5 & 127; const LAS unsigned char* img = gb + (isw ? G_KN : G_VC); const LAS float* fac = isw ? FK : BT;
          float X[64];
#pragma unroll
          for (int jj = 0; jj < 64; ++jj) { const bf16_t raw = *(const LAS bf16_t*)(img + jj * 256 + ((((cc >> 3) ^ (jj & 15))) << 4) + (cc & 7) * 2); X[jj] = bf2f(raw) * fac[jj]; }
          f32x4 arow[2][16];
          arow[1][0] = *(const LAS f32x4*)(AM + 1 * 64);
#pragma unroll
          for (int i = 1; i < 64; ++i) {
              if (i + 1 < 64) {
#pragma unroll
                  for (int q = 0; q < (i + 1 + 3) / 4; ++q) arow[(i + 1) & 1][q] = *(const LAS f32x4*)(AM + (i + 1) * 64 + 4 * q); }
              __builtin_amdgcn_sched_barrier(0);
              float acc0 = X[i], acc1 = 0.f;
#pragma unroll
              for (int q = 0; q < (i + 3) / 4; ++q) { const f32x4 a4 = arow[i & 1][q]; const int j4 = 4 * q;
                  acc0 -= a4.x * X[j4]; if (j4 + 1 < i) acc1 -= a4.y * X[j4 + 1]; if (j4 + 2 < i) acc0 -= a4.z * X[j4 + 2]; if (j4 + 3 < i) acc1 -= a4.w * X[j4 + 3]; }
              X[i] = acc0 + acc1; __builtin_amdgcn_sched_barrier(0); }
          if (!isw) { const int slice = cc >> 5, c31 = cc & 31;
#pragma unroll
              for (int mt = 0; mt < 2; ++mt)
#pragma unroll
                  for (int rp = 0; rp < 8; ++rp)
#pragma unroll
                      for (int hi = 0; hi < 2; ++hi) *(GAS unsigned*)(blk + OFF_U + ((((slice * 2 + mt) * 8 + rp) * 64) + hi * 32 + c31) * 4) = pk2h(X[32 * mt + crow(2 * rp, hi)], X[32 * mt + crow(2 * rp + 1, hi)]);
          } else { const int sc = kperm(cc);
#pragma unroll
              for (int i = 0; i < 64; ++i) *(LAS bf16_t*)(gb + G_QN + i * 256 + ((((sc >> 3) ^ (i & 15))) << 4) + (sc & 7) * 2) = (bf16_t)pk2h(-X[i], 0.f); }
          if (tg5 == 0) *(GAS float*)(blk + OFF_HDR) = __expf(CG[63]);
        }
        __syncthreads(); PRB_E(24, PRB); PRB_B(25, PRB);
        { int tgf = tg; asm volatile("" : "+v"(tgf));
#pragma unroll
          for (int i = 0; i < 4; ++i) *(GAS v4u*)(blk + OFF_NEGW + tgf * 16 + i * 4096) = *(const LAS v4u*)(gb + G_QN + tgf * 16 + i * 4096); }
        __syncthreads(); PRB_E(25, PRB); PRB_E(26, PRB);
    }
#undef GDN_S0LOAD
}

__device__ __forceinline__ void glds16(const void* gsrc, unsigned lds_dst) { unsigned keep;
    asm volatile("s_mov_b32 %0, m0\n\ts_mov_b32 m0, %2\n\ts_nop 0\n\tglobal_load_lds_dwordx4 %1, off\n\ts_mov_b32 m0, %0" : "=&s"(keep) : "v"(gsrc), "s"(lds_dst) : "memory"); }
__device__ __forceinline__ bf16x8 pack8(const f32x16& v, int s) { v4u o; o.x = pk2h(v[8 * s], v[8 * s + 1]); o.y = pk2h(v[8 * s + 2], v[8 * s + 3]); o.z = pk2h(v[8 * s + 4], v[8 * s + 5]); o.w = pk2h(v[8 * s + 6], v[8 * s + 7]); return __builtin_bit_cast(bf16x8, o); }
#define GDN_WAITL(n) asm volatile("s_waitcnt lgkmcnt(" #n ")" ::: "memory")
#define GDN_SBAR() __builtin_amdgcn_sched_barrier(0)
__device__ __forceinline__ void scan(unsigned char* lds_generic, int tid, int bh, const unsigned char* r2, bf16_t* OB) {
    const int lane = tid & 63; const int wave = __builtin_amdgcn_readfirstlane(tid >> 6);
    const int h = bh & 7, b = bh >> 3;
    const unsigned char* blk0 = r2 + (size_t)bh * 128 * BLK;
    const unsigned lds0 = (unsigned)(uintptr_t)lds_generic;
    const LAS unsigned char* L = (const LAS unsigned char*)lds_generic;
#define GDN_DMA(n, buf) do { const unsigned char* gsrc_ = blk0 + (size_t)(n) * BLK + lane * 16; _Pragma("unroll") for (int i_ = 0; i_ < 10; ++i_) { const int p_ = wave + 8 * i_; if (p_ < 74) glds16(gsrc_ + p_ * 1024, (unsigned)__builtin_amdgcn_readfirstlane(lds0 + (buf) * BLK + p_ * 1024)); } } while (0)
    f32x16 S[4];
    { float zz; asm volatile("v_mov_b32 %0, 0" : "=v"(zz));
#pragma unroll
      for (int kt = 0; kt < 4; ++kt)
#pragma unroll
          for (int r = 0; r < 16; ++r) S[kt][r] = zz; }
    GDN_DMA(0, 0);
    asm volatile("s_waitcnt vmcnt(0) lgkmcnt(0)\n\ts_barrier" ::: "memory");
    for (int n = 0; n < 128; ++n) {
        const int buf = n & 1;
        if (n + 1 < 128) GDN_DMA(n + 1, buf ^ 1);
        if (wave < 4) {
            int lnc = lane; asm volatile("" : "+v"(lnc)); const int r32 = lnc & 31, hi = lnc >> 5;
            const int base = (int)(lds0 + buf * BLK);
            const float gl = *(const LAS float*)(L + buf * BLK + OFF_HDR);
            bf16x8 Sb[4][2];
#pragma unroll
            for (int kt = 0; kt < 4; ++kt) { Sb[kt][0] = pack8(S[kt], 0); Sb[kt][1] = pack8(S[kt], 1); }
            f32x16 av[2], ao[2];
#pragma unroll
            for (int mt = 0; mt < 2; ++mt) {
#pragma unroll
                for (int rp = 0; rp < 8; ++rp) { const unsigned w = *(const LAS unsigned*)(L + buf * BLK + OFF_U + ((((wave * 2 + mt) * 8 + rp) * 64) + lnc) * 4); av[mt][2 * rp] = __uint_as_float(w << 16); av[mt][2 * rp + 1] = __uint_as_float(w & 0xffff0000u); }
#pragma unroll
                for (int r = 0; r < 16; ++r) ao[mt][r] = 0.f; }
            const int a8_0 = base + r32 * 256 + (((0 + hi) ^ (r32 & 15)) << 4), a8_1 = base + r32 * 256 + (((2 + hi) ^ (r32 & 15)) << 4), a8_2 = base + r32 * 256 + (((4 + hi) ^ (r32 & 15)) << 4), a8_3 = base + r32 * 256 + (((6 + hi) ^ (r32 & 15)) << 4),
                      a8_4 = base + r32 * 256 + (((8 + hi) ^ (r32 & 15)) << 4), a8_5 = base + r32 * 256 + (((10 + hi) ^ (r32 & 15)) << 4), a8_6 = base + r32 * 256 + (((12 + hi) ^ (r32 & 15)) << 4), a8_7 = base + r32 * 256 + (((14 + hi) ^ (r32 & 15)) << 4);
            const int a4_0 = base + r32 * 128 + (((0 + hi) ^ ((r32 >> 1) & 7)) << 4), a4_1 = base + r32 * 128 + (((2 + hi) ^ ((r32 >> 1) & 7)) << 4), a4_2 = base + r32 * 128 + (((4 + hi) ^ ((r32 >> 1) & 7)) << 4), a4_3 = base + r32 * 128 + (((6 + hi) ^ ((r32 >> 1) & 7)) << 4);
            bf16x8 Vb[2][2]; bf16x8 f0, f1, f2, f3, f4;
            asm volatile("s_waitcnt lgkmcnt(0)" ::: "memory"); GDN_SBAR();
#define GDN_RDA(F, A, OFF) asm volatile("ds_read_b128 %0,%1 offset:%c2" : "=&v"(F) : "v"(A), "i"(OFF) : "memory")
            GDN_RDA(f0, a8_0, OFF_NEGW + 0); GDN_RDA(f1, a8_0, OFF_QDEC + 0); GDN_RDA(f2, a8_1, OFF_NEGW + 0); GDN_RDA(f3, a8_1, OFF_QDEC + 0);
            GDN_RDA(f4, a8_2, OFF_NEGW + 0); GDN_WAITL(4); GDN_SBAR(); av[0] = __builtin_amdgcn_mfma_f32_32x32x16_bf16(f0, Sb[0][0], av[0], 0, 0, 0);
            GDN_RDA(f0, a8_2, OFF_QDEC + 0); GDN_WAITL(4); GDN_SBAR(); ao[0] = __builtin_amdgcn_mfma_f32_32x32x16_bf16(f1, Sb[0][0], ao[0], 0, 0, 0);
            GDN_RDA(f1, a8_3, OFF_NEGW + 0); GDN_WAITL(4); GDN_SBAR(); av[0] = __builtin_amdgcn_mfma_f32_32x32x16_bf16(f2, Sb[0][1], av[0], 0, 0, 0);
            GDN_RDA(f2, a8_3, OFF_QDEC + 0); GDN_WAITL(4); GDN_SBAR(); ao[0] = __builtin_amdgcn_mfma_f32_32x32x16_bf16(f3, Sb[0][1], ao[0], 0, 0, 0);
            GDN_RDA(f3, a8_4, OFF_NEGW + 0); GDN_WAITL(4); GDN_SBAR(); av[0] = __builtin_amdgcn_mfma_f32_32x32x16_bf16(f4, Sb[1][0], av[0], 0, 0, 0);
            GDN_RDA(f4, a8_4, OFF_QDEC + 0); GDN_WAITL(4); GDN_SBAR(); ao[0] = __builtin_amdgcn_mfma_f32_32x32x16_bf16(f0, Sb[1][0], ao[0], 0, 0, 0);
            GDN_RDA(f0, a8_5, OFF_NEGW + 0); GDN_WAITL(4); GDN_SBAR(); av[0] = __builtin_amdgcn_mfma_f32_32x32x16_bf16(f1, Sb[1][1], av[0], 0, 0, 0);
            GDN_RDA(f1, a8_5, OFF_QDEC + 0); GDN_WAITL(4); GDN_SBAR(); ao[0] = __builtin_amdgcn_mfma_f32_32x32x16_bf16(f2, Sb[1][1], ao[0], 0, 0, 0);
            GDN_RDA(f2, a8_6, OFF_NEGW + 0); GDN_WAITL(4); GDN_SBAR(); av[0] = __builtin_amdgcn_mfma_f32_32x32x16_bf16(f3, Sb[2][0], av[0], 0, 0, 0);
            GDN_RDA(f3, a8_6, OFF_QDEC + 0); GDN_WAITL(4); GDN_SBAR(); ao[0] = __builtin_amdgcn_mfma_f32_32x32x16_bf16(f4, Sb[2][0], ao[0], 0, 0, 0);
            GDN_RDA(f4, a8_7, OFF_NEGW + 0); GDN_WAITL(4); GDN_SBAR(); av[0] = __builtin_amdgcn_mfma_f32_32x32x16_bf16(f0, Sb[2][1], av[0], 0, 0, 0);
            GDN_RDA(f0, a8_7, OFF_QDEC + 0); GDN_WAITL(4); GDN_SBAR(); ao[0] = __builtin_amdgcn_mfma_f32_32x32x16_bf16(f1, Sb[2][1], ao[0], 0, 0, 0);
            GDN_RDA(f1, a8_0, OFF_NEGW + 8192); GDN_WAITL(4); GDN_SBAR(); av[0] = __builtin_amdgcn_mfma_f32_32x32x16_bf16(f2, Sb[3][0], av[0], 0, 0, 0);
            GDN_RDA(f2, a8_0, OFF_QDEC + 8192); GDN_WAITL(4); GDN_SBAR(); ao[0] = __builtin_amdgcn_mfma_f32_32x32x16_bf16(f3, Sb[3][0], ao[0], 0, 0, 0);
            GDN_RDA(f3, a8_1, OFF_NEGW + 8192); GDN_WAITL(4); GDN_SBAR(); av[0] = __builtin_amdgcn_mfma_f32_32x32x16_bf16(f4, Sb[3][1], av[0], 0, 0, 0);
            GDN_RDA(f4, a8_1, OFF_QDEC + 8192); GDN_WAITL(4); GDN_SBAR(); ao[0] = __builtin_amdgcn_mfma_f32_32x32x16_bf16(f0, Sb[3][1], ao[0], 0, 0, 0);
            GDN_RDA(f0, a8_2, OFF_NEGW + 8192); GDN_WAITL(4); GDN_SBAR(); av[1] = __builtin_amdgcn_mfma_f32_32x32x16_bf16(f1, Sb[0][0], av[1], 0, 0, 0);
            GDN_RDA(f1, a8_2, OFF_QDEC + 8192); GDN_WAITL(4); GDN_SBAR(); ao[1] = __builtin_amdgcn_mfma_f32_32x32x16_bf16(f2, Sb[0][0], ao[1], 0, 0, 0);
            GDN_RDA(f2, a8_3, OFF_NEGW + 8192); GDN_WAITL(4); GDN_SBAR(); av[1] = __builtin_amdgcn_mfma_f32_32x32x16_bf16(f3, Sb[0][1], av[1], 0, 0, 0);
            GDN_RDA(f3, a8_3, OFF_QDEC + 8192); GDN_WAITL(4); GDN_SBAR(); ao[1] = __builtin_amdgcn_mfma_f32_32x32x16_bf16(f4, Sb[0][1], ao[1], 0, 0, 0);
            GDN_RDA(f4, a8_4, OFF_NEGW + 8192); GDN_WAITL(4); GDN_SBAR(); av[1] = __builtin_amdgcn_mfma_f32_32x32x16_bf16(f0, Sb[1][0], av[1], 0, 0, 0);
            GDN_RDA(f0, a8_4, OFF_QDEC + 8192); GDN_WAITL(4); GDN_SBAR(); ao[1] = __builtin_amdgcn_mfma_f32_32x32x16_bf16(f1, Sb[1][0], ao[1], 0, 0, 0);
            GDN_RDA(f1, a8_5, OFF_NEGW + 8192); GDN_WAITL(4); GDN_SBAR(); av[1] = __builtin_amdgcn_mfma_f32_32x32x16_bf16(f2, Sb[1][1], av[1], 0, 0, 0);
            GDN_RDA(f2, a8_5, OFF_QDEC + 8192); GDN_WAITL(4); GDN_SBAR(); ao[1] = __builtin_amdgcn_mfma_f32_32x32x16_bf16(f3, Sb[1][1], ao[1], 0, 0, 0);
            GDN_RDA(f3, a8_6, OFF_NEGW + 8192); GDN_WAITL(4); GDN_SBAR(); av[1] = __builtin_amdgcn_mfma_f32_32x32x16_bf16(f4, Sb[2][0], av[1], 0, 0, 0);
            GDN_RDA(f4, a8_6, OFF_QDEC + 8192); GDN_WAITL(4); GDN_SBAR(); ao[1] = __builtin_amdgcn_mfma_f32_32x32x16_bf16(f0, Sb[2][0], ao[1], 0, 0, 0);
            GDN_RDA(f0, a8_7, OFF_NEGW + 8192); GDN_WAITL(4); GDN_SBAR(); av[1] = __builtin_amdgcn_mfma_f32_32x32x16_bf16(f1, Sb[2][1], av[1], 0, 0, 0);
            GDN_RDA(f1, a8_7, OFF_QDEC + 8192); GDN_WAITL(4); GDN_SBAR(); ao[1] = __builtin_amdgcn_mfma_f32_32x32x16_bf16(f2, Sb[2][1], ao[1], 0, 0, 0);
            GDN_RDA(f2, a4_0, OFF_AQK + 0); GDN_WAITL(4); GDN_SBAR(); av[1] = __builtin_amdgcn_mfma_f32_32x32x16_bf16(f3, Sb[3][0], av[1], 0, 0, 0);
            GDN_RDA(f3, a4_1, OFF_AQK + 0); GDN_WAITL(4); GDN_SBAR(); ao[1] = __builtin_amdgcn_mfma_f32_32x32x16_bf16(f4, Sb[3][0], ao[1], 0, 0, 0);
            GDN_RDA(f4, a4_0, OFF_AQK + 4096); GDN_WAITL(4); GDN_SBAR(); av[1] = __builtin_amdgcn_mfma_f32_32x32x16_bf16(f0, Sb[3][1], av[1], 0, 0, 0);
            GDN_RDA(f0, a4_1, OFF_AQK + 4096); GDN_WAITL(4); GDN_SBAR(); ao[1] = __builtin_amdgcn_mfma_f32_32x32x16_bf16(f1, Sb[3][1], ao[1], 0, 0, 0);
            Vb[0][0] = pack8(av[0], 0); Vb[0][1] = pack8(av[0], 1); Vb[1][0] = pack8(av[1], 0); Vb[1][1] = pack8(av[1], 1);
            GDN_RDA(f1, a4_2, OFF_AQK + 4096); GDN_WAITL(4); GDN_SBAR(); ao[0] = __builtin_amdgcn_mfma_f32_32x32x16_bf16(f2, Vb[0][0], ao[0], 0, 0, 0);
            GDN_RDA(f2, a4_3, OFF_AQK + 4096); GDN_WAITL(4); GDN_SBAR(); ao[0] = __builtin_amdgcn_mfma_f32_32x32x16_bf16(f3, Vb[0][1], ao[0], 0, 0, 0);
            GDN_RDA(f3, a4_0, OFF_KDT + 0); GDN_WAITL(4); GDN_SBAR(); ao[1] = __builtin_amdgcn_mfma_f32_32x32x16_bf16(f4, Vb[0][0], ao[1], 0, 0, 0);
            GDN_RDA(f4, a4_1, OFF_KDT + 0); GDN_WAITL(4); GDN_SBAR(); ao[1] = __builtin_amdgcn_mfma_f32_32x32x16_bf16(f0, Vb[0][1], ao[1], 0, 0, 0);
            GDN_RDA(f0, a4_2, OFF_KDT + 0); GDN_WAITL(4); GDN_SBAR(); ao[1] = __builtin_amdgcn_mfma_f32_32x32x16_bf16(f1, Vb[1][0], ao[1], 0, 0, 0);
            GDN_RDA(f1, a4_3, OFF_KDT + 0); GDN_WAITL(4); GDN_SBAR(); ao[1] = __builtin_amdgcn_mfma_f32_32x32x16_bf16(f2, Vb[1][1], ao[1], 0, 0, 0);
            { bf16_t* op = OB + ((size_t)b * SEQ + 64 * n) * DM + h * 128 + 32 * wave + r32;
#pragma unroll
              for (int mt = 0; mt < 2; ++mt)
#pragma unroll
                  for (int r = 0; r < 16; ++r) *(GAS bf16_t*)(op + (size_t)(32 * mt + crow(r, hi)) * DM) = (bf16_t)pk2h(ao[mt][r], 0.f); }
            S[0] = S[0] * gl; S[1] = S[1] * gl; S[2] = S[2] * gl; S[3] = S[3] * gl;
            GDN_RDA(f2, a4_0, OFF_KDT + 4096); GDN_WAITL(4); GDN_SBAR(); S[0] = __builtin_amdgcn_mfma_f32_32x32x16_bf16(f3, Vb[0][0], S[0], 0, 0, 0);
            GDN_RDA(f3, a4_1, OFF_KDT + 4096); GDN_WAITL(4); GDN_SBAR(); S[0] = __builtin_amdgcn_mfma_f32_32x32x16_bf16(f4, Vb[0][1], S[0], 0, 0, 0);
            GDN_RDA(f4, a4_2, OFF_KDT + 4096); GDN_WAITL(4); GDN_SBAR(); S[0] = __builtin_amdgcn_mfma_f32_32x32x16_bf16(f0, Vb[1][0], S[0], 0, 0, 0);
            GDN_RDA(f0, a4_3, OFF_KDT + 4096); GDN_WAITL(4); GDN_SBAR(); S[0] = __builtin_amdgcn_mfma_f32_32x32x16_bf16(f1, Vb[1][1], S[0], 0, 0, 0);
            GDN_RDA(f1, a4_0, OFF_KDT + 8192); GDN_WAITL(4); GDN_SBAR(); S[1] = __builtin_amdgcn_mfma_f32_32x32x16_bf16(f2, Vb[0][0], S[1], 0, 0, 0);
            GDN_RDA(f2, a4_1, OFF_KDT + 8192); GDN_WAITL(4); GDN_SBAR(); S[1] = __builtin_amdgcn_mfma_f32_32x32x16_bf16(f3, Vb[0][1], S[1], 0, 0, 0);
            GDN_RDA(f3, a4_2, OFF_KDT + 8192); GDN_WAITL(4); GDN_SBAR(); S[1] = __builtin_amdgcn_mfma_f32_32x32x16_bf16(f4, Vb[1][0], S[1], 0, 0, 0);
            GDN_RDA(f4, a4_3, OFF_KDT + 8192); GDN_WAITL(4); GDN_SBAR(); S[1] = __builtin_amdgcn_mfma_f32_32x32x16_bf16(f0, Vb[1][1], S[1], 0, 0, 0);
            GDN_RDA(f0, a4_0, OFF_KDT + 12288); GDN_WAITL(4); GDN_SBAR(); S[2] = __builtin_amdgcn_mfma_f32_32x32x16_bf16(f1, Vb[0][0], S[2], 0, 0, 0);
            GDN_RDA(f1, a4_1, OFF_KDT + 12288); GDN_WAITL(4); GDN_SBAR(); S[2] = __builtin_amdgcn_mfma_f32_32x32x16_bf16(f2, Vb[0][1], S[2], 0, 0, 0);
            GDN_RDA(f2, a4_2, OFF_KDT + 12288); GDN_WAITL(4); GDN_SBAR(); S[2] = __builtin_amdgcn_mfma_f32_32x32x16_bf16(f3, Vb[1][0], S[2], 0, 0, 0);
            GDN_RDA(f3, a4_3, OFF_KDT + 12288); GDN_WAITL(4); GDN_SBAR(); S[2] = __builtin_amdgcn_mfma_f32_32x32x16_bf16(f4, Vb[1][1], S[2], 0, 0, 0);
            GDN_WAITL(3); GDN_SBAR(); S[3] = __builtin_amdgcn_mfma_f32_32x32x16_bf16(f0, Vb[0][0], S[3], 0, 0, 0);
            GDN_WAITL(2); GDN_SBAR(); S[3] = __builtin_amdgcn_mfma_f32_32x32x16_bf16(f1, Vb[0][1], S[3], 0, 0, 0);
            GDN_WAITL(1); GDN_SBAR(); S[3] = __builtin_amdgcn_mfma_f32_32x32x16_bf16(f2, Vb[1][0], S[3], 0, 0, 0);
            GDN_WAITL(0); GDN_SBAR(); S[3] = __builtin_amdgcn_mfma_f32_32x32x16_bf16(f3, Vb[1][1], S[3], 0, 0, 0);
#undef GDN_RDA
        }
        asm volatile("s_waitcnt vmcnt(0) lgkmcnt(0)\n\ts_barrier" ::: "memory");
    }
#undef GDN_DMA
}
}

constexpr int NWAVES = 8;
constexpr int RING_OFF = 0, RING_BYTES = 152576;
constexpr int LDSCTL_OFF = RING_BYTES, MISC_OFF = LDSCTL_OFF + 320;
constexpr int LDS_BYTES = 153600;
constexpr int NPHASE = 11;

#define FTID (tid_now((const void*)(uintptr_t)(unsigned)(uintptr_t)F.lds))
struct Frame {
    LAS unsigned char* lds;
    volatile LAS unsigned* MISC;
    gu32* ctl;
    int vcu, G;
    unsigned char* ws; float* out;
};
typedef unsigned v2u __attribute__((ext_vector_type(2)));

template <class ColMap>
__device__ __forceinline__ void transpose_item(const float* W, int ldw, bf16* WT, int dst_row0, int k0, const ColMap& cm, LAS float* scr, int lane) {
    const int n4 = (lane & 7) * 4, kr = lane >> 3; const int sc = cm(dst_row0 + n4);
    f32x4 v[8];
#pragma unroll
    for (int i = 0; i < 8; ++i) v[i] = *(const GAS f32x4*)(W + (size_t)(k0 + kr + 8 * i) * ldw + sc);
#pragma unroll
    for (int i = 0; i < 8; ++i) { const int kk = kr + 8 * i; scr[(n4 + 0) * 65 + kk] = v[i].x; scr[(n4 + 1) * 65 + kk] = v[i].y; scr[(n4 + 2) * 65 + kk] = v[i].z; scr[(n4 + 3) * 65 + kk] = v[i].w; }
    LDS_WAIT(); asm volatile("" ::: "memory");
    const int c = lane & 7;
#pragma unroll
    for (int j = 0; j < 4; ++j) { const int nn = (lane >> 3) + 8 * j; const LAS float* s = scr + nn * 65 + 8 * c;
        v4u o; o.x = pk2(s[0], s[1]); o.y = pk2(s[2], s[3]); o.z = pk2(s[4], s[5]); o.w = pk2(s[6], s[7]);
        *(GAS v4u*)(WT + (size_t)(dst_row0 + nn) * DM + k0 + 8 * c) = o; }
    LDS_WAIT(); asm volatile("" ::: "memory");
}
struct CmIdent { __device__ __forceinline__ int operator()(int r) const { return r; } };
struct CmWin {
    __device__ __forceinline__ int operator()(int R) const {
        const int pn = R >> 8, tc = R & 255;
        if (pn < 8) { const int bj = tc >> 7, wc = (tc >> 5) & 3, fq = (tc >> 3) & 3, n = (tc >> 2) & 1, e = tc & 3; return 256 * pn + 64 * (2 * bj + (wc >> 1)) + 32 * n + 16 * (wc & 1) + 4 * fq + e; }
        return (R < 7168) ? R : R + 16;
    }
};
struct CmOff { int off; __device__ __forceinline__ int operator()(int r) const { return r + off; } };

__device__ __forceinline__ void p0_prologue(Frame& F, const float* x, const float* mix_g, const float* w_in, const float* w_out, const float* a_log, const float* dt_bias) {
    int tid_ = FTID; asm volatile("" : "+v"(tid_)); const int lane_ = tid_ & 63; const int wave_ = __builtin_amdgcn_readfirstlane(tid_ >> 6); (void)lane_; (void)wave_;
    LAS float* scr = (LAS float*)(F.lds + RING_OFF + wave_ * 16384);
    const int gw = F.vcu * NWAVES + wave_, NGW = F.G * NWAVES;
    bf16* Win_t = (bf16*)((unsigned char*)F.out + 32 * MiB); bf16* Wout_t = (bf16*)(F.ws + WS_WOUT); bf16* XN = (bf16*)F.out;
    constexpr int I_IN = (9216 / 32) * 16, I_OUT = (1024 / 32) * 16;
    for (int it = gw; it < I_IN + I_OUT; it += NGW) {
        if (it < I_IN) transpose_item(w_in, IN_DIM, Win_t, 32 * (it >> 4), 64 * (it & 15), CmWin(), scr, lane_);
        else { const int r = it - I_IN; transpose_item(w_out, DM, Wout_t, 32 * (r >> 4), 64 * (r & 15), CmIdent(), scr, lane_); }
    }
    float* rope = (float*)(F.ws + WS_ROPE);
    for (int idx = (F.vcu * NWAVES + wave_) * 64 + lane_; idx < SEQ * 32; idx += NGW * 64) { const int pos = idx >> 5, i = idx & 31;
        const float inv_freq = 1.0f / powf(10000.0f, (float)(2 * i) / 64.0f); const float ang = (float)pos * inv_freq; rope[idx] = cosf(ang); rope[SEQ * 32 + idx] = sinf(ang); }
    __syncthreads();
    LAS float* w16 = (LAS float*)(F.lds + RING_OFF);
    { f32x4 t[8];
#pragma unroll
      for (int i = 0; i < 8; ++i) { const int i4 = tid_ + 512 * i; t[i] = *(const GAS f32x4*)(w_in + (size_t)(i4 >> 2) * IN_DIM + 7168 + (i4 & 3) * 4); }
#pragma unroll
      for (int i = 0; i < 8; ++i) { const int i4 = tid_ + 512 * i; const int k = i4 >> 2, e0 = (i4 & 3) * 4;
          w16[(e0 + 0) * 1028 + k] = t[i].x; w16[(e0 + 1) * 1028 + k] = t[i].y; w16[(e0 + 2) * 1028 + k] = t[i].z; w16[(e0 + 3) * 1028 + k] = t[i].w; } }
    __syncthreads();
    float* bg = (float*)(F.ws + WS_BG);
    const int me = (lane_ >> 2) & 15;
    const float mydt = dt_bias[me & 7], myal = a_log[me & 7];
    f32x4 vnext[4];
    if (gw < T_) { const GAS f32x4* x0 = (const GAS f32x4*)(x + (size_t)gw * DM) + lane_;
#pragma unroll
        for (int j = 0; j < 4; ++j) vnext[j] = x0[64 * j]; }
#pragma unroll 1
    for (int m = gw; m < T_; m += NGW) {
        f32x4 v[4]; float s = 0.f;
#pragma unroll
        for (int j = 0; j < 4; ++j) v[j] = vnext[j];
        { const int mn = (m + NGW < T_) ? m + NGW : m; const GAS f32x4* xn = (const GAS f32x4*)(x + (size_t)mn * DM) + lane_;
#pragma unroll
          for (int j = 0; j < 4; ++j) vnext[j] = xn[64 * j]; }
#pragma unroll
        for (int j = 0; j < 4; ++j) s += (v[j].x * v[j].x + v[j].y * v[j].y) + (v[j].z * v[j].z + v[j].w * v[j].w);
        s = wave_sum(s);
        const float rstd = 1.0f / sqrtf(s * (1.0f / DM) + NORM_EPS);
        GAS unsigned long long* o8 = (GAS unsigned long long*)(XN + (size_t)m * DM) + lane_;
#pragma unroll
        for (int j = 0; j < 4; ++j) { const f32x4 gg = ((const GAS f32x4*)mix_g)[lane_ + 64 * j]; v[j] = v[j] * rstd * gg;
            o8[64 * j] = (unsigned long long)pk2(v[j].x, v[j].y) | ((unsigned long long)pk2(v[j].z, v[j].w) << 32); }
        float a16[16];
#pragma unroll
        for (int e = 0; e < 16; ++e) { f32x2 a2 = {0.f, 0.f};
#pragma unroll
            for (int j = 0; j < 4; ++j) { const f32x4 w4 = *(const LAS f32x4*)(w16 + e * 1028 + 4 * (lane_ + 64 * j)); a2 += (f32x2){v[j].x, v[j].y} * (f32x2){w4.x, w4.y}; a2 += (f32x2){v[j].z, v[j].w} * (f32x2){w4.z, w4.w}; }
            a16[e] = a2.x + a2.y; if ((e & 3) == 3) __builtin_amdgcn_sched_barrier(0); }
        float r8[8], r4[4], r2[2];
        { const bool up = (lane_ & 32) != 0;
#pragma unroll
          for (int e = 0; e < 8; ++e) { const float send = up ? a16[e] : a16[e + 8], keep = up ? a16[e + 8] : a16[e]; r8[e] = keep + __shfl_xor(send, 32); } }
        { const bool up = (lane_ & 16) != 0;
#pragma unroll
          for (int e = 0; e < 4; ++e) { const float send = up ? r8[e] : r8[e + 4], keep = up ? r8[e + 4] : r8[e]; r4[e] = keep + __shfl_xor(send, 16); } }
        { const bool up = (lane_ & 8) != 0;
#pragma unroll
          for (int e = 0; e < 2; ++e) { const float send = up ? r4[e] : r4[e + 2], keep = up ? r4[e + 2] : r4[e]; r2[e] = keep + __shfl_xor(send, 8); } }
        float val; { const bool up = (lane_ & 4) != 0; const float send = up ? r2[0] : r2[1], keep = up ? r2[1] : r2[0]; val = keep + __shfl_xor(send, 4); }
        val += __shfl_xor(val, 2); val += __shfl_xor(val, 1);
        float res;
        if (me < 8) res = 1.0f / (1.0f + expf(-val));
        else { const float z = val + mydt; const float sp = (z > 20.f) ? z : log1pf(expf(z)); res = -expf(myal) * sp; }
        if ((lane_ & 3) == 0) bg[(size_t)m * 16 + me] = res;
    }
    __syncthreads();
}

__device__ __forceinline__ int dequeue(Frame& F, int qword) {
    if (FTID == 0) F.MISC[16] = __hip_atomic_fetch_add(F.ctl + qword, 1u, __ATOMIC_RELAXED, __HIP_MEMORY_SCOPE_AGENT);
    __syncthreads();
    const int idx = __builtin_amdgcn_readfirstlane((int)F.MISC[16]);
    __syncthreads();
    return idx;
}
__device__ __forceinline__ void p2_scans(Frame& F, unsigned char* lds_generic, int qbase) {
    bf16* OB = (bf16*)(F.ws + WS_SLAB) + 3 * (SLAB / 2);
    const int x = (int)(xb_xcc_id() & 7u);
    for (int qi = 0; qi < 8; ++qi) {
        const int q = (x + qi) & 7;
        for (;;) { const int idx = dequeue(F, qbase + 64 * (8 + q)); if (idx >= 2) break; gdn::scan(lds_generic + RING_OFF, FTID, 2 * q + idx, F.ws + WS_R2, OB); }
    }
}
__device__ __forceinline__ void p2_attention(Frame& F, unsigned char* lds_generic, int qbase) {
    const bf16* QA = (const bf16*)(F.ws + WS_SLAB); const bf16* KA = QA + (SLAB / 2); const bf16* VA = KA + (SLAB / 2);
    bf16* O1 = (bf16*)F.out;
    const int x = (int)(xb_xcc_id() & 7u);
    for (int qi = 0; qi < 8; ++qi) {
        const int q = (x + qi) & 7;
        for (;;) {
            const int u = dequeue(F, qbase + 64 * q);
            if (u >= 128) break;
            const int bh = 2 * q + (u >> 6), rem = u & 63; const int qb = 31 - (rem >> 1), c = rem & 1; const int b = bh >> 3, h = bh & 7;
            attn128::unit6<8>(b, 2 * h + c, 2 * h, qb, (const attn_body::bf16*)QA, (const attn_body::bf16*)KA, (const attn_body::bf16*)VA, (attn_body::bf16*)(O1 + (size_t)c * T_ * DM), (char*)lds_generic + RING_OFF);
        }
    }
}

__device__ __forceinline__ void p2b_merge(Frame& F, const float* lq1, const float* lk1, const float* lq2, const float* lk2, const float* subln_g, const float* gdn_g) {
    int tid_ = FTID; asm volatile("" : "+v"(tid_)); const int lane_ = tid_ & 63; const int wave_ = __builtin_amdgcn_readfirstlane(tid_ >> 6); (void)lane_; (void)wave_;
    const bf16* O1 = (const bf16*)F.out; const bf16* O2 = O1 + (size_t)T_ * DM;
    bf16* slab = (bf16*)(F.ws + WS_SLAB); bf16* MG = slab; const bf16* OB = slab + 3 * (SLAB / 2); const bf16* GZ = slab + 6 * (SLAB / 2); const bf16* GA = slab + 7 * (SLAB / 2); const bf16* GB = slab + 8 * (SLAB / 2);
    const int gw = F.vcu * NWAVES + wave_, NGW = F.G * NWAVES, lane = lane_;
    const float lam = expf(wave_sum(lq1[lane] * lk1[lane])) - expf(wave_sum(lq2[lane] * lk2[lane])) + 0.2f;
    const float sg0 = subln_g[2 * lane] * 0.8f, sg1 = subln_g[2 * lane + 1] * 0.8f, gg0 = gdn_g[2 * lane], gg1 = gdn_g[2 * lane + 1];
#pragma unroll 1
    for (int row = gw; row < T_; row += NGW) {
        unsigned u1[8], u2[8], ub[8], uz[8], ua[8], ugb[8];
#pragma unroll
        for (int h = 0; h < 8; ++h) { const size_t off = (size_t)row * DM + h * 128 + 2 * lane;
            u1[h] = *(const GAS unsigned*)(O1 + off); u2[h] = *(const GAS unsigned*)(O2 + off); ub[h] = *(const GAS unsigned*)(OB + off); uz[h] = *(const GAS unsigned*)(GZ + off); ua[h] = *(const GAS unsigned*)(GA + off); ugb[h] = *(const GAS unsigned*)(GB + off); }
#pragma unroll
        for (int h = 0; h < 8; ++h) { const size_t off = (size_t)row * DM + h * 128 + 2 * lane;
            const float d0 = __uint_as_float(u1[h] << 16) - lam * __uint_as_float(u2[h] << 16), d1 = __uint_as_float(u1[h] & 0xffff0000u) - lam * __uint_as_float(u2[h] & 0xffff0000u);
            const float ra = __builtin_amdgcn_rsqf(wave_sum(d0 * d0 + d1 * d1) * (1.0f / 128.0f) + NORM_EPS);
            const float ya0 = d0 * ra * sg0, ya1 = d1 * ra * sg1;
            const float b0 = __uint_as_float(ub[h] << 16), b1 = __uint_as_float(ub[h] & 0xffff0000u);
            const float rb = __builtin_amdgcn_rsqf(wave_sum(b0 * b0 + b1 * b1) * (1.0f / 128.0f) + NORM_EPS);
            const float z0 = __uint_as_float(uz[h] << 16), z1 = __uint_as_float(uz[h] & 0xffff0000u);
            const float yb0 = b0 * rb * gg0 * (z0 * sigmoidf_(z0)), yb1 = b1 * rb * gg1 * (z1 * sigmoidf_(z1));
            const float m0 = sigmoidf_(__uint_as_float(ua[h] << 16)) * ya0 + sigmoidf_(__uint_as_float(ugb[h] << 16)) * yb0;
            const float m1 = sigmoidf_(__uint_as_float(ua[h] & 0xffff0000u)) * ya1 + sigmoidf_(__uint_as_float(ugb[h] & 0xffff0000u)) * yb1;
            *(GAS unsigned*)(MG + off) = pk2(m0, m1); }
    }
}

__device__ __forceinline__ void p3b_router(Frame& F, const float* g2, const float* rw, const float* rb, bool lists) {
    int tid_ = FTID; asm volatile("" : "+v"(tid_)); const int lane = tid_ & 63; const int wave_ = __builtin_amdgcn_readfirstlane(tid_ >> 6);
    const float* x1 = F.out; bf16* H2 = (bf16*)(F.ws + WS_H2); int* tope = (int*)(F.ws + WS_TOPE); float* topw = (float*)(F.ws + WS_TOPW); int* cnt = (int*)(F.ws + WS_CTL) + CW_CNT; int* list = (int*)(F.ws + WS_LIST);
    LAS float* rwT = (LAS float*)(F.lds + RING_OFF);
    {
        const GAS f32x4* rw4 = (const GAS f32x4*)rw;
#pragma unroll 1
        for (int b0 = 0; b0 < 16; b0 += 8) { f32x4 t[8];
#pragma unroll
            for (int i = 0; i < 8; ++i) t[i] = rw4[tid_ + 512 * (b0 + i)];
#pragma unroll
            for (int i = 0; i < 8; ++i) { const int i4 = tid_ + 512 * (b0 + i); const int k = i4 >> 3, e0 = (i4 & 7) * 4;
                rwT[(e0 + 0) * 1028 + k] = t[i].x; rwT[(e0 + 1) * 1028 + k] = t[i].y; rwT[(e0 + 2) * 1028 + k] = t[i].z; rwT[(e0 + 3) * 1028 + k] = t[i].w; } } }
    __syncthreads();
    const int gw = F.vcu * NWAVES + wave_, NGW = F.G * NWAVES;
    const float myb = rb[(lane >> 1) & 31];
    LAS int* lcnt = (LAS int*)(F.lds + RING_OFF + 131584); LAS int* gbase = lcnt + 32; LAS int* rec = lcnt + 64;
    for (int rowb = gw; rowb < T_; rowb += 8 * NGW) {
        if (tid_ < 32) lcnt[tid_] = 0;
        __syncthreads();
        f32x4 vnA[4], vnB[4];
        { const GAS f32x4* x0 = (const GAS f32x4*)(x1 + (size_t)rowb * DM); const int rb1 = (rowb + NGW < T_) ? rowb + NGW : rowb; const GAS f32x4* x1p = (const GAS f32x4*)(x1 + (size_t)rb1 * DM);
#pragma unroll
          for (int j = 0; j < 4; ++j) { vnA[j] = x0[lane + 64 * j]; vnB[j] = x1p[lane + 64 * j]; } }
#pragma unroll 1
        for (int it = 0; it < 8; it += 2) { const int rowA = rowb + it * NGW; if (rowA >= T_) break;
        const bool hasB = rowA + NGW < T_; const int rowB = hasB ? rowA + NGW : rowA;
        f32x4 vA[4], vB[4]; float sA = 0.f, sB = 0.f;
#pragma unroll
        for (int j = 0; j < 4; ++j) { vA[j] = vnA[j]; vB[j] = vnB[j]; }
        { int ra = rowA + 2 * NGW, rb_ = rowA + 3 * NGW; if (!(ra < T_ && it + 2 < 8)) ra = rowA; if (!(rb_ < T_ && it + 2 < 8)) rb_ = ra;
          const GAS f32x4* xa = (const GAS f32x4*)(x1 + (size_t)ra * DM); const GAS f32x4* xb = (const GAS f32x4*)(x1 + (size_t)rb_ * DM);
#pragma unroll
          for (int j = 0; j < 4; ++j) { vnA[j] = xa[lane + 64 * j]; vnB[j] = xb[lane + 64 * j]; } }
#pragma unroll
        for (int j = 0; j < 4; ++j) { sA += (vA[j].x * vA[j].x + vA[j].y * vA[j].y) + (vA[j].z * vA[j].z + vA[j].w * vA[j].w); sB += (vB[j].x * vB[j].x + vB[j].y * vB[j].y) + (vB[j].z * vB[j].z + vB[j].w * vB[j].w); }
        sA = wave_sum(sA); sB = wave_sum(sB);
        const float rA = 1.0f / sqrtf(sA * (1.0f / DM) + NORM_EPS), rB = 1.0f / sqrtf(sB * (1.0f / DM) + NORM_EPS);
#pragma unroll
        for (int j = 0; j < 4; ++j) { const f32x4 gg = ((const GAS f32x4*)g2)[lane + 64 * j]; vA[j] = vA[j] * rA * gg; vB[j] = vB[j] * rB * gg;
            *(GAS unsigned long long*)(H2 + (size_t)rowA * DM + 4 * (lane + 64 * j)) = (unsigned long long)pk2(vA[j].x, vA[j].y) | ((unsigned long long)pk2(vA[j].z, vA[j].w) << 32);
            if (hasB) *(GAS unsigned long long*)(H2 + (size_t)rowB * DM + 4 * (lane + 64 * j)) = (unsigned long long)pk2(vB[j].x, vB[j].y) | ((unsigned long long)pk2(vB[j].z, vB[j].w) << 32); }
        float lgA[32], lgB[32];
#pragma unroll
        for (int e = 0; e < 32; ++e) { f32x2 a2 = {0.f, 0.f}, b2 = {0.f, 0.f};
#pragma unroll
            for (int j = 0; j < 4; ++j) { const f32x4 w4 = *(const LAS f32x4*)(rwT + e * 1028 + 4 * (lane + 64 * j)); const f32x2 wl = {w4.x, w4.y}, wh = {w4.z, w4.w};
                a2 += (f32x2){vA[j].x, vA[j].y} * wl; a2 += (f32x2){vA[j].z, vA[j].w} * wh; b2 += (f32x2){vB[j].x, vB[j].y} * wl; b2 += (f32x2){vB[j].z, vB[j].w} * wh; }
            lgA[e] = a2.x + a2.y; lgB[e] = b2.x + b2.y; if ((e & 3) == 3) __builtin_amdgcn_sched_barrier(0); }
        float r32_[32], r16[16], r8[8], r4[4], r2[2];
        { const bool odd = (lane & 1) != 0;
#pragma unroll
          for (int e = 0; e < 32; ++e) { const float send = odd ? lgA[e] : lgB[e], keep = odd ? lgB[e] : lgA[e]; r32_[e] = keep + __shfl_xor(send, 1); } }
        { const bool up = (lane & 32) != 0;
#pragma unroll
          for (int e = 0; e < 16; ++e) { const float send = up ? r32_[e] : r32_[e + 16], keep = up ? r32_[e + 16] : r32_[e]; r16[e] = keep + __shfl_xor(send, 32); } }
        { const bool up = (lane & 16) != 0;
#pragma unroll
          for (int e = 0; e < 8; ++e) { const float send = up ? r16[e] : r16[e + 8], keep = up ? r16[e + 8] : r16[e]; r8[e] = keep + __shfl_xor(send, 16); } }
        { const bool up = (lane & 8) != 0;
#pragma unroll
          for (int e = 0; e < 4; ++e) { const float send = up ? r8[e] : r8[e + 4], keep = up ? r8[e + 4] : r8[e]; r4[e] = keep + __shfl_xor(send, 8); } }
        { const bool up = (lane & 4) != 0;
#pragma unroll
          for (int e = 0; e < 2; ++e) { const float send = up ? r4[e] : r4[e + 2], keep = up ? r4[e + 2] : r4[e]; r2[e] = keep + __shfl_xor(send, 4); } }
        float val; { const bool up = (lane & 2) != 0; const float send = up ? r2[0] : r2[1], keep = up ? r2[1] : r2[0]; val = keep + __shfl_xor(send, 2); }
        val += myb;
        const unsigned long long par = (lane & 1) ? 0xAAAAAAAAAAAAAAAAull : 0x5555555555555555ull;
        int sel[4]; float sv[4];
#pragma unroll
        for (int k = 0; k < 4; ++k) { float m = val;
#pragma unroll
            for (int o = 2; o < 64; o <<= 1) m = fmaxf(m, __shfl_xor(m, o));
            const unsigned long long mk = __ballot(val == m) & par; const int e = (int)(__builtin_ctzll(mk) >> 1); sel[k] = e; sv[k] = m; if (((lane >> 1) & 31) == e) val = -INFINITY; }
        const float e0 = 1.0f, e1 = expf(sv[1] - sv[0]), e2 = expf(sv[2] - sv[0]), e3 = expf(sv[3] - sv[0]); const float inv = 1.0f / (e0 + e1 + e2 + e3);
        if (lane < 8 && (hasB || !(lane & 1))) { const int k = lane >> 1; const int row = (lane & 1) ? rowB : rowA; const int ex = (k == 0) ? sel[0] : (k == 1) ? sel[1] : (k == 2) ? sel[2] : sel[3]; const float wv = ((k == 0) ? e0 : (k == 1) ? e1 : (k == 2) ? e2 : e3) * inv;
            tope[row * 4 + k] = ex; topw[row * 4 + k] = wv;
            if (lists) { const int lp = atomicAdd((int*)(lcnt + ex), 1); rec[(wave_ * 8 + it + (lane & 1)) * 4 + k] = ex | (lp << 8); } }
        }
        __syncthreads();
        if (lists) {
            if (tid_ < 32) { const int c = lcnt[tid_]; gbase[tid_] = c ? atomicAdd(cnt + 64 * tid_, c) : 0; }
            __syncthreads();
            if (lane < 32) { const int it = lane >> 2, k = lane & 3; const int row = rowb + it * NGW;
                if (row < T_) { const int rc = rec[(wave_ * 8 + it) * 4 + k]; const int ex = rc & 255, lp = rc >> 8; list[ex * 16384 + gbase[ex] + lp] = row * 4 + k; } }
            __syncthreads();
        }
    }
    __syncthreads();
}

constexpr size_t WS_W1T = WS_R2, WS_W2T = WS_R2 + 128 * MiB;
__device__ __forceinline__ void p_expert_weights(Frame& F, const float* wg, const float* wu, const float* wd) {
    int tid_ = FTID; asm volatile("" : "+v"(tid_)); const int lane_ = tid_ & 63; const int wave_ = __builtin_amdgcn_readfirstlane(tid_ >> 6); (void)lane_; (void)wave_;
    LAS float* scr = (LAS float*)(F.lds + RING_OFF + wave_ * 16384);
    const int gw = F.vcu * NWAVES + wave_, NGW = F.G * NWAVES;
    bf16* W1t = (bf16*)(F.ws + WS_W1T); bf16* W2t = (bf16*)(F.ws + WS_W2T);
    (void)gw; (void)NGW;
    for (;;) {
        int ck = 0; if (lane_ == 0) ck = (int)__hip_atomic_fetch_add(F.ctl + CW_Q + 64 * 40, 1u, __ATOMIC_RELAXED, __HIP_MEMORY_SCOPE_AGENT);
        ck = __builtin_amdgcn_readfirstlane(ck);
        if (ck >= NEXP * 1536 / 16) break;
#pragma unroll 1
      for (int ki = 0; ki < 16; ++ki) { const int it = ck * 16 + ki;
        const int e = it / 1536, r = it % 1536;
        if (r < 1024) { const int rbk = r >> 4, kb = r & 15; const int pn = rbk >> 3, tcb = rbk & 7; const int srccol0 = 128 * pn + 32 * (tcb & 3);
            const float* W = ((tcb >> 2) ? wu : wg) + (size_t)e * DM * DM;
            transpose_item(W, DM, W1t + (size_t)e * 2048 * DM, 32 * rbk, 64 * kb, CmOff{srccol0 - 32 * rbk}, scr, lane_); }
        else { const int r2 = r - 1024; transpose_item(wd + (size_t)e * DM * DM, DM, W2t + (size_t)e * DM * DM, 32 * (r2 >> 4), 64 * (r2 & 15), CmIdent(), scr, lane_); }
      }
    }
}
constexpr size_t TBL_NMT = WS_SLOT, TBL_TILEE = WS_SLOT + 1024, TBL_SLOTOF = WS_SLOT + 64 * 1024, TBL_WSLOT = WS_SLOT + 320 * 1024;
constexpr int MOE_LDS_TILEE = 131072, MOE_LDS_START = 131072 + 2048, MOE_LDS_CNT = 131072 + 2048 + 128;
__device__ __forceinline__ int p3c_gather(Frame& F) {
    int tid_ = FTID; asm volatile("" : "+v"(tid_)); const int lane_ = tid_ & 63; const int wave_ = __builtin_amdgcn_readfirstlane(tid_ >> 6); (void)lane_; (void)wave_;
    const int* cnt = (const int*)(F.ws + WS_CTL) + CW_CNT; const int* list = (const int*)(F.ws + WS_LIST); const float* topw = (const float*)(F.ws + WS_TOPW);
    int* nmt = (int*)(F.ws + TBL_NMT); int* tile_e = (int*)(F.ws + TBL_TILEE); int* slot_of = (int*)(F.ws + TBL_SLOTOF); float* wslot = (float*)(F.ws + TBL_WSLOT);
    const int lane = lane_, gw = F.vcu * NWAVES + wave_, NGW = F.G * NWAVES;
    const int c = (lane < 32) ? __hip_atomic_load(cnt + 64 * lane, __ATOMIC_RELAXED, __HIP_MEMORY_SCOPE_AGENT) : 0;
    const int pc = ((c + 255) >> 8) << 8;
    int incl = pc;
#pragma unroll
    for (int o = 1; o < 32; o <<= 1) { const int t = __shfl_up(incl, o); if (lane >= o) incl += t; }
    const int start = incl - pc; const int total = __shfl(incl, 31);
    if (wave_ == 0 && lane < 32) { LAS int* lt = (LAS int*)(F.lds + RING_OFF + MOE_LDS_TILEE); for (int t = start >> 8; t < (start + pc) >> 8; ++t) lt[t] = lane;
        ((LAS int*)(F.lds + RING_OFF + MOE_LDS_START))[lane] = start; ((LAS int*)(F.lds + RING_OFF + MOE_LDS_CNT))[lane] = c; }
    if (gw == 0) { if (lane == 0) nmt[0] = total >> 8; if (lane < 32) for (int t = start >> 8; t < (start + pc) >> 8; ++t) tile_e[t] = lane; }
    for (int g0 = gw * 64; g0 < total; g0 += NGW * 64) {
        const unsigned long long mk = __ballot(lane < 32 && g0 >= start && g0 < start + pc);
        const int e = __builtin_ctzll(mk); const int g = g0 + lane; const int pos = g - __shfl(start, e); const int ce = __shfl(c, e);
        float w = 0.f;
        if (pos < ce) { const int aid = __hip_atomic_load(list + e * 16384 + pos, __ATOMIC_RELAXED, __HIP_MEMORY_SCOPE_AGENT);
            slot_of[aid] = g; w = __hip_atomic_load(topw + aid, __ATOMIC_RELAXED, __HIP_MEMORY_SCOPE_AGENT); }
        wslot[g] = w;
    }
    __syncthreads();
    return __builtin_amdgcn_readfirstlane(total >> 8);
}

__device__ __forceinline__ void p6_final(Frame& F, const bf16* y, const int* slot_of, const float* g, float* dst) {
    int tid_ = FTID; asm volatile("" : "+v"(tid_)); const int lane_ = tid_ & 63; const int wave_ = __builtin_amdgcn_readfirstlane(tid_ >> 6); (void)lane_; (void)wave_;
    const int gw = F.vcu * NWAVES + wave_, NGW = F.G * NWAVES, lane = lane_;
    for (int row = gw; row < T_; row += NGW) {
        GAS f32x4* xr = (GAS f32x4*)(F.out + (size_t)row * DM);
        int sl[4];
#pragma unroll
        for (int k = 0; k < 4; ++k) sl[k] = slot_of ? __hip_atomic_load(slot_of + row * 4 + k, __ATOMIC_RELAXED, __HIP_MEMORY_SCOPE_AGENT) : row * 4 + k;
        f32x4 v[4]; float s = 0.f;
#pragma unroll
        for (int j = 0; j < 4; ++j) { v[j] = xr[lane + 64 * j];
#pragma unroll
            for (int k = 0; k < 4; ++k) { const v2u u = *(const GAS v2u*)(y + (size_t)sl[k] * DM + 4 * (lane + 64 * j));
                v[j].x += __uint_as_float(u.x << 16); v[j].y += __uint_as_float(u.x & 0xffff0000u); v[j].z += __uint_as_float(u.y << 16); v[j].w += __uint_as_float(u.y & 0xffff0000u); }
            s += (v[j].x * v[j].x + v[j].y * v[j].y) + (v[j].z * v[j].z + v[j].w * v[j].w); }
        s = wave_sum(s);
        const float r = 1.0f / sqrtf(s * (1.0f / DM) + NORM_EPS);
        GAS f32x4* dr = (GAS f32x4*)(dst + (size_t)row * DM);
#pragma unroll
        for (int j = 0; j < 4; ++j) { const f32x4 gg = ((const GAS f32x4*)g)[lane + 64 * j]; dr[lane + 64 * j] = v[j] * r * gg; }
    }
}

__device__ __forceinline__ const float* argp(int i) { const unsigned char* kp = (const unsigned char*)__builtin_amdgcn_kernarg_segment_ptr(); asm volatile("" : "+s"(kp)); return *(const float* const*)(kp + 8 * i); }
struct Args { const float* in[23]; float* out; unsigned char* ws; int ph_lo, ph_hi, li, pad; };
__global__ void __launch_bounds__(NWAVES * 64, 2) mega(Args args) {
    extern __shared__ __attribute__((aligned(16))) unsigned char lds[];
    Frame F;
    F.lds = (LAS unsigned char*)lds;
    F.MISC = (volatile LAS unsigned*)(F.lds + MISC_OFF);
    F.G = gridDim.x; { const int bx = blockIdx.x; F.vcu = (F.G % 8 == 0) ? (bx % 8) * (F.G / 8) + bx / 8 : bx; }
    F.ws = args.ws; F.out = args.out; F.ctl = (gu32*)(args.ws + WS_CTL);
    for (int u = threadIdx.x; u < (LDS_BYTES - LDSCTL_OFF) / 4; u += NWAVES * 64) ((LAS unsigned*)(F.lds + LDSCTL_OFF))[u] = 0u;
    __syncthreads();
    if ((threadIdx.x & 63) == 0) ((LAS unsigned*)(F.lds + TID_TBL_OFF))[hw_slot()] = threadIdx.x >> 6;
    __syncthreads();

    XcdBarrier bar = xcd_barrier_post((unsigned*)(F.ctl + CW_BAR) + args.li * XCD_BAR_WORDS, F.MISC + 8);
    const int lo = args.ph_lo, hi = args.ph_hi;
#define IN(k) (lo <= (k) && (k) < hi)
#define SEAM(k) do { PRB_E(k, F.MISC + 24); if (IN(k) && IN((k) + 1)) { PRB_B(100 + (k), F.MISC + 24); xcd_barrier(bar); PRB_E(100 + (k), F.MISC + 24); } PRB_B((k) + 1, F.MISC + 24); } while (0)
#ifndef REP_PHASE
#define REP_PHASE -1
#endif

    PRB_B(0, F.MISC + 24);
    if (IN(0)) { { const int rep_ = 0; (void)rep_;  p0_prologue(F, argp(0), argp(1), argp(2), argp(12), argp(9), argp(10));  }
        if (REP_PHASE == 0) { xcd_barrier(bar); const int rep_ = 1; (void)rep_;  p0_prologue(F, argp(0), argp(1), argp(2), argp(12), argp(9), argp(10));  } }
    SEAM(0);
    if (IN(1)) { { const int rep_ = 0; (void)rep_;
        pg8::Gemm g{(const pg8::bf16_t*)F.out, (const pg8::bf16_t*)((unsigned char*)F.out + 32 * MiB), T_, 9216, DM}; pg8::StaticOrder S; S.init(T_, 9216, F.G, (int)blockIdx.x);
        pg8::EpiProj E{((bf16*)(F.ws + WS_SLAB)), (const float*)(F.ws + WS_ROPE)};
        pg8::gemm_phase<pg8::EpiProj, pg8::StaticOrder, true, true>(F.lds + RING_OFF, g, S, E);
     }
        if (REP_PHASE == 1) { xcd_barrier(bar); const int rep_ = 1; (void)rep_;
        pg8::Gemm g{(const pg8::bf16_t*)F.out, (const pg8::bf16_t*)((unsigned char*)F.out + 32 * MiB), T_, 9216, DM}; pg8::StaticOrder S; S.init(T_, 9216, F.G, (int)blockIdx.x);
        pg8::EpiProj E{((bf16*)(F.ws + WS_SLAB)), (const float*)(F.ws + WS_ROPE)};
        pg8::gemm_phase<pg8::EpiProj, pg8::StaticOrder, true, true>(F.lds + RING_OFF, g, S, E);
     } }
    SEAM(1);
    if (IN(2)) { { const int rep_ = 0; (void)rep_;  gdn::stageA(F.lds + RING_OFF, FTID, F.vcu, F.G, ((bf16*)(F.ws + WS_SLAB)), argp(8), (const float*)(F.ws + WS_BG), F.ws + WS_R2, F.MISC + 24);  }
        if (REP_PHASE == 2) { xcd_barrier(bar); const int rep_ = 1; (void)rep_;  gdn::stageA(F.lds + RING_OFF, FTID, F.vcu, F.G, ((bf16*)(F.ws + WS_SLAB)), argp(8), (const float*)(F.ws + WS_BG), F.ws + WS_R2, F.MISC + 24);  } }
    SEAM(2);
    if (IN(3)) { { const int rep_ = 0; (void)rep_;  p2_scans(F, lds, CW_Q + 64 * 16 * rep_); p2_attention(F, lds, CW_Q + 64 * 16 * rep_);  }
        if (REP_PHASE == 3) { xcd_barrier(bar); const int rep_ = 1; (void)rep_;  p2_scans(F, lds, CW_Q + 64 * 16 * rep_); p2_attention(F, lds, CW_Q + 64 * 16 * rep_);  } }
    SEAM(3);
    if (IN(4)) { { const int rep_ = 0; (void)rep_;  p2b_merge(F, argp(3), argp(4), argp(5), argp(6), argp(7), argp(11)); p_expert_weights(F, argp(16), argp(18), argp(20));  }
        if (REP_PHASE == 4) { xcd_barrier(bar); const int rep_ = 1; (void)rep_;  p2b_merge(F, argp(3), argp(4), argp(5), argp(6), argp(7), argp(11)); p_expert_weights(F, argp(16), argp(18), argp(20));  } }
    SEAM(4);
    if (IN(5)) { { const int rep_ = 0; (void)rep_;
        pg8::Gemm g{(const pg8::bf16_t*)((bf16*)(F.ws + WS_SLAB)), (const pg8::bf16_t*)(F.ws + WS_WOUT), T_, DM, DM}; pg8::StaticOrder S; S.init(T_, DM, F.G, (int)blockIdx.x);
        pg8::EpiOutRes E{argp(0), F.out};
        pg8::gemm_phase<pg8::EpiOutRes, pg8::StaticOrder, true, true>(F.lds + RING_OFF, g, S, E);
     }
        if (REP_PHASE == 5) { xcd_barrier(bar); const int rep_ = 1; (void)rep_;
        pg8::Gemm g{(const pg8::bf16_t*)((bf16*)(F.ws + WS_SLAB)), (const pg8::bf16_t*)(F.ws + WS_WOUT), T_, DM, DM}; pg8::StaticOrder S; S.init(T_, DM, F.G, (int)blockIdx.x);
        pg8::EpiOutRes E{argp(0), F.out};
        pg8::gemm_phase<pg8::EpiOutRes, pg8::StaticOrder, true, true>(F.lds + RING_OFF, g, S, E);
     } }
    SEAM(5);
    if (IN(6)) { if (REP_PHASE == 6) { p3b_router(F, argp(13), argp(14), argp(15), false); xcd_barrier(bar); } p3b_router(F, argp(13), argp(14), argp(15), true); }
    SEAM(6);
    PRB_E(7, F.MISC + 24); PRB_B(8, F.MISC + 24);
    if (IN(8)) {
        const int nMt = p3c_gather(F);
        const unsigned lb = (unsigned)(uintptr_t)(F.lds + RING_OFF);
        pg8::Gemm g{(const pg8::bf16_t*)(F.ws + WS_H2), (const pg8::bf16_t*)(F.ws + WS_W1T), nMt * 256, 2048, DM, (const int*)(F.ws + WS_LIST), lb + MOE_LDS_START, lb + MOE_LDS_CNT};
        pg8::MoeOrderT<true> S; S.init(nMt, 2048, F.G, (int)blockIdx.x, (const int*)(uintptr_t)(lb + MOE_LDS_TILEE), (long)2048 * DM * 2);
        pg8::EpiAct E{(bf16*)(F.ws + WS_SLAB + 144 * MiB), argp(17), argp(19), (const int*)(F.ws + TBL_TILEE)};
        pg8::gemm_phase<pg8::EpiAct, pg8::MoeOrderT<true>, true, true, true>(F.lds + RING_OFF, g, S, E);
    }
    SEAM(8);
    if (IN(9)) { { const int rep_ = 0; (void)rep_;
        const int nMt = __hip_atomic_load((const int*)(F.ws + TBL_NMT), __ATOMIC_RELAXED, __HIP_MEMORY_SCOPE_AGENT);
        pg8::Gemm g{(const pg8::bf16_t*)(F.ws + WS_SLAB + 144 * MiB), (const pg8::bf16_t*)(F.ws + WS_W2T), nMt * 256, DM, DM}; pg8::MoeOrder S; S.init(nMt, DM, F.G, (int)blockIdx.x, (const int*)(F.ws + TBL_TILEE), (long)DM * DM * 2);
        pg8::EpiDown E{(bf16*)(F.ws + WS_SLAB), argp(21), (const float*)(F.ws + TBL_WSLOT), (const int*)(F.ws + TBL_TILEE)};
        pg8::gemm_phase<pg8::EpiDown, pg8::MoeOrder, true, true>(F.lds + RING_OFF, g, S, E);
     }
        if (REP_PHASE == 9) { xcd_barrier(bar); const int rep_ = 1; (void)rep_;
        const int nMt = __hip_atomic_load((const int*)(F.ws + TBL_NMT), __ATOMIC_RELAXED, __HIP_MEMORY_SCOPE_AGENT);
        pg8::Gemm g{(const pg8::bf16_t*)(F.ws + WS_SLAB + 144 * MiB), (const pg8::bf16_t*)(F.ws + WS_W2T), nMt * 256, DM, DM}; pg8::MoeOrder S; S.init(nMt, DM, F.G, (int)blockIdx.x, (const int*)(F.ws + TBL_TILEE), (long)DM * DM * 2);
        pg8::EpiDown E{(bf16*)(F.ws + WS_SLAB), argp(21), (const float*)(F.ws + TBL_WSLOT), (const int*)(F.ws + TBL_TILEE)};
        pg8::gemm_phase<pg8::EpiDown, pg8::MoeOrder, true, true>(F.lds + RING_OFF, g, S, E);
     } }
    SEAM(9);
    if (IN(10)) { if (REP_PHASE == 10) { p6_final(F, (const bf16*)(F.ws + WS_SLAB), (const int*)(F.ws + TBL_SLOTOF), argp(22), (float*)(F.ws + WS_SLAB + 144 * MiB)); xcd_barrier(bar); } p6_final(F, (const bf16*)(F.ws + WS_SLAB), (const int*)(F.ws + TBL_SLOTOF), argp(22), F.out); }
    PRB_E(10, F.MISC + 24);
    if (PROBE_ID >= 0 && IN(10) && blockIdx.x == 0 && FTID == 0) { asm volatile("s_waitcnt vmcnt(0)" ::: "memory"); F.out[0] += (float)F.MISC[24] * 0.0003f; }
#undef IN
#undef SEAM
}


static void launch_mega(Args a, int lo, int hi, int li, int grid, hipStream_t stream) { a.ph_lo = lo; a.ph_hi = hi; a.li = li; a.pad = 0; hipLaunchKernelGGL(mega, dim3(grid), dim3(NWAVES * 64), LDS_BYTES, stream, a);
    const hipError_t le = hipPeekAtLastError(); if (le != hipSuccess) fprintf(stderr, "kernel_launch: mega launch [%d,%d) failed: %s\n", lo, hi, hipGetErrorName(le)); }
extern "C" void kernel_launch(void* const* d_in, const int* in_sizes, int n_in, void* d_out, int out_size, void* d_ws, size_t ws_size, hipStream_t stream) {
    static int grid = 0;
    if (grid == 0) {
        if (n_in != 23 || ws_size < WS_END || out_size != T_ * DM) { fprintf(stderr, "kernel_launch: unexpected shapes n_in %d ws %zu out %d\n", n_in, ws_size, out_size); grid = -1; return; }
        int dev = 0, cus = 0;
        if (hipGetDevice(&dev) != hipSuccess || hipDeviceGetAttribute(&cus, hipDeviceAttributeMultiprocessorCount, dev) != hipSuccess) { grid = -1; return; }
        if (hipFuncSetAttribute((const void*)mega, hipFuncAttributeMaxDynamicSharedMemorySize, LDS_BYTES) != hipSuccess) { fprintf(stderr, "kernel_launch: hipFuncSetAttribute failed\n"); grid = -1; return; }
        (void)hipGetLastError();
        grid = cus;
        fprintf(stderr, "kernel_launch: grid %d ws_size %zu MiB\n", grid, ws_size >> 20);
    }
    if (grid < 0) return;
    const float* conv_w = (const float*)d_in[8];
    const float *wg = (const float*)d_in[16], *bgate = (const float*)d_in[17], *wu = (const float*)d_in[18], *bup = (const float*)d_in[19], *wd = (const float*)d_in[20], *bdown = (const float*)d_in[21];
    unsigned char* ws = (unsigned char*)d_ws;
    int* cnt = (int*)(ws + WS_CTL); float* bg = (float*)(ws + WS_BG); float* topw = (float*)(ws + WS_TOPW); int* list = (int*)(ws + WS_LIST);
    bf16_t* slab = (bf16_t*)(ws + WS_SLAB);
    bf16_t *VA = slab + 2 * (SLAB / 2), *GQ = slab + 3 * (SLAB / 2);
    float *cq = (float*)(ws + WS_R2), *ck = (float*)(ws + WS_R2 + 64 * MiB), *cv = (float*)(ws + WS_R2 + 128 * MiB);
    bf16_t* act = (bf16_t*)(ws + WS_R2); bf16_t* ybuf = VA; bf16_t* H2 = (bf16_t*)(ws + WS_H2);
    (void)hipMemsetAsync(ws + WS_CTL, 0, CTL_ZERO_BYTES, stream);
    Args a; memset(&a, 0, sizeof a);
    for (int i = 0; i < 23; ++i) a.in[i] = (const float*)d_in[i];
    a.out = (float*)d_out; a.ws = ws;
    launch_mega(a, 0, 11, 0, grid, stream);
}
```

```cpp
#include <hip/hip_runtime.h>
#include <hip/hip_bf16.h>
#include <cstdio>
#include <cstdint>
#include <cmath>
#include <cstring>

constexpr int T_ = 16384, SEQ = 8192, DM = 1024, IN_DIM = 9232, NEXP = 32;
constexpr float NORM_EPS = 1e-6f;
constexpr float C2 = 0.125f * 1.4426950408889634f;
typedef unsigned short bf16_t;

constexpr size_t MiB = 1u << 20;
constexpr size_t WS_CTL = 0, CTL_ZERO_BYTES = 64 * 1024;
constexpr size_t WS_BG = 2 * MiB;
constexpr size_t WS_ROPE = 3 * MiB;
constexpr size_t WS_TOPE = 5 * MiB;
constexpr size_t WS_TOPW = 5 * MiB + 512 * 1024;
constexpr size_t WS_LIST = 6 * MiB;
constexpr size_t WS_SLAB = 8 * MiB;
constexpr size_t SLAB = 32 * MiB;
constexpr size_t WS_H2 = WS_SLAB;
constexpr size_t WS_R2 = WS_SLAB + 9 * SLAB;
constexpr size_t WS_WOUT = WS_R2 + 192 * MiB;
constexpr size_t WS_SLOT = WS_WOUT + 2 * MiB;
constexpr size_t WS_END = WS_SLOT + 4 * MiB;
constexpr int CW_CNT = 8192;
constexpr int CW_Q = 64;
constexpr int CW_BAR = 4096;

__device__ __forceinline__ float bf2f(bf16_t v) { return __uint_as_float((unsigned)v << 16); }
__device__ __forceinline__ bf16_t f2bf(float f) { unsigned u = __float_as_uint(f); return (bf16_t)((u + 0x7fffu + ((u >> 16) & 1u)) >> 16); }
#define WAVE_DPP(x, ctrl, rmask, old) __int_as_float(__builtin_amdgcn_update_dpp(__float_as_int(old), __float_as_int(x), ctrl, rmask, 0xF, false))
__device__ __forceinline__ float wave_sum(float v) {
    v += WAVE_DPP(v, 0xB1, 0xF, 0.f); v += WAVE_DPP(v, 0x4E, 0xF, 0.f); v += WAVE_DPP(v, 0x141, 0xF, 0.f); v += WAVE_DPP(v, 0x140, 0xF, 0.f);
    v += WAVE_DPP(v, 0x142, 0xA, 0.f); v += WAVE_DPP(v, 0x143, 0xC, 0.f);
    return __int_as_float(__builtin_amdgcn_readlane(__float_as_int(v), 63));
}
__device__ __forceinline__ float wave_max(float v) {
    v = fmaxf(v, WAVE_DPP(v, 0xB1, 0xF, v)); v = fmaxf(v, WAVE_DPP(v, 0x4E, 0xF, v)); v = fmaxf(v, WAVE_DPP(v, 0x141, 0xF, v)); v = fmaxf(v, WAVE_DPP(v, 0x140, 0xF, v));
    v = fmaxf(v, WAVE_DPP(v, 0x142, 0xA, v)); v = fmaxf(v, WAVE_DPP(v, 0x143, 0xC, v));
    return __int_as_float(__builtin_amdgcn_readlane(__float_as_int(v), 63));
}
__device__ __forceinline__ float sigmoidf_(float x) { return __builtin_amdgcn_rcpf(1.0f + __expf(-x)); }

constexpr int TID_TBL_OFF = 152576 + 320 + 256;
__device__ __forceinline__ int hw_slot() { return (int)(__builtin_amdgcn_s_getreg((5 << 11) | 4) & 63u); }
__device__ __forceinline__ int lane_now() { unsigned z; asm volatile("v_mov_b32 %0, 0" : "=v"(z)); return (int)__builtin_amdgcn_mbcnt_hi(~0u, __builtin_amdgcn_mbcnt_lo(~0u, z)); }
__device__ __forceinline__ int wave_now(const void* ring_base) { const __attribute__((address_space(3))) unsigned* T = (const __attribute__((address_space(3))) unsigned*)((const __attribute__((address_space(3))) unsigned char*)(unsigned)(uintptr_t)ring_base + TID_TBL_OFF);
    return __builtin_amdgcn_readfirstlane((int)T[hw_slot()]); }
__device__ __forceinline__ int tid_now(const void* ring_base) { return wave_now(ring_base) * 64 + lane_now(); }

#ifndef PROBE_ID
#define PROBE_ID -1
#endif
#define PRB4_B(id, PRB) do { if (PROBE_ID == (id) && blockIdx.x == 0 && threadIdx.x == 256) (PRB)[1] = (unsigned)__builtin_amdgcn_s_memrealtime(); } while (0)
#define PRB4_E(id, PRB) do { if (PROBE_ID == (id) && blockIdx.x == 0 && threadIdx.x == 256) (PRB)[0] += (unsigned)__builtin_amdgcn_s_memrealtime() - (PRB)[1]; } while (0)
#ifndef PROBE_TID
#define PROBE_TID 0
#endif
#define PRB_B(id, PRB) do { if (PROBE_ID == (id) && blockIdx.x == 0 && threadIdx.x == PROBE_TID) (PRB)[1] = (unsigned)__builtin_amdgcn_s_memrealtime(); } while (0)
#define PRBC_B(id, PRB) do { if (PROBE_ID == (id) && blockIdx.x == 0 && threadIdx.x == 0) (PRB)[1] = (unsigned)__builtin_amdgcn_s_memtime(); } while (0)
#define PRBC_E(id, PRB) do { if (PROBE_ID == (id) && blockIdx.x == 0 && threadIdx.x == 0) (PRB)[0] += ((unsigned)__builtin_amdgcn_s_memtime() - (PRB)[1]) >> 4; } while (0)
#define PRB_E(id, PRB) do { if (PROBE_ID == (id) && blockIdx.x == 0 && threadIdx.x == PROBE_TID) (PRB)[0] += (unsigned)__builtin_amdgcn_s_memrealtime() - (PRB)[1]; } while (0)

namespace pg8 {
#define PG8_LAS __attribute__((address_space(3)))
typedef unsigned short bf16_t;
typedef short bf16x8 __attribute__((ext_vector_type(8)));
typedef float f32x4 __attribute__((ext_vector_type(4)));
typedef unsigned u32x4 __attribute__((ext_vector_type(4)));
constexpr int BM = 256, BK = 64, HALF = 128, HTB = HALF * BK * 2  , STAGE_BYTES = 8 * HTB, NXCD = 8, WGM = 8;

__host__ __device__ __forceinline__ int lds_byte(int r, int c) { const int st = (r >> 4) * 2 + (c >> 5), rr = r & 15, cc = c & 31, ob = rr * 64 + cc * 2; return st * 1024 + (ob ^ (((ob >> 9) & 1) << 5)); }
__host__ __device__ __forceinline__ void stage_rc(int b, int& R, int& C) { const int st = b / 1024, sb = b % 1024, swz = sb ^ (((sb >> 9) & 1) << 5); R = (st >> 1) * 16 + swz / 64; C = (st & 1) * 32 + (swz % 64) / 2; }
__host__ __device__ __forceinline__ int perm32(int rho) { const int n = rho >> 4, i = rho & 15; return 8 * (i >> 2) + 4 * n + (i & 3); }

struct Unit { int pm, pn; long boff; int e; int half, rofs; };
struct Gemm { const bf16_t* A; const bf16_t* Bt; int M, N, K; const int* list; unsigned ldsStart, ldsCnt; };

struct StaticOrder {
    int nM, nN, nwg, G, c;
    __host__ __device__ void init(int M, int N, int G_, int c_) { nM = M / BM; nN = N / BM; nwg = nM * nN; G = G_; c = c_; }
    __host__ __device__ bool next(int i, Unit& u) const { const long L = (long)i * G + c; if (L >= nwg) return false; map((int)L, u); return true; }
    __host__ __device__ void map(int L, Unit& u) const {
        int wgid = L; { const int q = nwg / NXCD, r = nwg % NXCD, xcd = wgid % NXCD, off = wgid / NXCD; wgid = (xcd < r ? xcd * (q + 1) : r * (q + 1) + (xcd - r) * q) + off; }
        const int nig = WGM * nN, gid = wgid / nig, fm = gid * WGM, gsz = (nM - fm) < WGM ? (nM - fm) : WGM;
        u.pm = fm + ((wgid % nig) % gsz); u.pn = (wgid % nig) / gsz; u.boff = 0; u.e = 0; u.half = 0; u.rofs = 0;
    }
    __device__ __forceinline__ void a_ready(const Unit&) const {}
    __device__ __forceinline__ void done(const Unit&) const {}
};


#ifndef GAS
#define GAS __attribute__((address_space(1)))
#endif
__device__ __forceinline__ unsigned cvt_pk_bf16(float lo, float hi) { unsigned r; asm volatile("v_cvt_pk_bf16_f32 %0, %1, %2" : "=v"(r) : "v"(lo), "v"(hi)); return r; }
typedef unsigned u32x2 __attribute__((ext_vector_type(2)));

struct EpiProj {
    static constexpr bool PERM = true, AFTER_DRAIN = false;
    bf16_t* slab; const float* rope;
    __device__ __forceinline__ void operator()(const f32x4 (&acc)[2][2][4][2], const Unit& u, int wr, int wc, int fr, int fq) const {
        const int s = u.pn >> 2; bf16_t* base = slab + (size_t)s * (SLAB / 2); const int colt = (u.pn & 3) * 256;
        const int row0 = u.pm * BM + wr * 64 + fr;
        if (s < 2) {
            const float sc = (s == 0) ? C2 : 1.0f; const int i0 = 16 * (wc & 1) + 4 * fq;
            f32x4 csv[2][4], snv[2][4];
#pragma unroll
            for (int ai = 0; ai < 2; ++ai)
#pragma unroll
                for (int m = 0; m < 4; ++m) { const int pos = (row0 + ai * HALF + m * 16) & (SEQ - 1);
                    csv[ai][m] = *(const GAS f32x4*)(rope + pos * 32 + i0); snv[ai][m] = *(const GAS f32x4*)(rope + SEQ * 32 + pos * 32 + i0); }
#pragma unroll
            for (int ai = 0; ai < 2; ++ai)
#pragma unroll
                for (int m = 0; m < 4; ++m) { const int row = row0 + ai * HALF + m * 16;
                    const f32x4 cs = csv[ai][m] * sc, sn = snv[ai][m] * sc;
#pragma unroll
                    for (int bj = 0; bj < 2; ++bj) { const f32x4 v0 = acc[ai][bj][m][0], v1 = acc[ai][bj][m][1];
                        const f32x4 lo = v0 * cs - v1 * sn, hi = v1 * cs + v0 * sn;
                        bf16_t* p = base + (size_t)row * DM + colt + 64 * (2 * bj + (wc >> 1)) + i0;
                        u32x2 w0, w1; w0.x = cvt_pk_bf16(lo[0], lo[1]); w0.y = cvt_pk_bf16(lo[2], lo[3]); w1.x = cvt_pk_bf16(hi[0], hi[1]); w1.y = cvt_pk_bf16(hi[2], hi[3]);
                        *(GAS u32x2*)p = w0; *(GAS u32x2*)(p + 32) = w1; } }
        } else {
            const int col0 = colt + wc * 32 + 8 * fq;
#pragma unroll
            for (int ai = 0; ai < 2; ++ai)
#pragma unroll
                for (int m = 0; m < 4; ++m) { bf16_t* rowp = base + (size_t)(row0 + ai * HALF + m * 16) * DM + col0;
#pragma unroll
                    for (int bj = 0; bj < 2; ++bj) { const f32x4 v0 = acc[ai][bj][m][0], v1 = acc[ai][bj][m][1];
                        u32x4 w; w.x = cvt_pk_bf16(v0[0], v0[1]); w.y = cvt_pk_bf16(v0[2], v0[3]); w.z = cvt_pk_bf16(v1[0], v1[1]); w.w = cvt_pk_bf16(v1[2], v1[3]);
                        *(GAS u32x4*)(rowp + bj * HALF) = w; } }
        }
    }
};
struct EpiOutRes {
    static constexpr bool PERM = false, AFTER_DRAIN = false;
    const float* x; float* x1;
    __device__ __forceinline__ void operator()(const f32x4 (&acc)[2][2][4][2], const Unit& u, int wr, int wc, int fr, int fq) const {
        const int col0 = u.pn * BM + wc * 32 + 4 * fq;
#pragma unroll
        for (int ai = 0; ai < 2; ++ai) { f32x4 bs[4][2][2];
#pragma unroll
            for (int m = 0; m < 4; ++m) { const size_t off = (size_t)(u.pm * BM + ai * HALF + wr * 64 + m * 16 + fr) * DM + col0;
#pragma unroll
                for (int bj = 0; bj < 2; ++bj)
#pragma unroll
                    for (int n = 0; n < 2; ++n) bs[m][bj][n] = *(const GAS f32x4*)(x + off + bj * HALF + n * 16); }
#pragma unroll
            for (int m = 0; m < 4; ++m) { const size_t off = (size_t)(u.pm * BM + ai * HALF + wr * 64 + m * 16 + fr) * DM + col0;
#pragma unroll
                for (int bj = 0; bj < 2; ++bj)
#pragma unroll
                    for (int n = 0; n < 2; ++n) *(GAS f32x4*)(x1 + off + bj * HALF + n * 16) = bs[m][bj][n] + acc[ai][bj][m][n]; } }
    }
};
struct EpiAct {
    static constexpr bool PERM = true, AFTER_DRAIN = false;
    bf16_t* act; const float* bgate; const float* bup; const int* tile_e;
    __device__ __forceinline__ void operator()(const f32x4 (&acc)[2][2][4][2], const Unit& u, int wr, int wc, int fr, int fq) const {
        const int e = u.e;
        const int col0 = u.pn * HALF + wc * 32 + 8 * fq; const int row0 = u.pm * BM + u.rofs + wr * 64 + fr;
        const f32x4 bg0 = *(const GAS f32x4*)(bgate + e * 1024 + col0), bg1 = *(const GAS f32x4*)(bgate + e * 1024 + col0 + 4), bu0 = *(const GAS f32x4*)(bup + e * 1024 + col0), bu1 = *(const GAS f32x4*)(bup + e * 1024 + col0 + 4);
#pragma unroll
        for (int ai = 0; ai < 2; ++ai) { if (ai == 1 && u.half) break;
#pragma unroll
            for (int m = 0; m < 4; ++m) { f32x4 o[2];
#pragma unroll
                for (int n = 0; n < 2; ++n) { const f32x4 g = acc[ai][0][m][n] + (n ? bg1 : bg0), up = acc[ai][1][m][n] + (n ? bu1 : bu0);
                    f32x4 gate, uu, ex;
#pragma unroll
                    for (int q = 0; q < 4; ++q) { gate[q] = fminf(g[q], 7.0f); uu[q] = fminf(fmaxf(up[q], -7.0f), 7.0f); }
                    const f32x4 tt = gate * (-1.702f * 1.4426950408889634f);
#pragma unroll
                    for (int q = 0; q < 4; ++q) ex[q] = __builtin_amdgcn_exp2f(tt[q]);
                    const f32x4 den = ex + 1.0f; f32x4 rc;
#pragma unroll
                    for (int q = 0; q < 4; ++q) rc[q] = __builtin_amdgcn_rcpf(den[q]);
                    o[n] = (uu + 1.0f) * gate * rc; }
                u32x4 w; w.x = cvt_pk_bf16(o[0][0], o[0][1]); w.y = cvt_pk_bf16(o[0][2], o[0][3]); w.z = cvt_pk_bf16(o[1][0], o[1][1]); w.w = cvt_pk_bf16(o[1][2], o[1][3]);
                *(GAS u32x4*)(act + (size_t)(row0 + ai * HALF + m * 16) * DM + col0) = w; } }
    }
};
struct EpiDown {
    static constexpr bool PERM = true, AFTER_DRAIN = false;
    bf16_t* y; const float* bdown; const float* wslot; const int* tile_e;
    __device__ __forceinline__ void operator()(const f32x4 (&acc)[2][2][4][2], const Unit& u, int wr, int wc, int fr, int fq) const {
        const int e = u.e;
        const int col0 = u.pn * BM + wc * 32 + 8 * fq; const int row0 = u.pm * BM + u.rofs + wr * 64 + fr;
        f32x4 bv[2][2]; float wsv[2][4];
#pragma unroll
        for (int bj = 0; bj < 2; ++bj)
#pragma unroll
            for (int n = 0; n < 2; ++n) bv[bj][n] = *(const GAS f32x4*)(bdown + e * 1024 + col0 + bj * HALF + 4 * n);
#pragma unroll
        for (int ai = 0; ai < 2; ++ai)
#pragma unroll
            for (int m = 0; m < 4; ++m) wsv[ai][m] = *(const GAS float*)(wslot + row0 + (u.half ? 0 : ai * HALF) + m * 16);
#pragma unroll
        for (int ai = 0; ai < 2; ++ai) { if (ai == 1 && u.half) break;
#pragma unroll
            for (int m = 0; m < 4; ++m) { const int row = row0 + ai * HALF + m * 16; const float ws = wsv[ai][m];
#pragma unroll
                for (int bj = 0; bj < 2; ++bj) { const f32x4 v0 = (acc[ai][bj][m][0] + bv[bj][0]) * ws, v1 = (acc[ai][bj][m][1] + bv[bj][1]) * ws;
                    u32x4 w; w.x = cvt_pk_bf16(v0[0], v0[1]); w.y = cvt_pk_bf16(v0[2], v0[3]); w.z = cvt_pk_bf16(v1[0], v1[1]); w.w = cvt_pk_bf16(v1[2], v1[3]);
                    *(GAS u32x4*)(y + (size_t)row * DM + col0 + bj * HALF) = w; } } }
    }
};
template <bool LDS_TBL> struct MoeOrderT {
    StaticOrder so; const int* tile_e; long estride; int nfull, rem, rev;
    __device__ void init(int nMt, int N, int G_, int c_, const int* te, long es) { rev = 0; so.nM = nMt; so.nN = N / BM; so.nwg = so.nM * so.nN; so.G = G_; so.c = c_; tile_e = te; estride = es;
        nfull = (so.nwg / G_) * G_; rem = so.nwg - nfull; }
    __device__ bool next(int i, Unit& u) const { const long L = (long)i * so.G + so.c; int idx, half = 0, rofs = 0;
        if (L < nfull) idx = (int)L;
        else { const int j = (int)(L - nfull); if (2 * rem <= so.G) { if (j >= 2 * rem) return false; idx = nfull + (j >> 1); half = 1; rofs = (j & 1) * HALF; } else { if (j >= rem) return false; idx = nfull + j; } }
        if (rev) idx = so.nwg - 1 - idx;
        so.map(idx, u); int e; if constexpr (LDS_TBL) e = *(const PG8_LAS int*)(uintptr_t)((unsigned)(uintptr_t)tile_e + 4u * (unsigned)u.pm); else e = __hip_atomic_load(tile_e + u.pm, __ATOMIC_RELAXED, __HIP_MEMORY_SCOPE_AGENT);
        u.boff = (long)e * estride; u.e = e; u.half = half; u.rofs = rofs; return true; }
    __device__ __forceinline__ void a_ready(const Unit&) const {}
    __device__ __forceinline__ void done(const Unit&) const {}
};
typedef MoeOrderT<false> MoeOrder;
template <class Epi, class Sched, bool ALIGN_EPI = false, bool SP2 = false, bool GATHER = false>
__device__ __forceinline__ void gemm_phase(PG8_LAS unsigned char* lds, const Gemm g, const Sched& S, const Epi& E) {
    const int wid = wave_now((const void*)(uintptr_t)(unsigned)(uintptr_t)lds), lane = lane_now(), tid = wid * 64 + lane, wr = wid >> 2, wc = wid & 3, fr = lane & 15, fq = lane >> 4;
    const int K = g.K, nt = K / BK;
    unsigned voffA[2], voffB[2];
#pragma unroll
    for (int i = 0; i < 2; ++i) { int R, C; stage_rc(tid * 16 + i * 8192, R, C); const int Rb = Epi::PERM ? ((R & ~31) + perm32(R & 31)) : R;
        voffA[i] = (unsigned)(R * K + C) * 2u; voffB[i] = (unsigned)(Rb * K + C) * 2u; }
    const size_t kstep = (size_t)(BK * 2);
    const size_t hstep = (size_t)HALF * K * 2;
    const size_t tstep = 2 * hstep;
    const unsigned ldsw = (unsigned)wid * 1024u;
    const int aoff = lds_byte(wr * 64 + fr, fq * 8), boff = lds_byte(wc * 32 + fr, fq * 8);
#define PG8_SA(b, h) (((b) * 2 + (h)) * HTB)
#define PG8_SB(b, h) ((4 + (b) * 2 + (h)) * HTB)
#define PG8_STAGE(bufoff, gbase, voff) do { _Pragma("unroll") for (int _i = 0; _i < 2; ++_i) \
        __builtin_amdgcn_global_load_lds((const unsigned*)((const char*)(gbase) + (voff)[_i]), (PG8_LAS unsigned*)(lds + (bufoff) + ldsw + _i * 8192), 16, 0, 0); } while (0)
#define PG8_STA(bufoff, P, h, G) do { if constexpr (GATHER) { PG8_STAGE(bufoff, P, (G)[h]); } else { PG8_STAGE(bufoff, (P) + (h) * hstep, voffA); } } while (0)
#define PG8_LDA(dst, b, h) do { _Pragma("unroll") for (int m = 0; m < 4; ++m) _Pragma("unroll") for (int k = 0; k < 2; ++k) dst[m][k] = *(const PG8_LAS bf16x8*)(lds + PG8_SA(b, h) + aoff + m * 2048 + k * 1024); } while (0)
#define PG8_LDB(dst, b, h) do { _Pragma("unroll") for (int n = 0; n < 2; ++n) _Pragma("unroll") for (int k = 0; k < 2; ++k) dst[n][k] = *(const PG8_LAS bf16x8*)(lds + PG8_SB(b, h) + boff + n * 2048 + k * 1024); } while (0)
#define PG8_MMA(ai, bj, At, Bt) do { __builtin_amdgcn_s_setprio(1); _Pragma("unroll") for (int m = 0; m < 4; ++m) _Pragma("unroll") for (int n = 0; n < 2; ++n) _Pragma("unroll") for (int k = 0; k < 2; ++k) \
        acc[ai][bj][m][n] = __builtin_amdgcn_mfma_f32_16x16x32_bf16(Bt[n][k], At[m][k], acc[ai][bj][m][n], 0, 0, 0); __builtin_amdgcn_s_setprio(0); } while (0)
#define PG8_WAIT_V(n) asm volatile("s_waitcnt vmcnt(" #n ")" ::: "memory")
#define PG8_WAIT_L(n) asm volatile("s_waitcnt lgkmcnt(" #n ")" ::: "memory")
#define PG8_BAR __builtin_amdgcn_s_barrier()
#define PG8_SCHED __builtin_amdgcn_sched_barrier(0)
    Unit cur, nxt; int ui = 0;
    if (!S.next(0, cur)) return;
    f32x4 acc[2][2][4][2];
#pragma unroll
    for (int a = 0; a < 2; ++a)
#pragma unroll
        for (int b = 0; b < 2; ++b)
#pragma unroll
            for (int m = 0; m < 4; ++m)
#pragma unroll
                for (int n = 0; n < 2; ++n) acc[a][b][m][n] = (f32x4){0.f, 0.f, 0.f, 0.f};
    bf16x8 At[4][2], B0[2][2], B1[2][2];
    const char* cA = (const char*)g.A + (GATHER ? (size_t)0 : (size_t)cur.pm * tstep + (size_t)cur.rofs * K * 2); const char* cB = (const char*)g.Bt + cur.boff + (size_t)cur.pn * tstep;
    S.a_ready(cur);
    unsigned gC[2][2], gX[2][2];
#define PG8_ROWIDS(G, U_) do { const int se_ = *(const PG8_LAS int*)(uintptr_t)(g.ldsStart + 4u * (unsigned)(U_).e), ce_ = *(const PG8_LAS int*)(uintptr_t)(g.ldsCnt + 4u * (unsigned)(U_).e);   \
        const int* lb_ = g.list + (U_).e * 16384;                                                                                                       \
        _Pragma("unroll") for (int h_ = 0; h_ < 2; ++h_) _Pragma("unroll") for (int i_ = 0; i_ < 2; ++i_) {                                              \
            int pos_ = (U_).pm * 256 + (U_).rofs + ((U_).half ? 0 : h_ * 128) + (int)(voffA[i_] / (unsigned)(2 * K)) - se_; if (pos_ >= ce_) pos_ = 0;     \
            const int* rp_ = lb_ + pos_; unsigned v_; asm volatile("global_load_dword %0, %1, off" : "=v"(v_) : "v"(rp_) : "memory"); G[h_][i_] = v_; } } while (0)
#define PG8_ROWFIX(G) do { _Pragma("unroll") for (int h_ = 0; h_ < 2; ++h_) _Pragma("unroll") for (int i_ = 0; i_ < 2; ++i_) G[h_][i_] = (G[h_][i_] >> 2) * (unsigned)(2 * K) + voffA[i_] % (unsigned)(2 * K); } while (0)
    if constexpr (GATHER) { PG8_ROWIDS(gC, cur); asm volatile("s_waitcnt vmcnt(0)" ::: "memory"); PG8_ROWFIX(gC);
#pragma unroll
        for (int h_ = 0; h_ < 2; ++h_) { gX[h_][0] = gC[h_][0]; gX[h_][1] = gC[h_][1]; } }
    if constexpr (SP2) {
        PG8_STAGE(PG8_SB(0, 0), cB, voffB); PG8_STAGE(PG8_SB(0, 1), cB + hstep, voffB); PG8_STA(PG8_SA(0, 0), cA, 0, gC); PG8_STA(PG8_SA(0, 1), cA, 1, gC);
        if (wr == 1) PG8_BAR;
        PG8_WAIT_V(2); PG8_BAR;
        PG8_STAGE(PG8_SB(1, 0), cB + kstep, voffB); PG8_STA(PG8_SA(1, 0), cA + kstep, 0, gC); PG8_STAGE(PG8_SB(1, 1), cB + hstep + kstep, voffB);
        PG8_WAIT_V(6); PG8_BAR;
    } else {
        PG8_STAGE(PG8_SB(0, 0), cB, voffB); PG8_STA(PG8_SA(0, 0), cA, 0, gC); PG8_STAGE(PG8_SB(0, 1), cB + hstep, voffB); PG8_STA(PG8_SA(0, 1), cA, 1, gC);
        if (wr == 1) PG8_BAR;
        PG8_WAIT_V(4); PG8_BAR;
        PG8_STAGE(PG8_SB(1, 0), cB + kstep, voffB); PG8_STA(PG8_SA(1, 0), cA + kstep, 0, gC); PG8_STAGE(PG8_SB(1, 1), cB + hstep + kstep, voffB);
        PG8_WAIT_V(6); PG8_BAR;
    }
    for (;;) {
        const bool has_next = S.next(ui + 1, nxt);
        const char* nA = (has_next && !GATHER) ? (const char*)g.A + (size_t)nxt.pm * tstep + (size_t)nxt.rofs * K * 2 : cA; const char* nB = has_next ? (const char*)g.Bt + nxt.boff + (size_t)nxt.pn * tstep : cB;
        if constexpr (GATHER) { if (has_next) PG8_ROWIDS(gX, nxt); }
        for (int t = 0; t < nt; t += 2) {
            const bool last = (t == nt - 2);
            const char* a1 = cA + (size_t)(t + 1) * kstep;
            const char* a2 = last ? nA : cA + (size_t)(t + 2) * kstep; const char* b2 = last ? nB : cB + (size_t)(t + 2) * kstep;
            const char* a3 = a2 + kstep; const char* b3 = b2 + kstep;
            if (last && has_next) S.a_ready(nxt);
            unsigned g2[2][2];
            if constexpr (GATHER) { if (last && has_next) PG8_ROWFIX(gX);
#pragma unroll
                for (int h_ = 0; h_ < 2; ++h_) { g2[h_][0] = last ? gX[h_][0] : gC[h_][0]; g2[h_][1] = last ? gX[h_][1] : gC[h_][1]; } }
            if constexpr (SP2) {
            const bool hc = cur.half != 0, h2 = last ? (has_next ? nxt.half != 0 : hc) : hc;
            PG8_LDB(B0, 0, 0); PG8_LDB(B1, 0, 1); PG8_SCHED; PG8_LDA(At, 0, 0); if (!hc) PG8_STA(PG8_SA(1, 1), a1, 1, gC);
            PG8_WAIT_V(8); PG8_WAIT_L(0); PG8_BAR; PG8_MMA(0, 0, At, B0); PG8_MMA(0, 1, At, B1); PG8_BAR; PG8_SCHED;
            if (!hc) PG8_LDA(At, 0, 1); PG8_STAGE(PG8_SB(0, 0), b2, voffB); PG8_STAGE(PG8_SB(0, 1), b2 + hstep, voffB); PG8_STA(PG8_SA(0, 0), a2, 0, g2);
            if (hc) PG8_WAIT_V(6); else PG8_WAIT_V(8);
            PG8_WAIT_L(0); PG8_BAR; if (!hc) { PG8_MMA(1, 0, At, B0); PG8_MMA(1, 1, At, B1); } PG8_BAR; PG8_SCHED;
            PG8_LDB(B0, 1, 0); PG8_LDB(B1, 1, 1); PG8_SCHED; PG8_LDA(At, 1, 0); if (!h2) PG8_STA(PG8_SA(0, 1), a2, 1, g2);
            if (h2) PG8_WAIT_V(6); else PG8_WAIT_V(8);
            PG8_WAIT_L(0); PG8_BAR; PG8_MMA(0, 0, At, B0); PG8_MMA(0, 1, At, B1); PG8_BAR; PG8_SCHED;
            if (!hc) PG8_LDA(At, 1, 1); PG8_STAGE(PG8_SB(1, 0), b3, voffB); PG8_STAGE(PG8_SB(1, 1), b3 + hstep, voffB); PG8_STA(PG8_SA(1, 0), a3, 0, g2);
            if (h2) PG8_WAIT_V(6); else PG8_WAIT_V(8);
            PG8_WAIT_L(0); PG8_BAR; if (!hc) { PG8_MMA(1, 0, At, B0); PG8_MMA(1, 1, At, B1); } PG8_BAR; PG8_SCHED;
            } else {
            PG8_LDB(B0, 0, 0); PG8_SCHED; PG8_LDA(At, 0, 0); PG8_STA(PG8_SA(1, 1), a1, 1, gC);
            PG8_WAIT_L(8); PG8_BAR; PG8_WAIT_L(0); PG8_MMA(0, 0, At, B0); PG8_BAR; PG8_SCHED;
            PG8_LDB(B1, 0, 1); PG8_STAGE(PG8_SB(0, 0), b2, voffB);
            PG8_BAR; PG8_WAIT_L(0); PG8_MMA(0, 1, At, B1); PG8_BAR;
            PG8_LDA(At, 0, 1); PG8_STA(PG8_SA(0, 0), a2, 0, g2);
            PG8_BAR; PG8_WAIT_L(0); PG8_MMA(1, 0, At, B0); PG8_BAR; PG8_SCHED;
            PG8_STAGE(PG8_SB(0, 1), b2 + hstep, voffB);
            PG8_WAIT_V(6); PG8_BAR; PG8_MMA(1, 1, At, B1); PG8_BAR;
            PG8_LDB(B0, 1, 0); PG8_SCHED; PG8_LDA(At, 1, 0); PG8_STA(PG8_SA(0, 1), a2, 1, g2);
            PG8_WAIT_L(8); PG8_BAR; PG8_WAIT_L(0); PG8_MMA(0, 0, At, B0); PG8_BAR; PG8_SCHED;
            PG8_LDB(B1, 1, 1); PG8_STAGE(PG8_SB(1, 0), b3, voffB);
            PG8_BAR; PG8_WAIT_L(0); PG8_MMA(0, 1, At, B1); PG8_BAR;
            PG8_LDA(At, 1, 1); PG8_STA(PG8_SA(1, 0), a3, 0, g2);
            PG8_BAR; PG8_WAIT_L(0); PG8_MMA(1, 0, At, B0); PG8_BAR; PG8_SCHED;
            PG8_STAGE(PG8_SB(1, 1), b3 + hstep, voffB);
            PG8_WAIT_V(6); PG8_BAR; PG8_MMA(1, 1, At, B1); PG8_BAR;
            }
        }
        if constexpr (ALIGN_EPI) { if (wr == 0) PG8_BAR; }
        if constexpr (!Epi::AFTER_DRAIN) { E(acc, cur, wr, wc, fr, fq); S.done(cur); }
        if (!has_next) break;
#pragma unroll
        for (int a = 0; a < 2; ++a)
#pragma unroll
            for (int b = 0; b < 2; ++b)
#pragma unroll
                for (int m = 0; m < 4; ++m)
#pragma unroll
                    for (int n = 0; n < 2; ++n) acc[a][b][m][n] = (f32x4){0.f, 0.f, 0.f, 0.f};
        cur = nxt; cA = nA; cB = nB; ++ui;
        if constexpr (GATHER) {
#pragma unroll
            for (int h_ = 0; h_ < 2; ++h_) { gC[h_][0] = gX[h_][0]; gC[h_][1] = gX[h_][1]; } }
        if constexpr (ALIGN_EPI) { if (wr == 1) PG8_BAR; }
    }
    PG8_WAIT_V(0);
    if constexpr (!ALIGN_EPI) { if (wr == 0) PG8_BAR; }
    PG8_BAR;
    if constexpr (Epi::AFTER_DRAIN) { E.fused(acc, cur, wr, wc, fr, fq, lds, wid, lane); S.done(cur); }
#undef PG8_SA
#undef PG8_STA
#undef PG8_ROWIDS
#undef PG8_ROWFIX
#undef PG8_SB
#undef PG8_STAGE
#undef PG8_LDA
#undef PG8_LDB
#undef PG8_MMA
#undef PG8_WAIT_V
#undef PG8_WAIT_L
#undef PG8_BAR
#undef PG8_SCHED
}
}

#include <hip/hip_bf16.h>
#include <cmath>
namespace attn_body {
using bf16=__hip_bfloat16;
using bf16x8=__attribute__((ext_vector_type(8)))short;
using s16x4=__attribute__((ext_vector_type(4)))short;
using f32x16=__attribute__((ext_vector_type(16)))float;
using u32x4=__attribute__((ext_vector_type(4)))unsigned;
constexpr int BATCH=2,NHEAD=16,SEQ=8192,D=64,DM=NHEAD*D;
constexpr int NW=8,QBLK=32,QB=QBLK*NW,KVBLK=64,NQB=SEQ/QB;
constexpr int ATTN_PITCH=DM, ATTN_UNIT_ROWS=QB;
__device__ __forceinline__ int crow(int r,int hi){return (r&3)+8*(r>>2)+4*hi;}
#define SBAR() __builtin_amdgcn_sched_barrier(0)
__device__ __forceinline__ void cmask(f32x16&p0,f32x16&p1,int jb,int qrel,int hi){
  const float NEG=-INFINITY; int kb=64*jb+4*hi;
  #pragma unroll
  for(int r=0;r<16;++r){int kv=kb+(r&3)+8*(r>>2); if(kv>qrel)p0[r]=NEG; if(kv+32>qrel)p1[r]=NEG;}
}

constexpr int NSLOT=3, SLOTB=8192;
constexpr int LDS_K=0, LDS_V=NSLOT*SLOTB, LDS_WS=2*NSLOT*SLOTB, LDS_OST=LDS_WS+NW*64*4, LDS_BYTES=LDS_OST+NW*4096;
constexpr float C2=0.125f*1.4426950408889634f;
__device__ __forceinline__ void glds16(const void*gsrc,unsigned lds_dst){unsigned keep;
  asm volatile("s_mov_b32 %0, m0\n\ts_mov_b32 m0, %2\n\ts_nop 0\n\tglobal_load_lds_dwordx4 %1, off\n\ts_mov_b32 m0, %0":"=&s"(keep):"v"(gsrc),"s"(lds_dst):"memory");}
__device__ __forceinline__ float max3f(float a,float b,float c){float r;asm("v_max3_f32 %0, %1, %2, %3":"=v"(r):"v"(a),"v"(b),"v"(c));return r;}
__device__ __forceinline__ float max2f(float a,float b){float r;asm("v_max_f32_e32 %0, %1, %2":"=v"(r):"v"(a),"v"(b));return r;}
__device__ __forceinline__ float fadd_s(float a,float b){float r;asm("v_add_f32_e32 %0, %1, %2":"=v"(r):"v"(a),"v"(b));return r;}
__device__ __forceinline__ float fsub_s(float a,float b){float r;asm("v_sub_f32_e32 %0, %1, %2":"=v"(r):"v"(a),"v"(b));return r;}
typedef float f32x2_t __attribute__((ext_vector_type(2))); typedef __bf16 bf16x2_t __attribute__((ext_vector_type(2)));
__device__ __forceinline__ unsigned cvtpk_s(float lo,float hi){f32x2_t v={lo,hi};bf16x2_t b=__builtin_convertvector(v,bf16x2_t);return __builtin_bit_cast(unsigned,b);}
#define WAIT_BAR(N) asm volatile("s_waitcnt vmcnt(" #N ") lgkmcnt(0)\n\ts_barrier":::"memory")

__device__ __forceinline__ void qkt(f32x16&p0,f32x16&p1,const char*Kslot,const bf16x8*qr,const f32x16&negm,int r32,int hi){
  const char*kb=Kslot+hi*1024+r32*16;
  #pragma unroll
  for(int d0=0;d0<4;++d0){
    const bf16x8 b0=*reinterpret_cast<const bf16x8*>(kb+d0*2048);
    const bf16x8 b1=*reinterpret_cast<const bf16x8*>(kb+d0*2048+512);
    if(d0==0){p0=__builtin_amdgcn_mfma_f32_32x32x16_bf16(b0,qr[0],negm,0,0,0);p1=__builtin_amdgcn_mfma_f32_32x32x16_bf16(b1,qr[0],negm,0,0,0);}
    else{p0=__builtin_amdgcn_mfma_f32_32x32x16_bf16(b0,qr[d0],p0,0,0,0);p1=__builtin_amdgcn_mfma_f32_32x32x16_bf16(b1,qr[d0],p1,0,0,0);}}
}
typedef __attribute__((address_space(3))) const char* lds_cptr;
typedef short v4i16_t __attribute__((ext_vector_type(4)));
__device__ __forceinline__ void kload8(bf16x8*kf,lds_cptr kp){
  kf[0]=*(const __attribute__((address_space(3))) bf16x8*)(kp);      kf[1]=*(const __attribute__((address_space(3))) bf16x8*)(kp+512);
  kf[2]=*(const __attribute__((address_space(3))) bf16x8*)(kp+2048); kf[3]=*(const __attribute__((address_space(3))) bf16x8*)(kp+2560);
  kf[4]=*(const __attribute__((address_space(3))) bf16x8*)(kp+4096); kf[5]=*(const __attribute__((address_space(3))) bf16x8*)(kp+4608);
  kf[6]=*(const __attribute__((address_space(3))) bf16x8*)(kp+6144); kf[7]=*(const __attribute__((address_space(3))) bf16x8*)(kp+6656);
}
__device__ __forceinline__ void kload2(bf16x8*kf,lds_cptr kp,int j){ kf[2*j]=*(const __attribute__((address_space(3))) bf16x8*)(kp+j*2048); kf[2*j+1]=*(const __attribute__((address_space(3))) bf16x8*)(kp+j*2048+512); }
__device__ __forceinline__ s16x4 vtr(lds_cptr p){ return __builtin_bit_cast(s16x4,__builtin_amdgcn_ds_read_tr16_b64_v4i16((__attribute__((address_space(3))) v4i16_t*)p)); }
__device__ __forceinline__ float rowmax(const f32x16&p0,const f32x16&p1){
  float a=max3f(p0[0],p0[1],p1[0]),b=max3f(p0[2],p0[3],p1[1]);a=max3f(a,p1[2],p1[3]);
  #pragma unroll
  for(int r=4;r<16;r+=4){a=max3f(a,p0[r],p0[r+1]);b=max3f(b,p0[r+2],p0[r+3]);a=max3f(a,p1[r],p1[r+1]);b=max3f(b,p1[r+2],p1[r+3]);}
  const float m=max2f(a,b);
  auto rr=__builtin_amdgcn_permlane32_swap(__float_as_uint(m),__float_as_uint(m),false,false);
  return max2f(__uint_as_float(rr[0]),__uint_as_float(rr[1]));
}
__device__ __forceinline__ void pv(f32x16*o,int vb,bf16x8 pa0,bf16x8 pa1,bf16x8 pa2,bf16x8 pa3){
  #pragma unroll
  for(int d0=0;d0<2;++d0){s16x4 lo[4],hi[4];
    #pragma unroll
    for(int ks=0;ks<4;++ks){
      asm volatile("ds_read_b64_tr_b16 %0,%1 offset:%c2":"=&v"(lo[ks]):"v"(vb),"i"(d0*4096+ks*1024):"memory");
      asm volatile("ds_read_b64_tr_b16 %0,%1 offset:%c2":"=&v"(hi[ks]):"v"(vb),"i"(d0*4096+ks*1024+512):"memory");}
    asm volatile("s_waitcnt lgkmcnt(0)":::"memory");SBAR();
    #define PK(k) (bf16x8){lo[k][0],lo[k][1],lo[k][2],lo[k][3],hi[k][0],hi[k][1],hi[k][2],hi[k][3]}
    o[d0]=__builtin_amdgcn_mfma_f32_32x32x16_bf16(pa0,PK(0),o[d0],0,0,0);
    o[d0]=__builtin_amdgcn_mfma_f32_32x32x16_bf16(pa1,PK(1),o[d0],0,0,0);
    o[d0]=__builtin_amdgcn_mfma_f32_32x32x16_bf16(pa2,PK(2),o[d0],0,0,0);
    o[d0]=__builtin_amdgcn_mfma_f32_32x32x16_bf16(pa3,PK(3),o[d0],0,0,0);
    #undef PK
  }
}

#ifndef ATTN_STORE16
#define ATTN_STORE16(p,v) (*(u32x4*)(p)=(v))
#endif
template<int THRL> __device__ __forceinline__ void attn_unit(int b,int h,int qb,int hv,const bf16*Q,const bf16*__restrict__ K,const bf16*__restrict__ V,bf16*O,char*shm){
  const int lane=lane_now(),r32=lane&31,hi=lane>>5; const int wid=wave_now(shm);
  const long rowbase=(long)b*SEQ; const int q0=qb*QB;
  const bf16*Qw=Q+(rowbase+q0+wid*QBLK)*DM+h*D;
  const bf16*Kh=K+rowbase*DM+h*D,*Vh=V+rowbase*DM+hv*D;
  const unsigned lds0=(unsigned)(uintptr_t)shm;
  float*wsf=(float*)(shm+LDS_WS)+wid*64;
  const bf16*ksrc=Kh+(long)lane*DM+wid*8;
  const bf16*vsrc=Vh+(long)(16*(wid&3)+(lane>>2))*DM+(wid>>2)*32+(lane&3)*8;
  const unsigned kdst=lds0+LDS_K+wid*1024, vdst=lds0+LDS_V+wid*1024;
  #define DMA_K(t,slot) glds16(ksrc+(long)(t)*KVBLK*DM,(unsigned)__builtin_amdgcn_readfirstlane(kdst+(slot)))
  #define DMA_V(t,slot) glds16(vsrc+(long)(t)*KVBLK*DM,(unsigned)__builtin_amdgcn_readfirstlane(vdst+(slot)))
  const int vb0=(int)(lds0+LDS_V)+((lane>>4)&1)*32+(lane&3)*8+(4*hi+((lane&15)>>2))*64;
  const char*Kbase=shm+LDS_K; bf16x8 kf[8];
  const lds_cptr shm3=(lds_cptr)shm; const lds_cptr kp0=shm3+LDS_K+hi*1024+r32*16; const lds_cptr vp0=shm3+LDS_V+((lane>>4)&1)*32+(lane&3)*8+(4*hi+((lane&15)>>2))*64;
  const int NT=(q0+QB)/KVBLK;
  DMA_K(0,0);DMA_V(0,0);DMA_K(1,SLOTB);
  bf16x8 qr[4];
  #pragma unroll
  for(int d0=0;d0<4;++d0)qr[d0]=*reinterpret_cast<const bf16x8*>(&Qw[(long)r32*DM+d0*16+hi*8]);
  float mhat=0.f,l_reg=0.f;f32x16 o[2];f32x16 negm; { float zz; asm volatile("v_mov_b32 %0, 0":"=v"(zz)); _Pragma("unroll") for(int r=0;r<16;++r){o[0][r]=zz;o[1][r]=zz;negm[r]=zz;} } asm volatile("":"+v"(negm));
  const int qrel=wid*QBLK+r32;
  #define CMASK(P0,P1,t) do{int jb_=(t)-(NT-4); if(jb_>=0)cmask(P0,P1,jb_,qrel,hi);}while(0)
  bool resc=false;
  #define START(P0,P1) do{ const float rm=rowmax(P0,P1); resc=false; \
    { const float dl=rm; mhat=fadd_s(mhat,dl); \
      _Pragma("unroll") for(int r=0;r<16;++r){P0[r]=fsub_s(P0[r],dl);P1[r]=fsub_s(P1[r],dl);} \
      _Pragma("unroll") for(int r=0;r<16;++r)negm[r]=-mhat; asm volatile("":"+v"(negm)); } \
    _Pragma("unroll") for(int r=0;r<16;++r)P0[r]=__builtin_amdgcn_exp2f(P0[r]); }while(0)
  #define RESC() do{ if(resc){ asm volatile("s_waitcnt lgkmcnt(0)":::"memory"); \
      _Pragma("unroll") for(int d_=0;d_<2;++d_) _Pragma("unroll") for(int r=0;r<16;++r)o[d_][r]*=wsf[crow(r,hi)]; } }while(0)
  f32x16 pA0,pA1,pB0,pB1;
  int sl_prev=0,sl_cur=0,sl_next=SLOTB;
  #define ROT() do{sl_prev=sl_cur;sl_cur=sl_next;sl_next=(sl_next==(NSLOT-1)*SLOTB)?0:sl_next+SLOTB;}while(0)
  DMA_K(2,2*SLOTB);
  WAIT_BAR(3);
  qkt(pA0,pA1,Kbase,qr,negm,r32,hi);asm volatile("s_nop 15\n\ts_nop 7":"+v"(pA0),"+v"(pA1));CMASK(pA0,pA1,0);
  START(pA0,pA1);
  _Pragma("unroll") for(int r=0;r<16;++r)pA1[r]=__builtin_amdgcn_exp2f(pA1[r]);
  WAIT_BAR(0);
  DMA_K(3,0);DMA_V(1,SLOTB);
  ROT();
  kload8(kf,kp0+sl_cur);
  WAIT_BAR(2);
  s16x4 vlo[8],vhi[8]; u32x4 pw0,pw1,pw2,pw3;
  #define PKW(P,B) cvtpk_s(P[B],P[B+1])
  #define PAF(k) __builtin_bit_cast(bf16x8,pw##k)
  #define VFR(i) (bf16x8){vlo[i][0],vlo[i][1],vlo[i][2],vlo[i][3],vhi[i][0],vhi[i][1],vhi[i][2],vhi[i][3]}
  #define PIN(x) asm volatile("":"+v"(x))
  #define MX3(a,b,c) __builtin_fmaxf(__builtin_fmaxf((a),(b)),(c))
  #define GAPA(MF,A0,A1,A2,A3,W0,W1,PW) do{ MF; sacc+=A0; sacc+=A1; sacc+=A2; sacc+=A3; PIN(sacc); W0; W1; PIN(PW); SBAR(); }while(0)
  #define EX(v) __builtin_amdgcn_exp2f(v)
  #define GAPB(MF,X,B) do{ MF; X[B]=EX(X[B]); X[B+1]=EX(X[B+1]); X[B+2]=EX(X[B+2]); X[B+3]=EX(X[B+3]); PIN(X); SBAR(); }while(0)
  #define VRD(i) do{ vlo[i]=vtr(vp_+(((i)>>2)*4096+((i)&3)*1024)); vhi[i]=vtr(vp_+(((i)>>2)*4096+((i)&3)*1024+512)); }while(0)
  #define KRD(G,j) do{ if(G){ kload2(kf,kp0+sl_next,j); SBAR(); } }while(0)
  #define STEP(C0,C1,P0,P1,t,GK,GV,GL) do{ SBAR(); \
    const lds_cptr vp_=vp0+sl_prev; \
    VRD(0); SBAR(); float sacc=(P0[0]+P0[1]); \
    GAPA(C0=__builtin_amdgcn_mfma_f32_32x32x16_bf16(kf[0],qr[0],negm,0,0,0), P0[2],P0[3],P0[4],P0[5],     pw0[0]=PKW(P0,0), pw0[1]=PKW(P0,2), pw0); \
    VRD(4); SBAR(); GAPA(C1=__builtin_amdgcn_mfma_f32_32x32x16_bf16(kf[1],qr[0],negm,0,0,0), P0[6],P0[7],P0[8],P0[9],     pw0[2]=PKW(P0,4), pw0[3]=PKW(P0,6), pw0); \
    VRD(1); SBAR(); GAPA(C0=__builtin_amdgcn_mfma_f32_32x32x16_bf16(kf[2],qr[1],C0,0,0,0),   P0[10],P0[11],P0[12],P0[13], pw1[0]=PKW(P0,8), pw1[1]=PKW(P0,10), pw1); \
    VRD(5); SBAR(); GAPA(C1=__builtin_amdgcn_mfma_f32_32x32x16_bf16(kf[3],qr[1],C1,0,0,0),   P0[14],P0[15],P1[0],P1[1],   pw1[2]=PKW(P0,12),pw1[3]=PKW(P0,14), pw1); \
    VRD(2); SBAR(); GAPA(C0=__builtin_amdgcn_mfma_f32_32x32x16_bf16(kf[4],qr[2],C0,0,0,0),   P1[2],P1[3],P1[4],P1[5],     pw2[0]=PKW(P1,0), pw2[1]=PKW(P1,2), pw2); \
    VRD(6); SBAR(); GAPA(C1=__builtin_amdgcn_mfma_f32_32x32x16_bf16(kf[5],qr[2],C1,0,0,0),   P1[6],P1[7],P1[8],P1[9],     pw2[2]=PKW(P1,4), pw2[3]=PKW(P1,6), pw2); \
    VRD(3); SBAR(); GAPA(C0=__builtin_amdgcn_mfma_f32_32x32x16_bf16(kf[6],qr[3],C0,0,0,0),   P1[10],P1[11],P1[12],P1[13], pw3[0]=PKW(P1,8), pw3[1]=PKW(P1,10), pw3); \
    VRD(7); SBAR(); GAPA(C1=__builtin_amdgcn_mfma_f32_32x32x16_bf16(kf[7],qr[3],C1,0,0,0),   P1[14],P1[15],0.f,0.f,       pw3[2]=PKW(P1,12),pw3[3]=PKW(P1,14), pw3); \
    l_reg+=sacc; \
    if(GK){DMA_K((t)+3,sl_cur);} if(GV){DMA_V((t)+1,sl_next);} \
    CMASK(C0,C1,t); \
    { float a=MX3(C0[0],C0[1],C1[0]),b=MX3(C0[2],C0[3],C1[1]); a=MX3(a,C1[2],C1[3]); \
      _Pragma("unroll") for(int r=4;r<16;r+=4){a=MX3(a,C0[r],C0[r+1]);b=MX3(b,C0[r+2],C0[r+3]);a=MX3(a,C1[r],C1[r+1]);b=MX3(b,C1[r+2],C1[r+3]);} \
      float rm=__builtin_fmaxf(a,b); { auto rr=__builtin_amdgcn_permlane32_swap(__float_as_uint(rm),__float_as_uint(rm),false,false); rm=__builtin_fmaxf(__uint_as_float(rr[0]),__uint_as_float(rr[1])); } \
      resc=false; \
      if(__builtin_expect(__any(rm>(float)THRL),0)){ const float dl=__builtin_fmaxf(rm,0.f); mhat+=dl; \
        _Pragma("unroll") for(int r=0;r<16;++r){C0[r]-=dl;C1[r]-=dl;} \
        _Pragma("unroll") for(int r=0;r<16;++r)negm[r]=-mhat; asm volatile("":"+v"(negm)); \
        const float f=__builtin_amdgcn_exp2f(-dl); l_reg*=f; if(hi==0)wsf[r32]=f; resc=true; } } \
    SBAR(); \
    GAPB(o[0]=__builtin_amdgcn_mfma_f32_32x32x16_bf16(PAF(0),VFR(0),o[0],0,0,0), C0,0); \
    GAPB(o[1]=__builtin_amdgcn_mfma_f32_32x32x16_bf16(PAF(0),VFR(4),o[1],0,0,0), C0,4); \
    KRD(GL,0); GAPB(o[0]=__builtin_amdgcn_mfma_f32_32x32x16_bf16(PAF(1),VFR(1),o[0],0,0,0), C0,8); \
    KRD(GL,1); GAPB(o[1]=__builtin_amdgcn_mfma_f32_32x32x16_bf16(PAF(1),VFR(5),o[1],0,0,0), C0,12); \
    KRD(GL,2); GAPB(o[0]=__builtin_amdgcn_mfma_f32_32x32x16_bf16(PAF(2),VFR(2),o[0],0,0,0), C1,0); \
    KRD(GL,3); GAPB(o[1]=__builtin_amdgcn_mfma_f32_32x32x16_bf16(PAF(2),VFR(6),o[1],0,0,0), C1,4); \
    GAPB(o[0]=__builtin_amdgcn_mfma_f32_32x32x16_bf16(PAF(3),VFR(3),o[0],0,0,0), C1,8); \
    GAPB(o[1]=__builtin_amdgcn_mfma_f32_32x32x16_bf16(PAF(3),VFR(7),o[1],0,0,0), C1,12); \
    }while(0)
  int t=1;
  #undef CMASK
  #define CMASK(P0,P1,t) do{}while(0)
  for(;t+5<NT;t+=2){
    STEP(pB0,pB1,pA0,pA1,t,true,true,true);     WAIT_BAR(2); RESC(); ROT();
    STEP(pA0,pA1,pB0,pB1,t+1,true,true,true);   WAIT_BAR(2); RESC(); ROT();
  }
  #undef CMASK
  #define CMASK(P0,P1,t) do{int jb_=(t)-(NT-4); if(jb_>=0)cmask(P0,P1,jb_,qrel,hi);}while(0)
  #define ENDW(tt) do{ if((tt)+3<NT){WAIT_BAR(2);} else if((tt)+2<NT){WAIT_BAR(1);} else {WAIT_BAR(0);} }while(0)
  for(;t+1<NT;t+=2){
    STEP(pB0,pB1,pA0,pA1,t,(t+3<NT),(t+1<NT),(t+1<NT));       ENDW(t);   RESC(); ROT();
    STEP(pA0,pA1,pB0,pB1,t+1,(t+4<NT),(t+2<NT),(t+2<NT));     ENDW(t+1); RESC(); ROT();
  }
  STEP(pB0,pB1,pA0,pA1,NT-1,false,false,false); RESC();
  { float sacc=pB0[0]+pB0[1]; _Pragma("unroll") for(int r=2;r<16;++r)sacc+=pB0[r]; _Pragma("unroll") for(int r=0;r<16;++r)sacc+=pB1[r]; l_reg+=sacc;
    pw0=(u32x4){PKW(pB0,0),PKW(pB0,2),PKW(pB0,4),PKW(pB0,6)};pw1=(u32x4){PKW(pB0,8),PKW(pB0,10),PKW(pB0,12),PKW(pB0,14)};pw2=(u32x4){PKW(pB1,0),PKW(pB1,2),PKW(pB1,4),PKW(pB1,6)};pw3=(u32x4){PKW(pB1,8),PKW(pB1,10),PKW(pB1,12),PKW(pB1,14)};
    SBAR(); pv(o,vb0+sl_cur,PAF(0),PAF(1),PAF(2),PAF(3)); }
  #undef PKW
  #undef PAF
  #undef VFR
  #undef PIN
  #undef MX3
  #undef GAPA
  #undef GAPB
  #undef EX
  #undef VRD
  #undef KRD
  #undef STEP
  #undef ENDW
  {auto rr=__builtin_amdgcn_permlane32_swap(__float_as_uint(l_reg),__float_as_uint(l_reg),false,false);l_reg=__uint_as_float(rr[0])+__uint_as_float(rr[1]);}
  if(hi==0)wsf[32+r32]=l_reg;asm volatile("s_waitcnt lgkmcnt(0)":::"memory");
  float rli[16];
  #pragma unroll
  for(int r=0;r<16;++r)rli[r]=__builtin_amdgcn_rcpf(wsf[32+crow(r,hi)]);
  bf16*Ow=O+(rowbase+q0+wid*QBLK)*DM+hv*D;
  { bf16*stg=(bf16*)(shm+LDS_OST)+wid*2048;
    #pragma unroll
    for(int r=0;r<16;++r){const int orow=crow(r,hi);
      #pragma unroll
      for(int d0=0;d0<2;++d0)stg[orow*64+d0*32+r32]=__float2bfloat16(o[d0][r]*rli[r]);}
    asm volatile("s_waitcnt lgkmcnt(0)":::"memory");
    #pragma unroll
    for(int i=0;i<4;++i){const int row=i*8+(lane>>3),ch=lane&7; const u32x4 v=*(const u32x4*)(stg+row*64+ch*8); ATTN_STORE16(Ow+(long)row*DM+ch*8,v);} }
  asm volatile("s_waitcnt lgkmcnt(0)\n\ts_barrier":::"memory");
  #undef DMA_K
  #undef DMA_V
  #undef CMASK
  #undef START
  #undef RESC
  #undef ROT
}
constexpr int ATTN_LDS_BYTES=LDS_BYTES;
#undef SBAR
#undef WAIT_BAR
}

namespace attn128 {
using attn_body::bf16; using attn_body::bf16x8; using attn_body::s16x4; using attn_body::f32x16; using attn_body::u32x4;
constexpr int SEQ_ = 8192, DMP = 1024, NW = 8, QBLK = 32, QB = 256, KVBLK = 64;
constexpr int KSLOT = 8192, VSLOT = 16384, NBUF = 3;
constexpr int L_K = 0, L_V = NBUF * KSLOT, L_WS = L_V + NBUF * VSLOT, L_OST = L_WS + NW * 64 * 4, L_BYTES = L_OST + NW * 8192;
#define A128_SBAR() __builtin_amdgcn_sched_barrier(0)
#define A128_WAITL(n) asm volatile("s_waitcnt lgkmcnt(" #n ")" ::: "memory")
__device__ __forceinline__ void pv128(f32x16* o, int vb, bf16x8 pa0, bf16x8 pa1, bf16x8 pa2, bf16x8 pa3) {
    s16x4 lo0, hi0, lo1, hi1, lo2, hi2, lo3, hi3, lo4, hi4;
#define A128_RDF(i, LO, HI) do { asm volatile("ds_read_b64_tr_b16 %0,%1 offset:%c2" : "=&v"(LO) : "v"(vb), "i"(((i) & 3) * 4096 + ((i) >> 2) * 1024) : "memory"); \
                                 asm volatile("ds_read_b64_tr_b16 %0,%1 offset:%c2" : "=&v"(HI) : "v"(vb), "i"(((i) & 3) * 4096 + ((i) >> 2) * 1024 + 512) : "memory"); } while (0)
#define A128_FR(LO, HI) (bf16x8){LO[0], LO[1], LO[2], LO[3], HI[0], HI[1], HI[2], HI[3]}
#define A128_MF(i, PA, LO, HI) o[(i) & 3] = __builtin_amdgcn_mfma_f32_32x32x16_bf16(PA, A128_FR(LO, HI), o[(i) & 3], 0, 0, 0)
    A128_RDF(0, lo0, hi0); A128_RDF(1, lo1, hi1); A128_RDF(2, lo2, hi2); A128_RDF(3, lo3, hi3);
    A128_RDF(4, lo4, hi4); A128_WAITL(8); A128_SBAR(); A128_MF(0, pa0, lo0, hi0);
    A128_RDF(5, lo0, hi0); A128_WAITL(8); A128_SBAR(); A128_MF(1, pa0, lo1, hi1);
    A128_RDF(6, lo1, hi1); A128_WAITL(8); A128_SBAR(); A128_MF(2, pa0, lo2, hi2);
    A128_RDF(7, lo2, hi2); A128_WAITL(8); A128_SBAR(); A128_MF(3, pa0, lo3, hi3);
    A128_RDF(8, lo3, hi3); A128_WAITL(8); A128_SBAR(); A128_MF(4, pa1, lo4, hi4);
    A128_RDF(9, lo4, hi4); A128_WAITL(8); A128_SBAR(); A128_MF(5, pa1, lo0, hi0);
    A128_RDF(10, lo0, hi0); A128_WAITL(8); A128_SBAR(); A128_MF(6, pa1, lo1, hi1);
    A128_RDF(11, lo1, hi1); A128_WAITL(8); A128_SBAR(); A128_MF(7, pa1, lo2, hi2);
    A128_RDF(12, lo2, hi2); A128_WAITL(8); A128_SBAR(); A128_MF(8, pa2, lo3, hi3);
    A128_RDF(13, lo3, hi3); A128_WAITL(8); A128_SBAR(); A128_MF(9, pa2, lo4, hi4);
    A128_RDF(14, lo4, hi4); A128_WAITL(8); A128_SBAR(); A128_MF(10, pa2, lo0, hi0);
    A128_RDF(15, lo0, hi0); A128_WAITL(8); A128_SBAR(); A128_MF(11, pa2, lo1, hi1);
    A128_WAITL(6); A128_SBAR(); A128_MF(12, pa3, lo2, hi2);
    A128_WAITL(4); A128_SBAR(); A128_MF(13, pa3, lo3, hi3);
    A128_WAITL(2); A128_SBAR(); A128_MF(14, pa3, lo4, hi4);
    A128_WAITL(0); A128_SBAR(); A128_MF(15, pa3, lo0, hi0);
#undef A128_RDF
#undef A128_FR
#undef A128_MF
}
__device__ __forceinline__ void qkt128(f32x16& p0, f32x16& p1, int kb, const bf16x8* qr, const f32x16& negm) {
    bf16x8 k0, k1, k2, k3, k4, k5, k6, k7;
#define A128_RDK(K, OFF) asm volatile("ds_read_b128 %0,%1 offset:%c2" : "=&v"(K) : "v"(kb), "i"(OFF) : "memory")
    A128_RDK(k0, 0); A128_RDK(k1, 512); A128_RDK(k2, 2048); A128_RDK(k3, 2560); A128_RDK(k4, 4096); A128_RDK(k5, 4608); A128_RDK(k6, 6144); A128_RDK(k7, 6656);
    A128_WAITL(7); A128_SBAR(); p0 = __builtin_amdgcn_mfma_f32_32x32x16_bf16(k0, qr[0], negm, 0, 0, 0);
    A128_WAITL(6); A128_SBAR(); p1 = __builtin_amdgcn_mfma_f32_32x32x16_bf16(k1, qr[0], negm, 0, 0, 0);
    A128_WAITL(5); A128_SBAR(); p0 = __builtin_amdgcn_mfma_f32_32x32x16_bf16(k2, qr[1], p0, 0, 0, 0);
    A128_WAITL(4); A128_SBAR(); p1 = __builtin_amdgcn_mfma_f32_32x32x16_bf16(k3, qr[1], p1, 0, 0, 0);
    A128_WAITL(3); A128_SBAR(); p0 = __builtin_amdgcn_mfma_f32_32x32x16_bf16(k4, qr[2], p0, 0, 0, 0);
    A128_WAITL(2); A128_SBAR(); p1 = __builtin_amdgcn_mfma_f32_32x32x16_bf16(k5, qr[2], p1, 0, 0, 0);
    A128_WAITL(1); A128_SBAR(); p0 = __builtin_amdgcn_mfma_f32_32x32x16_bf16(k6, qr[3], p0, 0, 0, 0);
    A128_WAITL(0); A128_SBAR(); p1 = __builtin_amdgcn_mfma_f32_32x32x16_bf16(k7, qr[3], p1, 0, 0, 0);
#undef A128_RDK
    asm volatile("s_nop 15\n\ts_nop 7" : "+v"(p0), "+v"(p1));
}
constexpr int NB2 = 4, L2_K = 0, L2_V = NB2 * KSLOT, L2_WS = L2_V + NB2 * VSLOT, L2_OST = L2_WS + NW * 64 * 4, L2_BYTES = L2_OST + NW * 4096;
template <int THRL> __device__ __forceinline__ void unit2(int b, int hq, int hv, int qb, const bf16* Q, const bf16* __restrict__ K, const bf16* __restrict__ V, bf16* O, char* shm, volatile __attribute__((address_space(3))) unsigned* PRB = nullptr) {
    const int tid = threadIdx.x; int lane = tid & 63; asm volatile("" : "+v"(lane));
    const int r32 = lane & 31, hi = lane >> 5; const int wid = __builtin_amdgcn_readfirstlane(tid >> 6);
    const long rowbase = (long)b * SEQ_; const int q0 = qb * QB;
    const bf16* Qw = Q + (rowbase + q0 + wid * QBLK) * DMP + hq * 64;
    const bf16* Kh = K + rowbase * DMP + hq * 64, * Vh = V + rowbase * DMP + hv * 64;
    const unsigned lds0 = (unsigned)(uintptr_t)shm;
    float* wsf = (float*)(shm + L2_WS) + wid * 64;
    const bf16* ksrc = Kh + (long)lane * DMP + wid * 8;
    const bf16* vsrc = Vh + (long)(16 * (wid & 3) + (lane >> 2)) * DMP + (wid >> 2) * 32 + (lane & 3) * 8;
    const unsigned kdst = lds0 + L2_K + wid * 1024, vdst = lds0 + L2_V + wid * 1024;
#define A128_DMAK(t) attn_body::glds16(ksrc + (long)(t) * KVBLK * DMP, (unsigned)__builtin_amdgcn_readfirstlane(kdst + ((t) & 3) * KSLOT))
#define A128_DMAV(t) do { attn_body::glds16(vsrc + (long)(t) * KVBLK * DMP, (unsigned)__builtin_amdgcn_readfirstlane(vdst + ((t) & 3) * VSLOT)); \
        attn_body::glds16(vsrc + (long)(t) * KVBLK * DMP + 64, (unsigned)__builtin_amdgcn_readfirstlane(vdst + ((t) & 3) * VSLOT + 8192)); } while (0)
    const int vb0 = (int)(lds0 + L2_V) + ((lane >> 4) & 1) * 32 + (lane & 3) * 8 + (4 * hi + ((lane & 15) >> 2)) * 64;
    const int kb0 = (int)(lds0 + L2_K) + hi * 1024 + r32 * 16;
    const int NT = (q0 + QB) / KVBLK;
    A128_DMAK(0); A128_DMAV(0); A128_DMAK(1); A128_DMAV(1); A128_DMAK(2);
    bf16x8 qr[4];
#pragma unroll
    for (int d0 = 0; d0 < 4; ++d0) qr[d0] = *reinterpret_cast<const bf16x8*>(&Qw[(long)r32 * DMP + d0 * 16 + hi * 8]);
    float mhat = 0.f, l_reg = 0.f; f32x16 o[4]; f32x16 negm;
    { float zz; asm volatile("v_mov_b32 %0, 0" : "=v"(zz));
#pragma unroll
      for (int r = 0; r < 16; ++r) { o[0][r] = zz; o[1][r] = zz; o[2][r] = zz; o[3][r] = zz; negm[r] = zz; } }
    const int qrel = wid * QBLK + r32;
    asm volatile("s_waitcnt vmcnt(0) lgkmcnt(0)\n\ts_barrier" ::: "memory");
    u32x4 pw0, pw1, pw2, pw3;
#define A128_ROWMAX(rm) do { float a = fmaxf(fmaxf(c0[0], c0[1]), c1[0]), bb = fmaxf(fmaxf(c0[2], c0[3]), c1[1]); a = fmaxf(fmaxf(a, c1[2]), c1[3]);                    \
          _Pragma("unroll") for (int r = 4; r < 16; r += 4) { a = fmaxf(fmaxf(a, c0[r]), c0[r + 1]); bb = fmaxf(fmaxf(bb, c0[r + 2]), c0[r + 3]); a = fmaxf(fmaxf(a, c1[r]), c1[r + 1]); bb = fmaxf(fmaxf(bb, c1[r + 2]), c1[r + 3]); } \
          rm = fmaxf(a, bb); auto rr = __builtin_amdgcn_permlane32_swap(__float_as_uint(rm), __float_as_uint(rm), false, false); rm = fmaxf(__uint_as_float(rr[0]), __uint_as_float(rr[1])); } while (0)
    { A128_DMAK(3); A128_DMAV(2);
      f32x16 c0, c1; qkt128(c0, c1, kb0, qr, negm);
      { const int jb = 0 - (NT - 4); if (jb >= 0) attn_body::cmask(c0, c1, jb, qrel, hi); }
      float rm; A128_ROWMAX(rm); mhat = rm;
#pragma unroll
      for (int r = 0; r < 16; ++r) { c0[r] -= rm; c1[r] -= rm; negm[r] = -mhat; }
      float sacc = 0.f;
#pragma unroll
      for (int r = 0; r < 16; ++r) { c0[r] = __builtin_amdgcn_exp2f(c0[r]); c1[r] = __builtin_amdgcn_exp2f(c1[r]); }
#pragma unroll
      for (int r = 0; r < 16; ++r) sacc += c0[r] + c1[r];
      l_reg += sacc;
#define A128_PKW(P, B) attn_body::cvtpk_s(P[B], P[B + 1])
      pw0 = (u32x4){A128_PKW(c0, 0), A128_PKW(c0, 2), A128_PKW(c0, 4), A128_PKW(c0, 6)}; pw1 = (u32x4){A128_PKW(c0, 8), A128_PKW(c0, 10), A128_PKW(c0, 12), A128_PKW(c0, 14)};
      pw2 = (u32x4){A128_PKW(c1, 0), A128_PKW(c1, 2), A128_PKW(c1, 4), A128_PKW(c1, 6)}; pw3 = (u32x4){A128_PKW(c1, 8), A128_PKW(c1, 10), A128_PKW(c1, 12), A128_PKW(c1, 14)};
#undef A128_PKW
      asm volatile("s_waitcnt vmcnt(3) lgkmcnt(0)\n\ts_barrier" ::: "memory"); }
#define A128_RDF(i, LO, HI) do { asm volatile("ds_read_b64_tr_b16 %0,%1 offset:%c2" : "=&v"(LO) : "v"(vb), "i"(((i) >> 2) * 4096 + ((i) & 3) * 1024) : "memory"); \
                                 asm volatile("ds_read_b64_tr_b16 %0,%1 offset:%c2" : "=&v"(HI) : "v"(vb), "i"(((i) >> 2) * 4096 + ((i) & 3) * 1024 + 512) : "memory"); } while (0)
#define A128_FR(LO, HI) (bf16x8){LO[0], LO[1], LO[2], LO[3], HI[0], HI[1], HI[2], HI[3]}
#define A128_MF(i, PA, LO, HI) o[(i) >> 2] = __builtin_amdgcn_mfma_f32_32x32x16_bf16(PA, A128_FR(LO, HI), o[(i) >> 2], 0, 0, 0)
    PRB_B(36, PRB); PRBC_B(41, PRB);
    for (int t = 1; t < NT; ++t) {
        if (t + 3 < NT) A128_DMAK(t + 3);
        if (t + 2 < NT) A128_DMAV(t + 2);
        const bf16x8 pa0 = __builtin_bit_cast(bf16x8, pw0), pa1 = __builtin_bit_cast(bf16x8, pw1), pa2 = __builtin_bit_cast(bf16x8, pw2), pa3 = __builtin_bit_cast(bf16x8, pw3);
        u32x4 pn0, pn1, pn2, pn3; float sacc = 0.f; bool resc = false;
        const int vb = vb0 + ((t - 1) & 3) * VSLOT;
        s16x4 lo0, hi0, lo1, hi1, lo2, hi2, lo3, hi3, lo4, hi4;
        A128_RDF(0, lo0, hi0); A128_RDF(1, lo1, hi1); A128_RDF(2, lo2, hi2); A128_RDF(3, lo3, hi3);
        f32x16 c0, c1; qkt128(c0, c1, kb0 + (t & 3) * KSLOT, qr, negm);
        { const int jb = t - (NT - 4); if (__builtin_expect(jb >= 0, 0)) { asm volatile("" ::: "memory"); attn_body::cmask(c0, c1, jb, qrel, hi); } }
        float rmA, rmB, rm;
        A128_RDF(4, lo4, hi4); A128_WAITL(8); A128_SBAR(); A128_MF(0, pa0, lo0, hi0); rmA = fmaxf(fmaxf(c0[0], c0[1]), c1[0]); rmB = fmaxf(fmaxf(c0[2], c0[3]), c1[1]); rmA = fmaxf(fmaxf(rmA, c1[2]), c1[3]); rmA = fmaxf(fmaxf(rmA, c0[4]), c0[5]); rmB = fmaxf(fmaxf(rmB, c0[6]), c0[7]); asm volatile("" : "+v"(rmA), "+v"(rmB)); A128_SBAR();
        A128_RDF(5, lo0, hi0); A128_WAITL(8); A128_SBAR(); A128_MF(1, pa1, lo1, hi1); rmA = fmaxf(fmaxf(rmA, c1[4]), c1[5]); rmB = fmaxf(fmaxf(rmB, c1[6]), c1[7]); rmA = fmaxf(fmaxf(rmA, c0[8]), c0[9]); rmB = fmaxf(fmaxf(rmB, c0[10]), c0[11]); rmA = fmaxf(fmaxf(rmA, c1[8]), c1[9]); asm volatile("" : "+v"(rmA), "+v"(rmB)); A128_SBAR();
        A128_RDF(6, lo1, hi1); A128_WAITL(8); A128_SBAR(); A128_MF(2, pa2, lo2, hi2); rmB = fmaxf(fmaxf(rmB, c1[10]), c1[11]); rmA = fmaxf(fmaxf(rmA, c0[12]), c0[13]); rmB = fmaxf(fmaxf(rmB, c0[14]), c0[15]); rmA = fmaxf(fmaxf(rmA, c1[12]), c1[13]); rmB = fmaxf(fmaxf(rmB, c1[14]), c1[15]); asm volatile("" : "+v"(rmA), "+v"(rmB)); A128_SBAR();
        A128_RDF(7, lo2, hi2); A128_WAITL(8); A128_SBAR(); A128_MF(3, pa3, lo3, hi3); rm = fmaxf(rmA, rmB); { auto rr = __builtin_amdgcn_permlane32_swap(__float_as_uint(rm), __float_as_uint(rm), false, false); rm = fmaxf(__uint_as_float(rr[0]), __uint_as_float(rr[1])); } asm volatile("" : "+v"(rm)); A128_SBAR();
        if (__builtin_expect(__any(rm > (float)THRL), 0)) {
            const float dl = fmaxf(rm, 0.f); mhat += dl;
#pragma unroll
            for (int r = 0; r < 16; ++r) { c0[r] -= dl; c1[r] -= dl; negm[r] = -mhat; }
            const float f = __builtin_amdgcn_exp2f(-dl); l_reg *= f; if (hi == 0) wsf[r32] = f; resc = true; asm volatile("s_waitcnt lgkmcnt(0)" ::: "memory"); }
        A128_RDF(8, lo3, hi3); A128_WAITL(8); A128_SBAR(); A128_MF(4, pa0, lo4, hi4); { const float e0_ = __builtin_amdgcn_exp2f(c0[0]), e1_ = __builtin_amdgcn_exp2f(c0[1]); sacc += e0_; sacc += e1_; pn0[0] = attn_body::cvtpk_s(e0_, e1_); asm volatile("" : "+v"(sacc), "+v"(pn0)); } { const float e0_ = __builtin_amdgcn_exp2f(c0[2]), e1_ = __builtin_amdgcn_exp2f(c0[3]); sacc += e0_; sacc += e1_; pn0[1] = attn_body::cvtpk_s(e0_, e1_); asm volatile("" : "+v"(sacc), "+v"(pn0)); } A128_SBAR();
        A128_RDF(9, lo4, hi4); A128_WAITL(8); A128_SBAR(); A128_MF(5, pa1, lo0, hi0); { const float e0_ = __builtin_amdgcn_exp2f(c0[4]), e1_ = __builtin_amdgcn_exp2f(c0[5]); sacc += e0_; sacc += e1_; pn0[2] = attn_body::cvtpk_s(e0_, e1_); asm volatile("" : "+v"(sacc), "+v"(pn0)); } A128_SBAR();
        A128_RDF(10, lo0, hi0); A128_WAITL(8); A128_SBAR(); A128_MF(6, pa2, lo1, hi1); { const float e0_ = __builtin_amdgcn_exp2f(c0[6]), e1_ = __builtin_amdgcn_exp2f(c0[7]); sacc += e0_; sacc += e1_; pn0[3] = attn_body::cvtpk_s(e0_, e1_); asm volatile("" : "+v"(sacc), "+v"(pn0)); } A128_SBAR();
        A128_RDF(11, lo1, hi1); A128_WAITL(8); A128_SBAR(); A128_MF(7, pa3, lo2, hi2); { const float e0_ = __builtin_amdgcn_exp2f(c0[8]), e1_ = __builtin_amdgcn_exp2f(c0[9]); sacc += e0_; sacc += e1_; pn1[0] = attn_body::cvtpk_s(e0_, e1_); asm volatile("" : "+v"(sacc), "+v"(pn1)); } { const float e0_ = __builtin_amdgcn_exp2f(c0[10]), e1_ = __builtin_amdgcn_exp2f(c0[11]); sacc += e0_; sacc += e1_; pn1[1] = attn_body::cvtpk_s(e0_, e1_); asm volatile("" : "+v"(sacc), "+v"(pn1)); } A128_SBAR();
        A128_RDF(12, lo2, hi2); A128_WAITL(8); A128_SBAR(); A128_MF(8, pa0, lo3, hi3); { const float e0_ = __builtin_amdgcn_exp2f(c0[12]), e1_ = __builtin_amdgcn_exp2f(c0[13]); sacc += e0_; sacc += e1_; pn1[2] = attn_body::cvtpk_s(e0_, e1_); asm volatile("" : "+v"(sacc), "+v"(pn1)); } A128_SBAR();
        A128_RDF(13, lo3, hi3); A128_WAITL(8); A128_SBAR(); A128_MF(9, pa1, lo4, hi4); { const float e0_ = __builtin_amdgcn_exp2f(c0[14]), e1_ = __builtin_amdgcn_exp2f(c0[15]); sacc += e0_; sacc += e1_; pn1[3] = attn_body::cvtpk_s(e0_, e1_); asm volatile("" : "+v"(sacc), "+v"(pn1)); } A128_SBAR();
        A128_RDF(14, lo4, hi4); A128_WAITL(8); A128_SBAR(); A128_MF(10, pa2, lo0, hi0); { const float e0_ = __builtin_amdgcn_exp2f(c1[0]), e1_ = __builtin_amdgcn_exp2f(c1[1]); sacc += e0_; sacc += e1_; pn2[0] = attn_body::cvtpk_s(e0_, e1_); asm volatile("" : "+v"(sacc), "+v"(pn2)); } { const float e0_ = __builtin_amdgcn_exp2f(c1[2]), e1_ = __builtin_amdgcn_exp2f(c1[3]); sacc += e0_; sacc += e1_; pn2[1] = attn_body::cvtpk_s(e0_, e1_); asm volatile("" : "+v"(sacc), "+v"(pn2)); } A128_SBAR();
        A128_RDF(15, lo0, hi0); A128_WAITL(8); A128_SBAR(); A128_MF(11, pa3, lo1, hi1); { const float e0_ = __builtin_amdgcn_exp2f(c1[4]), e1_ = __builtin_amdgcn_exp2f(c1[5]); sacc += e0_; sacc += e1_; pn2[2] = attn_body::cvtpk_s(e0_, e1_); asm volatile("" : "+v"(sacc), "+v"(pn2)); } A128_SBAR();
        A128_WAITL(6); A128_SBAR(); A128_MF(12, pa0, lo2, hi2); { const float e0_ = __builtin_amdgcn_exp2f(c1[6]), e1_ = __builtin_amdgcn_exp2f(c1[7]); sacc += e0_; sacc += e1_; pn2[3] = attn_body::cvtpk_s(e0_, e1_); asm volatile("" : "+v"(sacc), "+v"(pn2)); } A128_SBAR();
        A128_WAITL(4); A128_SBAR(); A128_MF(13, pa1, lo3, hi3); { const float e0_ = __builtin_amdgcn_exp2f(c1[8]), e1_ = __builtin_amdgcn_exp2f(c1[9]); sacc += e0_; sacc += e1_; pn3[0] = attn_body::cvtpk_s(e0_, e1_); asm volatile("" : "+v"(sacc), "+v"(pn3)); } { const float e0_ = __builtin_amdgcn_exp2f(c1[10]), e1_ = __builtin_amdgcn_exp2f(c1[11]); sacc += e0_; sacc += e1_; pn3[1] = attn_body::cvtpk_s(e0_, e1_); asm volatile("" : "+v"(sacc), "+v"(pn3)); } A128_SBAR();
        A128_WAITL(2); A128_SBAR(); A128_MF(14, pa2, lo4, hi4); { const float e0_ = __builtin_amdgcn_exp2f(c1[12]), e1_ = __builtin_amdgcn_exp2f(c1[13]); sacc += e0_; sacc += e1_; pn3[2] = attn_body::cvtpk_s(e0_, e1_); asm volatile("" : "+v"(sacc), "+v"(pn3)); } A128_SBAR();
        A128_WAITL(0); A128_SBAR(); A128_MF(15, pa3, lo0, hi0); { const float e0_ = __builtin_amdgcn_exp2f(c1[14]), e1_ = __builtin_amdgcn_exp2f(c1[15]); sacc += e0_; sacc += e1_; pn3[3] = attn_body::cvtpk_s(e0_, e1_); asm volatile("" : "+v"(sacc), "+v"(pn3)); } A128_SBAR();
        l_reg += sacc;
        if (resc) { asm volatile("s_waitcnt lgkmcnt(0)" ::: "memory");
#pragma unroll
            for (int r = 0; r < 16; ++r) { const float fr = wsf[attn_body::crow(r, hi)]; o[0][r] *= fr; o[1][r] *= fr; o[2][r] *= fr; o[3][r] *= fr; } }
        pw0 = pn0; pw1 = pn1; pw2 = pn2; pw3 = pn3;
        if (t + 3 < NT) asm volatile("s_waitcnt vmcnt(6) lgkmcnt(0)\n\ts_barrier" ::: "memory");
        else if (t + 2 < NT) asm volatile("s_waitcnt vmcnt(5) lgkmcnt(0)\n\ts_barrier" ::: "memory");
        else if (t + 1 < NT) asm volatile("s_waitcnt vmcnt(2) lgkmcnt(0)\n\ts_barrier" ::: "memory");
        else asm volatile("s_waitcnt vmcnt(0) lgkmcnt(0)\n\ts_barrier" ::: "memory");
    }
    PRB_E(36, PRB); PRBC_E(41, PRB);
#undef A128_RDF
#undef A128_FR
#undef A128_MF
    pv128(o, vb0 + ((NT - 1) & 3) * VSLOT, __builtin_bit_cast(bf16x8, pw0), __builtin_bit_cast(bf16x8, pw1), __builtin_bit_cast(bf16x8, pw2), __builtin_bit_cast(bf16x8, pw3));
    { auto rr = __builtin_amdgcn_permlane32_swap(__float_as_uint(l_reg), __float_as_uint(l_reg), false, false); l_reg = __uint_as_float(rr[0]) + __uint_as_float(rr[1]); }
    int lne = lane; asm volatile("" : "+v"(lne));
    const int r32e = lne & 31, hie = lne >> 5;
    if (hie == 0) wsf[32 + r32e] = l_reg; asm volatile("s_waitcnt lgkmcnt(0)" ::: "memory");
    float rli[16];
#pragma unroll
    for (int r = 0; r < 16; ++r) rli[r] = __builtin_amdgcn_rcpf(wsf[32 + attn_body::crow(r, hie)]);
    bf16* Ow = O + (rowbase + q0 + wid * QBLK) * DMP + hv * 64;
    { bf16* stg = (bf16*)(shm + L2_OST) + wid * 2048;
#pragma unroll
      for (int half = 0; half < 2; ++half) {
#pragma unroll
          for (int r = 0; r < 16; ++r) { const int orow = attn_body::crow(r, hie);
#pragma unroll
              for (int d0 = 0; d0 < 2; ++d0) stg[orow * 64 + d0 * 32 + r32e] = __float2bfloat16(o[2 * half + d0][r] * rli[r]); }
          asm volatile("s_waitcnt lgkmcnt(0)" ::: "memory");
#pragma unroll
          for (int i = 0; i < 4; ++i) { const int row = i * 8 + (lne >> 3), ch = lne & 7; const u32x4 v = *(const u32x4*)(stg + row * 64 + ch * 8); *(u32x4*)(Ow + (long)row * DMP + half * 64 + ch * 8) = v; }
          asm volatile("s_waitcnt lgkmcnt(0)" ::: "memory"); } }
    asm volatile("s_waitcnt lgkmcnt(0)\n\ts_barrier" ::: "memory");
#undef A128_DMAK
#undef A128_DMAV
#undef A128_ROWMAX
}
constexpr int NB3_ = 4;
template <int THRL> __device__ __forceinline__ void unit3(int b, int hq, int hv, int qb, const bf16* Q, const bf16* __restrict__ K, const bf16* __restrict__ V, bf16* O, char* shm) {
    const int tid = threadIdx.x; int lane = tid & 63; asm volatile("" : "+v"(lane));
    const int r32 = lane & 31, hi = lane >> 5; const int wid = __builtin_amdgcn_readfirstlane(tid >> 6);
    const long rowbase = (long)b * SEQ_; const int q0 = qb * QB;
    const bf16* Qw = Q + (rowbase + q0 + wid * QBLK) * DMP + hq * 64;
    const bf16* Kh = K + rowbase * DMP + hq * 64, * Vh = V + rowbase * DMP + hv * 64;
    const unsigned lds0 = (unsigned)(uintptr_t)shm;
    float* wsf = (float*)(shm + L2_WS) + wid * 64;
    const bf16* ksrc = Kh + (long)lane * DMP + wid * 8;
    const bf16* vsrc = Vh + (long)(16 * (wid & 3) + (lane >> 2)) * DMP + (wid >> 2) * 32 + (lane & 3) * 8;
    const unsigned kdst = lds0 + L2_K + wid * 1024, vdst = lds0 + L2_V + wid * 1024;
#define A128_DMAK(t) attn_body::glds16(ksrc + (long)(t) * KVBLK * DMP, (unsigned)__builtin_amdgcn_readfirstlane(kdst + ((t) & 3) * KSLOT))
#define A128_DMAV(t) do { attn_body::glds16(vsrc + (long)(t) * KVBLK * DMP, (unsigned)__builtin_amdgcn_readfirstlane(vdst + ((t) & 3) * VSLOT)); \
        attn_body::glds16(vsrc + (long)(t) * KVBLK * DMP + 64, (unsigned)__builtin_amdgcn_readfirstlane(vdst + ((t) & 3) * VSLOT + 8192)); } while (0)
    const int vb0 = (int)(lds0 + L2_V) + ((lane >> 4) & 1) * 32 + (lane & 3) * 8 + (4 * hi + ((lane & 15) >> 2)) * 64;
    const int kb0 = (int)(lds0 + L2_K) + hi * 1024 + r32 * 16;
    const int NT = (q0 + QB) / KVBLK;
    A128_DMAV(0); A128_DMAK(0); A128_DMAK(1); A128_DMAK(2);
    bf16x8 qr[4];
#pragma unroll
    for (int d0 = 0; d0 < 4; ++d0) qr[d0] = *reinterpret_cast<const bf16x8*>(&Qw[(long)r32 * DMP + d0 * 16 + hi * 8]);
    float mhat = 0.f, l_reg = 0.f; f32x16 o[4]; f32x16 negm;
    { float zz; asm volatile("v_mov_b32 %0, 0" : "=v"(zz));
#pragma unroll
      for (int r = 0; r < 16; ++r) { o[0][r] = zz; o[1][r] = zz; o[2][r] = zz; o[3][r] = zz; negm[r] = zz; } }
    const int qrel = wid * QBLK + r32;
    asm volatile("s_waitcnt vmcnt(0) lgkmcnt(0)\n\ts_barrier" ::: "memory");
    u32x4 pw0, pw1, pw2, pw3;
#define A128_ROWMAX(rm) do { float a = fmaxf(fmaxf(c0[0], c0[1]), c1[0]), bb = fmaxf(fmaxf(c0[2], c0[3]), c1[1]); a = fmaxf(fmaxf(a, c1[2]), c1[3]);                    \
          _Pragma("unroll") for (int r = 4; r < 16; r += 4) { a = fmaxf(fmaxf(a, c0[r]), c0[r + 1]); bb = fmaxf(fmaxf(bb, c0[r + 2]), c0[r + 3]); a = fmaxf(fmaxf(a, c1[r]), c1[r + 1]); bb = fmaxf(fmaxf(bb, c1[r + 2]), c1[r + 3]); } \
          rm = fmaxf(a, bb); auto rr = __builtin_amdgcn_permlane32_swap(__float_as_uint(rm), __float_as_uint(rm), false, false); rm = fmaxf(__uint_as_float(rr[0]), __uint_as_float(rr[1])); } while (0)
    f32x16 c0, c1; bool resc = false;
#define A128_PKW(P, B) attn_body::cvtpk_s(P[B], P[B + 1])
#define A128_RDF(i, LO, HI) do { asm volatile("ds_read_b64_tr_b16 %0,%1 offset:%c2" : "=&v"(LO) : "v"(vb), "i"(((i) >> 2) * 4096 + ((i) & 3) * 1024) : "memory"); \
                                 asm volatile("ds_read_b64_tr_b16 %0,%1 offset:%c2" : "=&v"(HI) : "v"(vb), "i"(((i) >> 2) * 4096 + ((i) & 3) * 1024 + 512) : "memory"); } while (0)
#define A128_FR(LO, HI) (bf16x8){LO[0], LO[1], LO[2], LO[3], HI[0], HI[1], HI[2], HI[3]}
#define A128_MF(i, PA, LO, HI) o[(i) >> 2] = __builtin_amdgcn_mfma_f32_32x32x16_bf16(PA, A128_FR(LO, HI), o[(i) >> 2], 0, 0, 0)
#define A128_H1(t) do { qkt128(c0, c1, kb0 + ((t) & 3) * KSLOT, qr, negm);                                                                        \
        { const int jb = (t) - (NT - 4); if (__builtin_expect(jb >= 0, 0)) { asm volatile("" ::: "memory"); attn_body::cmask(c0, c1, jb, qrel, hi); } } \
        float rm; A128_ROWMAX(rm); resc = false;                                                                                                  \
        if ((t) == 0) { mhat = rm; _Pragma("unroll") for (int r = 0; r < 16; ++r) { c0[r] -= rm; c1[r] -= rm; negm[r] = -mhat; } }               \
        else if (__builtin_expect(__any(rm > (float)THRL), 0)) { const float dl = fmaxf(rm, 0.f); mhat += dl;                                     \
            _Pragma("unroll") for (int r = 0; r < 16; ++r) { c0[r] -= dl; c1[r] -= dl; negm[r] = -mhat; }                                         \
            const float f = __builtin_amdgcn_exp2f(-dl); l_reg *= f; if (hi == 0) wsf[r32] = f; resc = true; } } while (0)
#define A128_H2_0() do { float sacc = 0.f;                                                                                                          \
        _Pragma("unroll") for (int r = 0; r < 16; ++r) { c0[r] = __builtin_amdgcn_exp2f(c0[r]); c1[r] = __builtin_amdgcn_exp2f(c1[r]); }          \
        _Pragma("unroll") for (int r = 0; r < 16; ++r) sacc += c0[r] + c1[r];                                                                     \
        l_reg += sacc;                                                                                                                            \
        pw0 = (u32x4){A128_PKW(c0, 0), A128_PKW(c0, 2), A128_PKW(c0, 4), A128_PKW(c0, 6)}; pw1 = (u32x4){A128_PKW(c0, 8), A128_PKW(c0, 10), A128_PKW(c0, 12), A128_PKW(c0, 14)}; \
        pw2 = (u32x4){A128_PKW(c1, 0), A128_PKW(c1, 2), A128_PKW(c1, 4), A128_PKW(c1, 6)}; pw3 = (u32x4){A128_PKW(c1, 8), A128_PKW(c1, 10), A128_PKW(c1, 12), A128_PKW(c1, 14)}; } while (0)
#define A128_H2(t) do { const bf16x8 pa0 = __builtin_bit_cast(bf16x8, pw0), pa1 = __builtin_bit_cast(bf16x8, pw1), pa2 = __builtin_bit_cast(bf16x8, pw2), pa3 = __builtin_bit_cast(bf16x8, pw3); \
        u32x4 pn0, pn1, pn2, pn3; float sacc = 0.f; const int vb = vb0 + (((t) - 1) & 3) * VSLOT;                                                 \
        s16x4 lo0, hi0, lo1, hi1, lo2, hi2, lo3, hi3, lo4, hi4; A128_SBAR();                                                                      \
        A128_RDF(0, lo0, hi0); A128_RDF(1, lo1, hi1); A128_RDF(2, lo2, hi2); A128_RDF(3, lo3, hi3); \
        A128_RDF(4, lo4, hi4); A128_WAITL(8); A128_SBAR(); A128_MF(0, pa0, lo0, hi0); { const float e0_ = __builtin_amdgcn_exp2f(c0[0]), e1_ = __builtin_amdgcn_exp2f(c0[1]); sacc += e0_; sacc += e1_; pn0[0] = attn_body::cvtpk_s(e0_, e1_); asm volatile("" : "+v"(sacc), "+v"(pn0)); } A128_SBAR(); \
        A128_RDF(5, lo0, hi0); A128_WAITL(8); A128_SBAR(); A128_MF(1, pa1, lo1, hi1); { const float e0_ = __builtin_amdgcn_exp2f(c0[2]), e1_ = __builtin_amdgcn_exp2f(c0[3]); sacc += e0_; sacc += e1_; pn0[1] = attn_body::cvtpk_s(e0_, e1_); asm volatile("" : "+v"(sacc), "+v"(pn0)); } A128_SBAR(); \
        A128_RDF(6, lo1, hi1); A128_WAITL(8); A128_SBAR(); A128_MF(2, pa2, lo2, hi2); { const float e0_ = __builtin_amdgcn_exp2f(c0[4]), e1_ = __builtin_amdgcn_exp2f(c0[5]); sacc += e0_; sacc += e1_; pn0[2] = attn_body::cvtpk_s(e0_, e1_); asm volatile("" : "+v"(sacc), "+v"(pn0)); } A128_SBAR(); \
        A128_RDF(7, lo2, hi2); A128_WAITL(8); A128_SBAR(); A128_MF(3, pa3, lo3, hi3); { const float e0_ = __builtin_amdgcn_exp2f(c0[6]), e1_ = __builtin_amdgcn_exp2f(c0[7]); sacc += e0_; sacc += e1_; pn0[3] = attn_body::cvtpk_s(e0_, e1_); asm volatile("" : "+v"(sacc), "+v"(pn0)); } A128_SBAR(); \
        A128_RDF(8, lo3, hi3); A128_WAITL(8); A128_SBAR(); A128_MF(4, pa0, lo4, hi4); { const float e0_ = __builtin_amdgcn_exp2f(c0[8]), e1_ = __builtin_amdgcn_exp2f(c0[9]); sacc += e0_; sacc += e1_; pn1[0] = attn_body::cvtpk_s(e0_, e1_); asm volatile("" : "+v"(sacc), "+v"(pn1)); } A128_SBAR(); \
        A128_RDF(9, lo4, hi4); A128_WAITL(8); A128_SBAR(); A128_MF(5, pa1, lo0, hi0); { const float e0_ = __builtin_amdgcn_exp2f(c0[10]), e1_ = __builtin_amdgcn_exp2f(c0[11]); sacc += e0_; sacc += e1_; pn1[1] = attn_body::cvtpk_s(e0_, e1_); asm volatile("" : "+v"(sacc), "+v"(pn1)); } A128_SBAR(); \
        A128_RDF(10, lo0, hi0); A128_WAITL(8); A128_SBAR(); A128_MF(6, pa2, lo1, hi1); { const float e0_ = __builtin_amdgcn_exp2f(c0[12]), e1_ = __builtin_amdgcn_exp2f(c0[13]); sacc += e0_; sacc += e1_; pn1[2] = attn_body::cvtpk_s(e0_, e1_); asm volatile("" : "+v"(sacc), "+v"(pn1)); } A128_SBAR(); \
        A128_RDF(11, lo1, hi1); A128_WAITL(8); A128_SBAR(); A128_MF(7, pa3, lo2, hi2); { const float e0_ = __builtin_amdgcn_exp2f(c0[14]), e1_ = __builtin_amdgcn_exp2f(c0[15]); sacc += e0_; sacc += e1_; pn1[3] = attn_body::cvtpk_s(e0_, e1_); asm volatile("" : "+v"(sacc), "+v"(pn1)); } A128_SBAR(); \
        A128_RDF(12, lo2, hi2); A128_WAITL(8); A128_SBAR(); A128_MF(8, pa0, lo3, hi3); { const float e0_ = __builtin_amdgcn_exp2f(c1[0]), e1_ = __builtin_amdgcn_exp2f(c1[1]); sacc += e0_; sacc += e1_; pn2[0] = attn_body::cvtpk_s(e0_, e1_); asm volatile("" : "+v"(sacc), "+v"(pn2)); } A128_SBAR(); \
        A128_RDF(13, lo3, hi3); A128_WAITL(8); A128_SBAR(); A128_MF(9, pa1, lo4, hi4); { const float e0_ = __builtin_amdgcn_exp2f(c1[2]), e1_ = __builtin_amdgcn_exp2f(c1[3]); sacc += e0_; sacc += e1_; pn2[1] = attn_body::cvtpk_s(e0_, e1_); asm volatile("" : "+v"(sacc), "+v"(pn2)); } A128_SBAR(); \
        A128_RDF(14, lo4, hi4); A128_WAITL(8); A128_SBAR(); A128_MF(10, pa2, lo0, hi0); { const float e0_ = __builtin_amdgcn_exp2f(c1[4]), e1_ = __builtin_amdgcn_exp2f(c1[5]); sacc += e0_; sacc += e1_; pn2[2] = attn_body::cvtpk_s(e0_, e1_); asm volatile("" : "+v"(sacc), "+v"(pn2)); } A128_SBAR(); \
        A128_RDF(15, lo0, hi0); A128_WAITL(8); A128_SBAR(); A128_MF(11, pa3, lo1, hi1); { const float e0_ = __builtin_amdgcn_exp2f(c1[6]), e1_ = __builtin_amdgcn_exp2f(c1[7]); sacc += e0_; sacc += e1_; pn2[3] = attn_body::cvtpk_s(e0_, e1_); asm volatile("" : "+v"(sacc), "+v"(pn2)); } A128_SBAR(); \
        A128_WAITL(6); A128_SBAR(); A128_MF(12, pa0, lo2, hi2); { const float e0_ = __builtin_amdgcn_exp2f(c1[8]), e1_ = __builtin_amdgcn_exp2f(c1[9]); sacc += e0_; sacc += e1_; pn3[0] = attn_body::cvtpk_s(e0_, e1_); asm volatile("" : "+v"(sacc), "+v"(pn3)); } A128_SBAR(); \
        A128_WAITL(4); A128_SBAR(); A128_MF(13, pa1, lo3, hi3); { const float e0_ = __builtin_amdgcn_exp2f(c1[10]), e1_ = __builtin_amdgcn_exp2f(c1[11]); sacc += e0_; sacc += e1_; pn3[1] = attn_body::cvtpk_s(e0_, e1_); asm volatile("" : "+v"(sacc), "+v"(pn3)); } A128_SBAR(); \
        A128_WAITL(2); A128_SBAR(); A128_MF(14, pa2, lo4, hi4); { const float e0_ = __builtin_amdgcn_exp2f(c1[12]), e1_ = __builtin_amdgcn_exp2f(c1[13]); sacc += e0_; sacc += e1_; pn3[2] = attn_body::cvtpk_s(e0_, e1_); asm volatile("" : "+v"(sacc), "+v"(pn3)); } A128_SBAR(); \
        A128_WAITL(0); A128_SBAR(); A128_MF(15, pa3, lo0, hi0); { const float e0_ = __builtin_amdgcn_exp2f(c1[14]), e1_ = __builtin_amdgcn_exp2f(c1[15]); sacc += e0_; sacc += e1_; pn3[3] = attn_body::cvtpk_s(e0_, e1_); asm volatile("" : "+v"(sacc), "+v"(pn3)); } A128_SBAR(); \
        l_reg += sacc;                                                                                                                            \
        if (resc) { asm volatile("s_waitcnt lgkmcnt(0)" ::: "memory");                                                                            \
            _Pragma("unroll") for (int r = 0; r < 16; ++r) { const float fr = wsf[attn_body::crow(r, hi)]; o[0][r] *= fr; o[1][r] *= fr; o[2][r] *= fr; o[3][r] *= fr; } } \
        pw0 = pn0; pw1 = pn1; pw2 = pn2; pw3 = pn3; } while (0)
#define A128_ISSUE(t) do { if ((t) + 1 < NT) A128_DMAV((t) + 1); if ((t) + 3 < NT) A128_DMAK((t) + 3); } while (0)
#define A128_END(t) do { if ((t) + 3 < NT) asm volatile("s_waitcnt vmcnt(4) lgkmcnt(0)\n\ts_barrier" ::: "memory");                               \
        else if ((t) + 2 < NT) asm volatile("s_waitcnt vmcnt(3) lgkmcnt(0)\n\ts_barrier" ::: "memory");                                          \
        else if ((t) + 1 < NT) asm volatile("s_waitcnt vmcnt(2) lgkmcnt(0)\n\ts_barrier" ::: "memory");                                          \
        else asm volatile("s_waitcnt vmcnt(0) lgkmcnt(0)\n\ts_barrier" ::: "memory"); } while (0)
    if (wid < 4) {
        A128_ISSUE(0); A128_H1(0); A128_H2_0(); A128_END(0);
        for (int t = 1; t < NT; ++t) { A128_ISSUE(t); A128_H1(t); A128_H2(t); A128_END(t); }
    } else {
        A128_ISSUE(0); A128_H1(0); A128_END(0);
        A128_ISSUE(1); A128_H2_0(); A128_H1(1); A128_END(1);
        for (int t = 2; t < NT; ++t) { A128_ISSUE(t); A128_H2(t - 1); A128_H1(t); A128_END(t); }
        A128_H2(NT - 1);
    }
    asm volatile("s_waitcnt vmcnt(0) lgkmcnt(0)\n\ts_barrier" ::: "memory");
#undef A128_H1
#undef A128_H2_0
#undef A128_H2
#undef A128_ISSUE
#undef A128_END
#undef A128_PKW
#undef A128_RDF
#undef A128_FR
#undef A128_MF
    pv128(o, vb0 + ((NT - 1) & 3) * VSLOT, __builtin_bit_cast(bf16x8, pw0), __builtin_bit_cast(bf16x8, pw1), __builtin_bit_cast(bf16x8, pw2), __builtin_bit_cast(bf16x8, pw3));
    { auto rr = __builtin_amdgcn_permlane32_swap(__float_as_uint(l_reg), __float_as_uint(l_reg), false, false); l_reg = __uint_as_float(rr[0]) + __uint_as_float(rr[1]); }
    int lne = lane; asm volatile("" : "+v"(lne));
    const int r32e = lne & 31, hie = lne >> 5;
    if (hie == 0) wsf[32 + r32e] = l_reg; asm volatile("s_waitcnt lgkmcnt(0)" ::: "memory");
    float rli[16];
#pragma unroll
    for (int r = 0; r < 16; ++r) rli[r] = __builtin_amdgcn_rcpf(wsf[32 + attn_body::crow(r, hie)]);
    bf16* Ow = O + (rowbase + q0 + wid * QBLK) * DMP + hv * 64;
    { bf16* stg = (bf16*)(shm + L2_OST) + wid * 2048;
#pragma unroll
      for (int half = 0; half < 2; ++half) {
#pragma unroll
          for (int r = 0; r < 16; ++r) { const int orow = attn_body::crow(r, hie);
#pragma unroll
              for (int d0 = 0; d0 < 2; ++d0) stg[orow * 64 + d0 * 32 + r32e] = __float2bfloat16(o[2 * half + d0][r] * rli[r]); }
          asm volatile("s_waitcnt lgkmcnt(0)" ::: "memory");
#pragma unroll
          for (int i = 0; i < 4; ++i) { const int row = i * 8 + (lne >> 3), ch = lne & 7; const u32x4 v = *(const u32x4*)(stg + row * 64 + ch * 8); *(u32x4*)(Ow + (long)row * DMP + half * 64 + ch * 8) = v; }
          asm volatile("s_waitcnt lgkmcnt(0)" ::: "memory"); } }
    asm volatile("s_waitcnt lgkmcnt(0)\n\ts_barrier" ::: "memory");
#undef A128_DMAK
#undef A128_DMAV
#undef A128_ROWMAX
}
#define A128_ROWMAX(rm) do { float a = fmaxf(fmaxf(c0[0], c0[1]), c1[0]), bb = fmaxf(fmaxf(c0[2], c0[3]), c1[1]); a = fmaxf(fmaxf(a, c1[2]), c1[3]);                    \
          _Pragma("unroll") for (int r = 4; r < 16; r += 4) { a = fmaxf(fmaxf(a, c0[r]), c0[r + 1]); bb = fmaxf(fmaxf(bb, c0[r + 2]), c0[r + 3]); a = fmaxf(fmaxf(a, c1[r]), c1[r + 1]); bb = fmaxf(fmaxf(bb, c1[r + 2]), c1[r + 3]); } \
          rm = fmaxf(a, bb); auto rr = __builtin_amdgcn_permlane32_swap(__float_as_uint(rm), __float_as_uint(rm), false, false); rm = fmaxf(__uint_as_float(rr[0]), __uint_as_float(rr[1])); } while (0)

__device__ __forceinline__ void qkt128r(f32x16& p0, f32x16& p1, int kb, const bf16x8* qr, const f32x16& negm) {
    bf16x8 k0, k1, k2, k3;
#define A128_RDK(K, OFF) asm volatile("ds_read_b128 %0,%1 offset:%c2" : "=&v"(K) : "v"(kb), "i"(OFF) : "memory")
#define A128_RDK2(K, OFF) asm volatile("ds_read_b128 %0,%1 offset:%c2" : "+v"(K) : "v"(kb), "i"(OFF) : "memory")
    A128_RDK(k0, 0); A128_RDK(k1, 512); A128_RDK(k2, 2048); A128_RDK(k3, 2560);
    A128_WAITL(3); A128_SBAR(); p0 = __builtin_amdgcn_mfma_f32_32x32x16_bf16(k0, qr[0], negm, 0, 0, 0); A128_SBAR(); A128_RDK2(k0, 4096);
    A128_WAITL(3); A128_SBAR(); p1 = __builtin_amdgcn_mfma_f32_32x32x16_bf16(k1, qr[0], negm, 0, 0, 0); A128_SBAR(); A128_RDK2(k1, 4608);
    A128_WAITL(3); A128_SBAR(); p0 = __builtin_amdgcn_mfma_f32_32x32x16_bf16(k2, qr[1], p0, 0, 0, 0); A128_SBAR(); A128_RDK2(k2, 6144);
    A128_WAITL(3); A128_SBAR(); p1 = __builtin_amdgcn_mfma_f32_32x32x16_bf16(k3, qr[1], p1, 0, 0, 0); A128_SBAR(); A128_RDK2(k3, 6656);
    A128_WAITL(3); A128_SBAR(); p0 = __builtin_amdgcn_mfma_f32_32x32x16_bf16(k0, qr[2], p0, 0, 0, 0);
    A128_WAITL(2); A128_SBAR(); p1 = __builtin_amdgcn_mfma_f32_32x32x16_bf16(k1, qr[2], p1, 0, 0, 0);
    A128_WAITL(1); A128_SBAR(); p0 = __builtin_amdgcn_mfma_f32_32x32x16_bf16(k2, qr[3], p0, 0, 0, 0);
    A128_WAITL(0); A128_SBAR(); p1 = __builtin_amdgcn_mfma_f32_32x32x16_bf16(k3, qr[3], p1, 0, 0, 0);
#undef A128_RDK
#undef A128_RDK2
    asm volatile("s_nop 15\n\ts_nop 7" : "+v"(p0), "+v"(p1));
}
template <int THRL> __device__ __forceinline__ void unit4(int b, int hq, int hv, int qb, const bf16* Q, const bf16* __restrict__ K, const bf16* __restrict__ V, bf16* O, char* shm, volatile __attribute__((address_space(3))) unsigned* PRB = nullptr) {
    const int tid = threadIdx.x; int lane = tid & 63; asm volatile("" : "+v"(lane));
    const int r32 = lane & 31, hi = lane >> 5; const int wid = __builtin_amdgcn_readfirstlane(tid >> 6);
    const long rowbase = (long)b * SEQ_; const int q0 = qb * QB;
    const bf16* Qw = Q + (rowbase + q0 + wid * QBLK) * DMP + hq * 64;
    const bf16* Kh = K + rowbase * DMP + hq * 64, * Vh = V + rowbase * DMP + hv * 64;
    const unsigned lds0 = (unsigned)(uintptr_t)shm;
    float* wsf = (float*)(shm + L2_WS) + wid * 64;
    const bf16* ksrc = Kh + (long)lane * DMP + wid * 8;
    const bf16* vsrc = Vh + (long)(16 * (wid & 3) + (lane >> 2)) * DMP + (wid >> 2) * 32 + (lane & 3) * 8;
    const unsigned kdst = lds0 + L2_K + wid * 1024, vdst = lds0 + L2_V + wid * 1024;
#define A128_DMAK(t) attn_body::glds16(ksrc + (long)(t) * KVBLK * DMP, (unsigned)__builtin_amdgcn_readfirstlane(kdst + ((t) & 3) * KSLOT))
#define A128_DMAV(t) do { attn_body::glds16(vsrc + (long)(t) * KVBLK * DMP, (unsigned)__builtin_amdgcn_readfirstlane(vdst + ((t) & 3) * VSLOT)); \
        attn_body::glds16(vsrc + (long)(t) * KVBLK * DMP + 64, (unsigned)__builtin_amdgcn_readfirstlane(vdst + ((t) & 3) * VSLOT + 8192)); } while (0)
    const int vb0 = (int)(lds0 + L2_V) + ((lane >> 4) & 1) * 32 + (lane & 3) * 8 + (4 * hi + ((lane & 15) >> 2)) * 64;
    const int kb0 = (int)(lds0 + L2_K) + hi * 1024 + r32 * 16;
    const int NT = (q0 + QB) / KVBLK;
    A128_DMAK(0); A128_DMAV(0); A128_DMAK(1); A128_DMAV(1); A128_DMAK(2);
    bf16x8 qr[4];
#pragma unroll
    for (int d0 = 0; d0 < 4; ++d0) qr[d0] = *reinterpret_cast<const bf16x8*>(&Qw[(long)r32 * DMP + d0 * 16 + hi * 8]);
    float mhat = 0.f, l_reg = 0.f; f32x16 o[4]; f32x16 negm;
    { float zz; asm volatile("v_mov_b32 %0, 0" : "=v"(zz));
#pragma unroll
      for (int r = 0; r < 16; ++r) { o[0][r] = zz; o[1][r] = zz; o[2][r] = zz; o[3][r] = zz; negm[r] = zz; } }
    const int qrel = wid * QBLK + r32;
    asm volatile("s_waitcnt vmcnt(0) lgkmcnt(0)\n\ts_barrier" ::: "memory");
    u32x4 pw0, pw1, pw2, pw3; f32x16 c0, c1;
#define A128_PKW(P, B) attn_body::cvtpk_s(P[B], P[B + 1])
#define A128_ISSUE(s) do { if ((s) + 3 < NT) A128_DMAK((s) + 3); if ((s) + 2 < NT) A128_DMAV((s) + 2); } while (0)
#define A128_BARE() asm volatile("s_waitcnt lgkmcnt(0)\n\ts_barrier" ::: "memory")
#define A128_BARO(s) do { PRB_B(55, PRB); if ((s) + 3 < NT) asm volatile("s_waitcnt vmcnt(6) lgkmcnt(0)" ::: "memory");                               \
        else if ((s) + 2 < NT) asm volatile("s_waitcnt vmcnt(5) lgkmcnt(0)" ::: "memory");                                          \
        else if ((s) + 1 < NT) asm volatile("s_waitcnt vmcnt(2) lgkmcnt(0)" ::: "memory");                                          \
        else asm volatile("s_waitcnt vmcnt(0) lgkmcnt(0)" ::: "memory"); PRB_E(55, PRB); PRB_B(56, PRB); asm volatile("s_barrier" ::: "memory"); PRB_E(56, PRB); } while (0)
#define A128_MQK(t) qkt128r(c0, c1, kb0 + ((t) & 3) * KSLOT, qr, negm)
#define A128_MPV(t) pv128(o, vb0 + ((t) & 3) * VSLOT, __builtin_bit_cast(bf16x8, pw0), __builtin_bit_cast(bf16x8, pw1), __builtin_bit_cast(bf16x8, pw2), __builtin_bit_cast(bf16x8, pw3))
#define A128_VEC(t) do { int hv_ = hi, qrel_ = qrel, r32_ = r32; asm volatile("" : "+v"(hv_), "+v"(qrel_), "+v"(r32_));                                \
        { const int jb = (t) - (NT - 4); if (__builtin_expect(jb >= 0, 0)) { asm volatile("" ::: "memory"); attn_body::cmask(c0, c1, jb, qrel_, hv_); } } \
        float rm; A128_ROWMAX(rm);                                                                                                                 \
        if ((t) == 0) { mhat = rm; _Pragma("unroll") for (int r = 0; r < 16; ++r) { c0[r] -= rm; c1[r] -= rm; negm[r] = -mhat; } }                \
        else if (__builtin_expect(__any(rm > (float)THRL), 0)) { const float dl = fmaxf(rm, 0.f); mhat += dl;                                      \
            _Pragma("unroll") for (int r = 0; r < 16; ++r) { c0[r] -= dl; c1[r] -= dl; negm[r] = -mhat; }                                          \
            const float f = __builtin_amdgcn_exp2f(-dl); l_reg *= f; if (hv_ == 0) wsf[r32_] = f; asm volatile("s_waitcnt lgkmcnt(0)" ::: "memory"); \
            _Pragma("unroll") for (int r = 0; r < 16; ++r) { const float fr = wsf[attn_body::crow(r, hv_)]; o[0][r] *= fr; o[1][r] *= fr; o[2][r] *= fr; o[3][r] *= fr; } } \
        float sacc = 0.f;                                                                                                                          \
        _Pragma("unroll") for (int r = 0; r < 16; ++r) { c0[r] = __builtin_amdgcn_exp2f(c0[r]); c1[r] = __builtin_amdgcn_exp2f(c1[r]); }           \
        _Pragma("unroll") for (int r = 0; r < 16; ++r) sacc += c0[r] + c1[r];                                                                      \
        l_reg += sacc;                                                                                                                             \
        pw0 = (u32x4){A128_PKW(c0, 0), A128_PKW(c0, 2), A128_PKW(c0, 4), A128_PKW(c0, 6)}; pw1 = (u32x4){A128_PKW(c0, 8), A128_PKW(c0, 10), A128_PKW(c0, 12), A128_PKW(c0, 14)}; \
        pw2 = (u32x4){A128_PKW(c1, 0), A128_PKW(c1, 2), A128_PKW(c1, 4), A128_PKW(c1, 6)}; pw3 = (u32x4){A128_PKW(c1, 8), A128_PKW(c1, 10), A128_PKW(c1, 12), A128_PKW(c1, 14)}; } while (0)
    const bool isB = wid >= 4;
    A128_ISSUE(0); A128_MQK(0);
    if (isB) { A128_BARO(0); A128_ISSUE(1); }
    A128_VEC(0);
    if (!isB) { A128_BARO(0); }
    for (int s = 1; s < NT; ++s) {
        if (!isB) A128_ISSUE(s);
        __builtin_amdgcn_s_setprio(1); A128_MQK(s); A128_MPV(s - 1); __builtin_amdgcn_s_setprio(0);
        if (isB) { A128_BARO(s); A128_ISSUE(s + 1); }
        A128_VEC(s);
        if (!isB) { A128_BARO(s); }
    }
    A128_MPV(NT - 1);
#undef A128_PKW
#undef A128_ISSUE
#undef A128_BARE
#undef A128_BARO
#undef A128_MQK
#undef A128_MPV
#undef A128_VEC
    { auto rr = __builtin_amdgcn_permlane32_swap(__float_as_uint(l_reg), __float_as_uint(l_reg), false, false); l_reg = __uint_as_float(rr[0]) + __uint_as_float(rr[1]); }
    int lne = lane; asm volatile("" : "+v"(lne));
    const int r32e = lne & 31, hie = lne >> 5;
    if (hie == 0) wsf[32 + r32e] = l_reg; asm volatile("s_waitcnt lgkmcnt(0)" ::: "memory");
    float rli[16];
#pragma unroll
    for (int r = 0; r < 16; ++r) rli[r] = __builtin_amdgcn_rcpf(wsf[32 + attn_body::crow(r, hie)]);
    bf16* Ow = O + (rowbase + q0 + wid * QBLK) * DMP + hv * 64;
    { bf16* stg = (bf16*)(shm + L2_OST) + wid * 2048;
#pragma unroll
      for (int half = 0; half < 2; ++half) {
#pragma unroll
          for (int r = 0; r < 16; ++r) { const int orow = attn_body::crow(r, hie);
#pragma unroll
              for (int d0 = 0; d0 < 2; ++d0) stg[orow * 64 + d0 * 32 + r32e] = __float2bfloat16(o[2 * half + d0][r] * rli[r]); }
          asm volatile("s_waitcnt lgkmcnt(0)" ::: "memory");
#pragma unroll
          for (int i = 0; i < 4; ++i) { const int row = i * 8 + (lne >> 3), ch = lne & 7; const u32x4 v = *(const u32x4*)(stg + row * 64 + ch * 8); *(u32x4*)(Ow + (long)row * DMP + half * 64 + ch * 8) = v; }
          asm volatile("s_waitcnt lgkmcnt(0)" ::: "memory"); } }
    asm volatile("s_waitcnt lgkmcnt(0)\n\ts_barrier" ::: "memory");
#undef A128_DMAK
#undef A128_DMAV
}
#undef A128_ROWMAX

template <int THRL> __device__ __forceinline__ void unit6(int b, int hq, int hv, int qb, const bf16* Q, const bf16* __restrict__ K, const bf16* __restrict__ V, bf16* O, char* shm) {
    const unsigned lds0 = (unsigned)(uintptr_t)shm;
    int lane = lane_now(); asm volatile("" : "+v"(lane));
    const int r32 = lane & 31, hi = lane >> 5; const int wid = __builtin_amdgcn_readfirstlane(wave_now((const void*)(uintptr_t)lds0));
    const long rowbase = (long)b * SEQ_; const int q0 = qb * QB;
    const bf16* Qw = Q + (rowbase + q0 + wid * QBLK) * DMP + hq * 64;
    const bf16* Kh = K + rowbase * DMP + hq * 64, * Vh = V + rowbase * DMP + hv * 64;
    float* wsf = (float*)(shm + L2_WS) + wid * 64;
    const bf16* ksrc = Kh + (long)lane * DMP + wid * 8;
    const bf16* vsrc = Vh + (long)(16 * (wid & 3) + (lane >> 2)) * DMP + (wid >> 2) * 32 + (lane & 3) * 8;
    const unsigned kdst = lds0 + L2_K + wid * 1024, vdst = lds0 + L2_V + wid * 1024;
#define A128_DMAK(t) attn_body::glds16(ksrc + (long)(t) * KVBLK * DMP, (unsigned)__builtin_amdgcn_readfirstlane(kdst + ((t) & 3) * KSLOT))
#define A128_DMAV(t) do { attn_body::glds16(vsrc + (long)(t) * KVBLK * DMP, (unsigned)__builtin_amdgcn_readfirstlane(vdst + ((t) & 3) * VSLOT)); \
        attn_body::glds16(vsrc + (long)(t) * KVBLK * DMP + 64, (unsigned)__builtin_amdgcn_readfirstlane(vdst + ((t) & 3) * VSLOT + 8192)); } while (0)
    const int vb0 = (int)(lds0 + L2_V) + ((lane >> 4) & 1) * 32 + (lane & 3) * 8 + (4 * hi + ((lane & 15) >> 2)) * 64;
    const int kb0 = (int)(lds0 + L2_K) + hi * 1024 + r32 * 16;
    const int NT = (q0 + QB) / KVBLK;
    A128_DMAK(0); A128_DMAK(1); A128_DMAV(0); A128_DMAK(2); A128_DMAV(1); A128_DMAK(3);
    bf16x8 qr[4];
#pragma unroll
    for (int d0 = 0; d0 < 4; ++d0) qr[d0] = *reinterpret_cast<const bf16x8*>(&Qw[(long)r32 * DMP + d0 * 16 + hi * 8]);
    float mhat = 0.f, l_reg = 0.f; f32x16 o[4]; f32x16 negm;
    { float zz; asm volatile("v_mov_b32 %0, 0" : "=v"(zz));
#pragma unroll
      for (int r = 0; r < 16; ++r) { o[0][r] = zz; o[1][r] = zz; o[2][r] = zz; o[3][r] = zz; negm[r] = zz; } }
    const int qrel = wid * QBLK + r32;
    asm volatile("s_waitcnt vmcnt(0) lgkmcnt(0)\n\ts_barrier" ::: "memory");
    u32x4 pw0, pw1, pw2, pw3; f32x16 ca0, ca1, cb0, cb1;
#define U6_RDV(j, LO, HI) do { asm volatile("ds_read_b64_tr_b16 %0,%1 offset:%c2" : "=&v"(LO) : "v"(vb), "i"(((j) & 3) * 4096 + ((j) >> 2) * 1024) : "memory"); \
                               asm volatile("ds_read_b64_tr_b16 %0,%1 offset:%c2" : "=&v"(HI) : "v"(vb), "i"(((j) & 3) * 4096 + ((j) >> 2) * 1024 + 512) : "memory"); } while (0)
#define U6_MFV(j, PA, LO, HI) o[(j) & 3] = __builtin_amdgcn_mfma_f32_32x32x16_bf16(PA, (bf16x8){LO[0], LO[1], LO[2], LO[3], HI[0], HI[1], HI[2], HI[3]}, o[(j) & 3], 0, 0, 0)
#define U6_RDK(K_, OFF) asm volatile("ds_read_b128 %0,%1 offset:%c2" : "=&v"(K_) : "v"(kb), "i"(OFF) : "memory")
#define U6_RDK2(K_, OFF) asm volatile("ds_read_b128 %0,%1 offset:%c2" : "+v"(K_) : "v"(kb), "i"(OFF) : "memory")
    { qkt128r(ca0, ca1, kb0, qr, negm);
      asm volatile("s_waitcnt lgkmcnt(0)\n\ts_barrier" ::: "memory");
      if (4 < NT) A128_DMAK(4); A128_DMAV(2);
      { const int jb = 0 - (NT - 4); if (jb >= 0) attn_body::cmask(ca0, ca1, jb, qrel, hi); }
      float rm; { float a_ = fmaxf(fmaxf(ca0[0], ca0[1]), ca1[0]), b_ = fmaxf(fmaxf(ca0[2], ca0[3]), ca1[1]); a_ = fmaxf(fmaxf(a_, ca1[2]), ca1[3]);
#pragma unroll
          for (int r = 4; r < 16; r += 4) { a_ = fmaxf(fmaxf(a_, ca0[r]), ca0[r + 1]); b_ = fmaxf(fmaxf(b_, ca0[r + 2]), ca0[r + 3]); a_ = fmaxf(fmaxf(a_, ca1[r]), ca1[r + 1]); b_ = fmaxf(fmaxf(b_, ca1[r + 2]), ca1[r + 3]); }
          rm = fmaxf(a_, b_); auto rr = __builtin_amdgcn_permlane32_swap(__float_as_uint(rm), __float_as_uint(rm), false, false); rm = fmaxf(__uint_as_float(rr[0]), __uint_as_float(rr[1])); }
      mhat = rm;
#pragma unroll
      for (int r = 0; r < 16; ++r) { ca0[r] -= rm; ca1[r] -= rm; negm[r] = -mhat; }
      float sacc = 0.f;
#pragma unroll
      for (int r = 0; r < 16; ++r) { ca0[r] = __builtin_amdgcn_exp2f(ca0[r]); ca1[r] = __builtin_amdgcn_exp2f(ca1[r]); }
#pragma unroll
      for (int r = 0; r < 16; ++r) sacc += ca0[r] + ca1[r];
      l_reg += sacc;
#define A128_PKW(P, B) attn_body::cvtpk_s(P[B], P[B + 1])
      pw0 = (u32x4){A128_PKW(ca0, 0), A128_PKW(ca0, 2), A128_PKW(ca0, 4), A128_PKW(ca0, 6)}; pw1 = (u32x4){A128_PKW(ca0, 8), A128_PKW(ca0, 10), A128_PKW(ca0, 12), A128_PKW(ca0, 14)};
      pw2 = (u32x4){A128_PKW(ca1, 0), A128_PKW(ca1, 2), A128_PKW(ca1, 4), A128_PKW(ca1, 6)}; pw3 = (u32x4){A128_PKW(ca1, 8), A128_PKW(ca1, 10), A128_PKW(ca1, 12), A128_PKW(ca1, 14)};
#undef A128_PKW
      qkt128r(cb0, cb1, kb0 + KSLOT, qr, negm);
      asm volatile("s_waitcnt vmcnt(3) lgkmcnt(0)\n\ts_barrier" ::: "memory"); }
#define U6_STEP(C0, C1, N0, N1, t) do {                                                                                                                       \
        if ((t) + 4 < NT) A128_DMAK((t) + 4);                                                                                                                   \
        if ((t) + 2 < NT) A128_DMAV((t) + 2);                                                                                                                   \
        { const int jb = (t) - (NT - 4); if (__builtin_expect(jb >= 0, 0)) { asm volatile("" ::: "memory"); attn_body::cmask(C0, C1, jb, qrel, hi); } }         \
        const bf16x8 pa0 = __builtin_bit_cast(bf16x8, pw0), pa1 = __builtin_bit_cast(bf16x8, pw1), pa2 = __builtin_bit_cast(bf16x8, pw2), pa3 = __builtin_bit_cast(bf16x8, pw3); \
        u32x4 pn0, pn1, pn2, pn3; float sacc = 0.f; bool resc = false; float rmA, rmB, rm;                                                                       \
        const int vb = vb0 + (((t) - 1) & 3) * VSLOT, kb = kb0 + (((t) + 1) & 3) * KSLOT;                                                                          \
        s16x4 vl0, vh0, vl1, vh1, vl2, vh2, vl3, vh3; bf16x8 kf0, kf1, kf2;                                                                         \
        U6_RDV(0, vl0, vh0); U6_RDV(1, vl1, vh1); U6_RDV(2, vl2, vh2);    \
        U6_RDV(3, vl3, vh3); A128_WAITL(6); A128_SBAR(); U6_MFV(0, pa0, vl0, vh0); rmA = fmaxf(fmaxf(C0[0], C0[1]), C1[0]); rmB = fmaxf(fmaxf(C0[2], C0[3]), C1[1]); rmA = fmaxf(fmaxf(rmA, C1[2]), C1[3]); rmA = fmaxf(fmaxf(rmA, C0[4]), C0[5]); rmB = fmaxf(fmaxf(rmB, C0[6]), C0[7]); asm volatile("" : "+v"(rmA), "+v"(rmB)); A128_SBAR();    \
        U6_RDV(4, vl0, vh0); A128_WAITL(6); A128_SBAR(); U6_MFV(1, pa0, vl1, vh1); rmA = fmaxf(fmaxf(rmA, C1[4]), C1[5]); rmB = fmaxf(fmaxf(rmB, C1[6]), C1[7]); rmA = fmaxf(fmaxf(rmA, C0[8]), C0[9]); rmB = fmaxf(fmaxf(rmB, C0[10]), C0[11]); rmA = fmaxf(fmaxf(rmA, C1[8]), C1[9]); asm volatile("" : "+v"(rmA), "+v"(rmB)); A128_SBAR();    \
        U6_RDV(5, vl1, vh1); A128_WAITL(6); A128_SBAR(); U6_MFV(2, pa0, vl2, vh2); rmB = fmaxf(fmaxf(rmB, C1[10]), C1[11]); rmA = fmaxf(fmaxf(rmA, C0[12]), C0[13]); rmB = fmaxf(fmaxf(rmB, C0[14]), C0[15]); rmA = fmaxf(fmaxf(rmA, C1[12]), C1[13]); rmB = fmaxf(fmaxf(rmB, C1[14]), C1[15]); asm volatile("" : "+v"(rmA), "+v"(rmB)); A128_SBAR();    \
        U6_RDV(6, vl2, vh2); A128_WAITL(6); A128_SBAR(); U6_MFV(3, pa0, vl3, vh3); rm = fmaxf(rmA, rmB); { auto rr = __builtin_amdgcn_permlane32_swap(__float_as_uint(rm), __float_as_uint(rm), false, false); rm = fmaxf(__uint_as_float(rr[0]), __uint_as_float(rr[1])); } asm volatile("" : "+v"(rm)); A128_SBAR();    \
        if (__builtin_expect(__any(rm > (float)THRL), 0)) { const float dl = fmaxf(rm, 0.f); mhat += dl;                                                     \
            _Pragma("unroll") for (int r = 0; r < 16; ++r) { C0[r] -= dl; C1[r] -= dl; negm[r] = -mhat; }                                                  \
            const float f = __builtin_amdgcn_exp2f(-dl); l_reg *= f; if (hi == 0) wsf[r32] = f; resc = true; asm volatile("s_waitcnt lgkmcnt(0)" ::: "memory"); }  \
        U6_RDV(7, vl3, vh3); A128_WAITL(6); A128_SBAR(); U6_MFV(4, pa1, vl0, vh0); { const float e0_ = __builtin_amdgcn_exp2f(C0[0]), e1_ = __builtin_amdgcn_exp2f(C0[1]); sacc += e0_; sacc += e1_; pn0[0] = attn_body::cvtpk_s(e0_, e1_); asm volatile("" : "+v"(sacc), "+v"(pn0)); } A128_SBAR();    \
        U6_RDV(8, vl0, vh0); A128_WAITL(6); A128_SBAR(); U6_MFV(5, pa1, vl1, vh1); { const float e0_ = __builtin_amdgcn_exp2f(C0[2]), e1_ = __builtin_amdgcn_exp2f(C0[3]); sacc += e0_; sacc += e1_; pn0[1] = attn_body::cvtpk_s(e0_, e1_); asm volatile("" : "+v"(sacc), "+v"(pn0)); } A128_SBAR();    \
        U6_RDV(9, vl1, vh1); A128_WAITL(6); A128_SBAR(); U6_MFV(6, pa1, vl2, vh2); { const float e0_ = __builtin_amdgcn_exp2f(C0[4]), e1_ = __builtin_amdgcn_exp2f(C0[5]); sacc += e0_; sacc += e1_; pn0[2] = attn_body::cvtpk_s(e0_, e1_); asm volatile("" : "+v"(sacc), "+v"(pn0)); } A128_SBAR();    \
        U6_RDV(10, vl2, vh2); A128_WAITL(6); A128_SBAR(); U6_MFV(7, pa1, vl3, vh3); { const float e0_ = __builtin_amdgcn_exp2f(C0[6]), e1_ = __builtin_amdgcn_exp2f(C0[7]); sacc += e0_; sacc += e1_; pn0[3] = attn_body::cvtpk_s(e0_, e1_); asm volatile("" : "+v"(sacc), "+v"(pn0)); } A128_SBAR();    \
        U6_RDV(11, vl3, vh3); A128_WAITL(6); A128_SBAR(); U6_MFV(8, pa2, vl0, vh0); A128_SBAR();    \
        U6_RDV(12, vl0, vh0); A128_WAITL(6); A128_SBAR(); U6_MFV(9, pa2, vl1, vh1); { const float e0_ = __builtin_amdgcn_exp2f(C0[8]), e1_ = __builtin_amdgcn_exp2f(C0[9]); sacc += e0_; sacc += e1_; pn1[0] = attn_body::cvtpk_s(e0_, e1_); asm volatile("" : "+v"(sacc), "+v"(pn1)); } A128_SBAR();    \
        U6_RDV(13, vl1, vh1); A128_WAITL(6); A128_SBAR(); U6_MFV(10, pa2, vl2, vh2); { const float e0_ = __builtin_amdgcn_exp2f(C0[10]), e1_ = __builtin_amdgcn_exp2f(C0[11]); sacc += e0_; sacc += e1_; pn1[1] = attn_body::cvtpk_s(e0_, e1_); asm volatile("" : "+v"(sacc), "+v"(pn1)); } A128_SBAR();    \
        U6_RDV(14, vl2, vh2); A128_WAITL(6); A128_SBAR(); U6_MFV(11, pa2, vl3, vh3); { const float e0_ = __builtin_amdgcn_exp2f(C0[12]), e1_ = __builtin_amdgcn_exp2f(C0[13]); sacc += e0_; sacc += e1_; pn1[2] = attn_body::cvtpk_s(e0_, e1_); asm volatile("" : "+v"(sacc), "+v"(pn1)); } A128_SBAR();    \
        U6_RDV(15, vl3, vh3); A128_WAITL(6); A128_SBAR(); U6_MFV(12, pa3, vl0, vh0); { const float e0_ = __builtin_amdgcn_exp2f(C0[14]), e1_ = __builtin_amdgcn_exp2f(C0[15]); sacc += e0_; sacc += e1_; pn1[3] = attn_body::cvtpk_s(e0_, e1_); asm volatile("" : "+v"(sacc), "+v"(pn1)); } A128_SBAR();    \
        U6_RDK(kf0, 0); A128_WAITL(5); A128_SBAR(); U6_MFV(13, pa3, vl1, vh1); A128_SBAR();    \
        U6_RDK(kf1, 512); A128_WAITL(4); A128_SBAR(); U6_MFV(14, pa3, vl2, vh2); { const float e0_ = __builtin_amdgcn_exp2f(C1[0]), e1_ = __builtin_amdgcn_exp2f(C1[1]); sacc += e0_; sacc += e1_; pn2[0] = attn_body::cvtpk_s(e0_, e1_); asm volatile("" : "+v"(sacc), "+v"(pn2)); } A128_SBAR();    \
        U6_RDK(kf2, 2048); A128_WAITL(3); A128_SBAR(); U6_MFV(15, pa3, vl3, vh3); { const float e0_ = __builtin_amdgcn_exp2f(C1[2]), e1_ = __builtin_amdgcn_exp2f(C1[3]); sacc += e0_; sacc += e1_; pn2[1] = attn_body::cvtpk_s(e0_, e1_); asm volatile("" : "+v"(sacc), "+v"(pn2)); } A128_SBAR();    \
        A128_WAITL(2); A128_SBAR(); N0 = __builtin_amdgcn_mfma_f32_32x32x16_bf16(kf0, qr[0], negm, 0, 0, 0); A128_SBAR(); U6_RDK2(kf0, 2560); { const float e0_ = __builtin_amdgcn_exp2f(C1[4]), e1_ = __builtin_amdgcn_exp2f(C1[5]); sacc += e0_; sacc += e1_; pn2[2] = attn_body::cvtpk_s(e0_, e1_); asm volatile("" : "+v"(sacc), "+v"(pn2)); } A128_SBAR();    \
        A128_WAITL(2); A128_SBAR(); N1 = __builtin_amdgcn_mfma_f32_32x32x16_bf16(kf1, qr[0], negm, 0, 0, 0); A128_SBAR(); U6_RDK2(kf1, 4096); { const float e0_ = __builtin_amdgcn_exp2f(C1[6]), e1_ = __builtin_amdgcn_exp2f(C1[7]); sacc += e0_; sacc += e1_; pn2[3] = attn_body::cvtpk_s(e0_, e1_); asm volatile("" : "+v"(sacc), "+v"(pn2)); } A128_SBAR();    \
        A128_WAITL(2); A128_SBAR(); N0 = __builtin_amdgcn_mfma_f32_32x32x16_bf16(kf2, qr[1], N0, 0, 0, 0); A128_SBAR(); U6_RDK2(kf2, 4608); A128_SBAR();    \
        A128_WAITL(2); A128_SBAR(); N1 = __builtin_amdgcn_mfma_f32_32x32x16_bf16(kf0, qr[1], N1, 0, 0, 0); A128_SBAR(); U6_RDK2(kf0, 6144); { const float e0_ = __builtin_amdgcn_exp2f(C1[8]), e1_ = __builtin_amdgcn_exp2f(C1[9]); sacc += e0_; sacc += e1_; pn3[0] = attn_body::cvtpk_s(e0_, e1_); asm volatile("" : "+v"(sacc), "+v"(pn3)); } A128_SBAR();    \
        A128_WAITL(2); A128_SBAR(); N0 = __builtin_amdgcn_mfma_f32_32x32x16_bf16(kf1, qr[2], N0, 0, 0, 0); A128_SBAR(); U6_RDK2(kf1, 6656); { const float e0_ = __builtin_amdgcn_exp2f(C1[10]), e1_ = __builtin_amdgcn_exp2f(C1[11]); sacc += e0_; sacc += e1_; pn3[1] = attn_body::cvtpk_s(e0_, e1_); asm volatile("" : "+v"(sacc), "+v"(pn3)); } A128_SBAR();    \
        A128_WAITL(2); A128_SBAR(); N1 = __builtin_amdgcn_mfma_f32_32x32x16_bf16(kf2, qr[2], N1, 0, 0, 0); { const float e0_ = __builtin_amdgcn_exp2f(C1[12]), e1_ = __builtin_amdgcn_exp2f(C1[13]); sacc += e0_; sacc += e1_; pn3[2] = attn_body::cvtpk_s(e0_, e1_); asm volatile("" : "+v"(sacc), "+v"(pn3)); } A128_SBAR();    \
        A128_WAITL(1); A128_SBAR(); N0 = __builtin_amdgcn_mfma_f32_32x32x16_bf16(kf0, qr[3], N0, 0, 0, 0); { const float e0_ = __builtin_amdgcn_exp2f(C1[14]), e1_ = __builtin_amdgcn_exp2f(C1[15]); sacc += e0_; sacc += e1_; pn3[3] = attn_body::cvtpk_s(e0_, e1_); asm volatile("" : "+v"(sacc), "+v"(pn3)); } A128_SBAR();    \
        A128_WAITL(0); A128_SBAR(); N1 = __builtin_amdgcn_mfma_f32_32x32x16_bf16(kf1, qr[3], N1, 0, 0, 0); A128_SBAR();    \
        asm volatile("s_nop 7" : "+v"(N0), "+v"(N1));                                                                                                            \
        l_reg += sacc;                                                                                                                                            \
        if (resc) { asm volatile("s_waitcnt lgkmcnt(0)" ::: "memory");                                                                                             \
            _Pragma("unroll") for (int r = 0; r < 16; ++r) { const float fr = wsf[attn_body::crow(r, hi)]; o[0][r] *= fr; o[1][r] *= fr; o[2][r] *= fr; o[3][r] *= fr; } } \
        pw0 = pn0; pw1 = pn1; pw2 = pn2; pw3 = pn3;                                                                                                                \
        if ((t) + 4 < NT) asm volatile("s_waitcnt vmcnt(6) lgkmcnt(0)\n\ts_barrier" ::: "memory");                                                                 \
        else if ((t) + 3 < NT) asm volatile("s_waitcnt vmcnt(5) lgkmcnt(0)\n\ts_barrier" ::: "memory");                                                            \
        else if ((t) + 2 < NT) asm volatile("s_waitcnt vmcnt(4) lgkmcnt(0)\n\ts_barrier" ::: "memory");                                                            \
        else if ((t) + 1 < NT) asm volatile("s_waitcnt vmcnt(2) lgkmcnt(0)\n\ts_barrier" ::: "memory");                                                            \
        else asm volatile("s_waitcnt vmcnt(0) lgkmcnt(0)\n\ts_barrier" ::: "memory"); } while (0)

    for (int t = 1; t + 2 < NT; t += 2) { U6_STEP(cb0, cb1, ca0, ca1, t); U6_STEP(ca0, ca1, cb0, cb1, t + 1); }
    U6_STEP(cb0, cb1, ca0, ca1, NT - 1);
#undef U6_STEP
#undef U6_RDV
#undef U6_MFV
#undef U6_RDK
#undef U6_RDK2
    pv128(o, vb0 + ((NT - 1) & 3) * VSLOT, __builtin_bit_cast(bf16x8, pw0), __builtin_bit_cast(bf16x8, pw1), __builtin_bit_cast(bf16x8, pw2), __builtin_bit_cast(bf16x8, pw3));
    { auto rr = __builtin_amdgcn_permlane32_swap(__float_as_uint(l_reg), __float_as_uint(l_reg), false, false); l_reg = __uint_as_float(rr[0]) + __uint_as_float(rr[1]); }
    int lne = lane; asm volatile("" : "+v"(lne));
    const int r32e = lne & 31, hie = lne >> 5;
    if (hie == 0) wsf[32 + r32e] = l_reg; asm volatile("s_waitcnt lgkmcnt(0)" ::: "memory");
    float rli[16];
#pragma unroll
    for (int r = 0; r < 16; ++r) rli[r] = __builtin_amdgcn_rcpf(wsf[32 + attn_body::crow(r, hie)]);
    bf16* Ow = O + (rowbase + q0 + wid * QBLK) * DMP + hv * 64;
    { bf16* stg = (bf16*)(shm + L2_OST) + wid * 2048;
#pragma unroll
      for (int half = 0; half < 2; ++half) {
#pragma unroll
          for (int r = 0; r < 16; ++r) { const int orow = attn_body::crow(r, hie);
#pragma unroll
              for (int d0 = 0; d0 < 2; ++d0) stg[orow * 64 + d0 * 32 + r32e] = __float2bfloat16(o[2 * half + d0][r] * rli[r]); }
          asm volatile("s_waitcnt lgkmcnt(0)" ::: "memory");
#pragma unroll
          for (int i = 0; i < 4; ++i) { const int row = i * 8 + (lne >> 3), ch = lne & 7; const u32x4 v = *(const u32x4*)(stg + row * 64 + ch * 8); *(u32x4*)(Ow + (long)row * DMP + half * 64 + ch * 8) = v; }
          asm volatile("s_waitcnt lgkmcnt(0)" ::: "memory"); } }
    asm volatile("s_waitcnt lgkmcnt(0)\n\ts_barrier" ::: "memory");
#undef A128_DMAK
#undef A128_DMAV
}
#undef A128_SBAR
#undef A128_WAITL
}

#ifndef GAS
#define GAS __attribute__((address_space(1)))
#endif
#define LAS __attribute__((address_space(3)))
typedef unsigned short bf16;
typedef unsigned v4u __attribute__((ext_vector_type(4)));
typedef float f32x4 __attribute__((ext_vector_type(4)));
typedef float f32x2 __attribute__((ext_vector_type(2)));
typedef short bf16x8 __attribute__((ext_vector_type(8)));
typedef GAS unsigned gu32;
typedef GAS unsigned long long gu64;
#define RLX_AGENT __ATOMIC_RELAXED, __HIP_MEMORY_SCOPE_AGENT
#define LDS_WAIT() asm volatile("s_waitcnt lgkmcnt(0)" ::: "memory")
#define VM_WAIT() asm volatile("s_waitcnt vmcnt(0)" ::: "memory")
__device__ __forceinline__ unsigned long long rt() { return __builtin_amdgcn_s_memrealtime(); }
typedef float f32x2_pk __attribute__((ext_vector_type(2))); typedef __bf16 bf16x2_pk __attribute__((ext_vector_type(2)));
__device__ __forceinline__ unsigned pk2h(float lo, float hi) { f32x2_pk v = {lo, hi}; bf16x2_pk b = __builtin_convertvector(v, bf16x2_pk); return __builtin_bit_cast(unsigned, b); }
__device__ __forceinline__ unsigned pk2(float lo, float hi) { f32x2_pk v = {lo, hi}; bf16x2_pk b = __builtin_convertvector(v, bf16x2_pk); return __builtin_bit_cast(unsigned, b); }

#define XB_TMO      128
#define XB_XCNT(j)  (256  + 64 * (j))
#define XB_XSUB(j)  (1280 + 64 * (j))
#define XB_XGEN(j)  (2304 + 64 * (j))
#define XB_TOP      3328
#define XB_TOPGEN   3392
#define XCD_BAR_WORDS 3456
#define XB_SPIN_CAP (1u << 18)

__device__ __forceinline__ unsigned xb_ld(unsigned* p)              { return __hip_atomic_load(p, __ATOMIC_RELAXED, __HIP_MEMORY_SCOPE_AGENT); }
__device__ __forceinline__ unsigned xb_add(unsigned* p, unsigned v) { return __hip_atomic_fetch_add(p, v, __ATOMIC_RELAXED, __HIP_MEMORY_SCOPE_AGENT); }
__device__ __forceinline__ unsigned xb_xcc_id() { return (unsigned)__builtin_amdgcn_s_getreg((3 << 11) | 20) & 0xFu; }
#define XB_SPIN(cond, bar) do { unsigned _sp = 0; while (cond) { __builtin_amdgcn_s_sleep(1); \
    if ((++_sp & 255u) == 0u) { if (xb_ld(&(bar)[XB_TMO])) break; if (_sp > XB_SPIN_CAP) { atomicAdd(&(bar)[XB_TMO], 1u); break; } } } } while (0)

struct XcdBarrier {
    unsigned* bar; unsigned x;
    volatile LAS unsigned* st;
};

__device__ __forceinline__ XcdBarrier xcd_barrier_post(unsigned* bar, volatile LAS unsigned* st) {
    XcdBarrier b; b.bar = bar; b.x = xb_xcc_id(); b.st = st;
    if (threadIdx.x == 0) (void)xb_add(&bar[XB_XCNT(b.x)], 1u);
    return b;
}
__device__ __forceinline__ void xcd_barrier_complete(unsigned* bar, unsigned x, unsigned& nloc, unsigned& nx) {
    const unsigned G = gridDim.x * gridDim.y * gridDim.z;
    unsigned sum, cnt, mine, sp = 0u;
    for (;;) {
        sum = 0u; cnt = 0u; mine = 0u;
#pragma unroll
        for (unsigned j = 0; j < 16; ++j) { const unsigned c = xb_ld(&bar[XB_XCNT(j)]); sum += c; cnt += (c > 0u) ? 1u : 0u; mine = (j == x) ? c : mine; }
        if (sum == G) break;
        __builtin_amdgcn_s_sleep(1);
        if ((++sp & 255u) == 0u) { if (xb_ld(&bar[XB_TMO])) break; if (sp > XB_SPIN_CAP) { atomicAdd(&bar[XB_TMO], 1u); break; } }
    }
    nloc = mine > 0u ? mine : 1u; nx = cnt > 0u ? cnt : 1u;
}

__device__ __forceinline__ void xcd_barrier(const XcdBarrier& b) {
    asm volatile("s_waitcnt vmcnt(0)" ::: "memory");
    __syncthreads();
    if (tid_now((const void*)(uintptr_t)((unsigned)(uintptr_t)b.st - (320 + 32) - 152576)) == 0) {
        unsigned* bar = b.bar;
        __builtin_amdgcn_s_waitcnt(0);
        unsigned nloc = b.st[0], nx = b.st[1];
        if (nloc == 0u) { xcd_barrier_complete(bar, b.x, nloc, nx); b.st[0] = nloc; b.st[1] = nx; }
        const unsigned old = xb_add(&bar[XB_XSUB(b.x)], 1u);
        const unsigned gen = old / nloc;
        if (old + 1u == (gen + 1u) * nloc) {
            __builtin_amdgcn_fence(__ATOMIC_RELEASE, "agent");
            asm volatile("s_waitcnt vmcnt(0)" ::: "memory");
            const unsigned og = xb_add(&bar[XB_TOP], 1u);
            const unsigned tg = og / nx;
            if (og + 1u == (tg + 1u) * nx) xb_add(&bar[XB_TOPGEN], 1u);
            else XB_SPIN(xb_ld(&bar[XB_TOPGEN]) == tg, bar);
            __builtin_amdgcn_fence(__ATOMIC_ACQUIRE, "agent");
            xb_add(&bar[XB_XGEN(b.x)], 1u);
            asm volatile("s_waitcnt vmcnt(0)" ::: "memory");
        } else {
            XB_SPIN(xb_ld(&bar[XB_XGEN(b.x)]) == gen, bar);
            __builtin_amdgcn_fence(__ATOMIC_ACQUIRE, "agent");
            asm volatile("s_waitcnt vmcnt(0)" ::: "memory");
        }
    }
    __syncthreads();
}

namespace gdn {
constexpr int BLK = 75776, OFF_NEGW = 0, OFF_QDEC = 16384, OFF_KDT = 32768, OFF_AQK = 49152, OFF_U = 57344, OFF_HDR = 73728;
constexpr int GRP_BYTES = 74752, G_KN = 0, G_QN = 16384, G_VC = 32768, G_AM = 49152, G_AQS = 65536, G_CG = 73728, G_BT = 73984, G_FK = 74240;
typedef short bf16x8 __attribute__((ext_vector_type(8)));
typedef float f32x16 __attribute__((ext_vector_type(16)));
__device__ __forceinline__ int crow(int r, int hi) { return (r & 3) + 8 * (r >> 2) + 4 * hi; }
__device__ __forceinline__ int kperm(int k) { return (k & ~12) | ((k & 4) << 1) | ((k & 8) >> 1); }
__device__ __forceinline__ unsigned pk2h(float lo, float hi) { typedef float f2_ __attribute__((ext_vector_type(2))); typedef __bf16 b2_ __attribute__((ext_vector_type(2))); f2_ v = {lo, hi}; b2_ b = __builtin_convertvector(v, b2_); return __builtin_bit_cast(unsigned, b); }
__device__ __forceinline__ float silu(float a) { return a * __builtin_amdgcn_rcpf(1.0f + __expf(-a)); }

__device__ __forceinline__ void stageA(LAS unsigned char* lds, int tid, int vcu, int G, const bf16_t* slab, const float* conv_w, const float* bg, unsigned char* r2, volatile LAS unsigned* PRB) {
    const int grp = __builtin_amdgcn_readfirstlane(tid >> 8), tg = tid & 255, lane = tid & 63; const int wg = __builtin_amdgcn_readfirstlane((tid >> 6) & 3);
    LAS unsigned char* gb = lds + grp * GRP_BYTES;
    LAS float* CG = (LAS float*)(gb + G_CG); LAS float* BT = (LAS float*)(gb + G_BT); LAS float* FK = (LAS float*)(gb + G_FK); LAS float* AM = (LAS float*)(gb + G_AM);
    float pcw[6], pgv = 0.f, pbt = 0.f;
#define GDN_S0LOAD(IT) do { const int ch_ = 2 * (IT) + grp; const int n_ = ch_ & 127, bh_ = ch_ >> 7, h_ = bh_ & 7, b_ = bh_ >> 3; const size_t row0_ = (size_t)b_ * SEQ + 64 * n_; int tq_ = tg; asm volatile("" : "+v"(tq_)); \
        _Pragma("unroll") for (int i = 0; i < 6; ++i) { const int idx = tq_ + 256 * i; const int tj = idx >> 7, col = idx & 127; pcw[i] = *(const GAS float*)(conv_w + (tj & 3) * 3072 + (tj >> 2) * 1024 + h_ * 128 + col); } \
        if (wg == 0) { const int ln0_ = tq_ & 63; pgv = *(const GAS float*)(bg + (row0_ + ln0_) * 16 + 8 + h_); pbt = *(const GAS float*)(bg + (row0_ + ln0_) * 16 + h_); } } while (0)
    if (vcu < 1024) GDN_S0LOAD(vcu);
    for (int it = vcu; it < 1024; it += G) {
        const int ch = 2 * it + grp; const int n = ch & 127, bh = ch >> 7, h = bh & 7, b = bh >> 3;
        const size_t row0 = (size_t)b * SEQ + 64 * n;
        unsigned char* blk = r2 + (size_t)ch * BLK;
        PRB_B(26, PRB); PRB_B(20, PRB);
        int tg0 = tg; asm volatile("" : "+v"(tg0));
        { LAS float* CW = (LAS float*)(gb + G_AQS);
#pragma unroll
          for (int i = 0; i < 6; ++i) CW[tg0 + 256 * i] = pcw[i]; }
        if (wg == 0) { const int ln0 = tg0 & 63; const float gv = pgv, bt = pbt; float cg = gv;
#pragma unroll
            for (int o = 1; o < 64; o <<= 1) { const float t = __shfl_up(cg, o); if (ln0 >= o) cg += t; }
            CG[ln0] = cg; BT[ln0] = bt; FK[ln0] = bt * __expf(cg); }
        __syncthreads(); PRB_E(20, PRB); PRB_B(21, PRB);
        { int tg1 = tg; asm volatile("" : "+v"(tg1)); const int r = tg1 >> 2, seg = tg1 & 3; const float cgr = CG[r], cgl = CG[63];
          v4u raw[4][4], rawn[4][4];
#define GDN_LOADRAW(DST, TY) do { const bf16_t* src_ = slab + (size_t)(3 + (TY)) * (SLAB / 2) + h * 128 + seg * 32;                                          \
            _Pragma("unroll") for (int j = 0; j < 4; ++j) { const bool ok = (64 * n + r - 3 + j) >= 0;     \
                _Pragma("unroll") for (int sub = 0; sub < 4; ++sub) { DST[j][sub] = *(const GAS v4u*)(src_ + (row0 + (ok ? r - 3 + j : 0)) * DM + sub * 8); } } } while (0)
          GDN_LOADRAW(raw, 0);
#pragma unroll
          for (int ty = 0; ty < 3; ++ty) {
            float val[32];
            __builtin_amdgcn_sched_barrier(0);
#pragma unroll
            for (int sub = 0; sub < 4; ++sub) {
                float a8[8];
#pragma unroll
                for (int e = 0; e < 8; ++e) a8[e] = 0.f;
#pragma unroll
                for (int j = 0; j < 4; ++j) { const bool okj = (64 * n + r - 3 + j) >= 0; v4u rw_ = raw[j][sub]; if (!okj) rw_ = (v4u){0u, 0u, 0u, 0u};
                    const f32x4 w0 = *(const LAS f32x4*)(gb + G_AQS + ((ty * 4 + j) * 128 + seg * 32 + sub * 8) * 4), w1 = *(const LAS f32x4*)(gb + G_AQS + ((ty * 4 + j) * 128 + seg * 32 + sub * 8 + 4) * 4);
                    a8[0] += w0.x * __uint_as_float(rw_.x << 16); a8[1] += w0.y * __uint_as_float(rw_.x & 0xffff0000u); a8[2] += w0.z * __uint_as_float(rw_.y << 16); a8[3] += w0.w * __uint_as_float(rw_.y & 0xffff0000u);
                    a8[4] += w1.x * __uint_as_float(rw_.z << 16); a8[5] += w1.y * __uint_as_float(rw_.z & 0xffff0000u); a8[6] += w1.z * __uint_as_float(rw_.w << 16); a8[7] += w1.w * __uint_as_float(rw_.w & 0xffff0000u); }
#pragma unroll
                for (int e = 0; e < 8; ++e) val[sub * 8 + e] = silu(a8[e]);
                asm volatile("" : "+v"(val[sub * 8 + 0]), "+v"(val[sub * 8 + 1]), "+v"(val[sub * 8 + 2]), "+v"(val[sub * 8 + 3]), "+v"(val[sub * 8 + 4]), "+v"(val[sub * 8 + 5]), "+v"(val[sub * 8 + 6]), "+v"(val[sub * 8 + 7]) :: "memory");
            }
            __builtin_amdgcn_sched_barrier(0);
            if (ty < 2) { GDN_LOADRAW(rawn, ty + 1); }
            __builtin_amdgcn_sched_barrier(0);
            if (ty < 2) { float ss = 0.f;
#pragma unroll
                for (int e = 0; e < 32; ++e) ss += val[e] * val[e];
                ss += __shfl_xor(ss, 1); ss += __shfl_xor(ss, 2);
                float sc = __builtin_amdgcn_rsqf(ss + NORM_EPS); if (ty == 0) sc *= 0.08838834764831845f;
#pragma unroll
                for (int e = 0; e < 32; ++e) val[e] *= sc; }
            LAS unsigned char* img = gb + (ty == 0 ? G_QN : ty == 1 ? G_KN : G_VC);
#pragma unroll
            for (int sub = 0; sub < 4; ++sub) { v4u o; o.x = pk2h(val[sub * 8], val[sub * 8 + 1]); o.y = pk2h(val[sub * 8 + 2], val[sub * 8 + 3]); o.z = pk2h(val[sub * 8 + 4], val[sub * 8 + 5]); o.w = pk2h(val[sub * 8 + 6], val[sub * 8 + 7]);
                *(LAS v4u*)(img + r * 256 + (((4 * seg + sub) ^ (r & 15)) << 4)) = o; }
            if (ty == 0) {
                const float f = __expf(cgr);
#pragma unroll
                for (int kb = 0; kb < 2; ++kb)
#pragma unroll
                    for (int hh = 0; hh < 2; ++hh) { const int k0 = 16 * kb + 4 * hh; v4u o; o.x = pk2h(val[k0] * f, val[k0 + 1] * f); o.y = pk2h(val[k0 + 2] * f, val[k0 + 3] * f); o.z = pk2h(val[k0 + 8] * f, val[k0 + 9] * f); o.w = pk2h(val[k0 + 10] * f, val[k0 + 11] * f);
                        const int chunk = 2 * (2 * seg + kb) + hh; *(GAS v4u*)(blk + OFF_QDEC + r * 256 + ((chunk ^ (r & 15)) << 4)) = o; } }
            if (ty == 1) {
                const float f = __expf(cgl - cgr); const int sc = kperm(r);
#pragma unroll
                for (int e = 0; e < 32; ++e) { const int d = 32 * seg + e; *(LAS bf16_t*)(gb + G_AM + d * 128 + ((((sc >> 3) ^ ((d >> 1) & 7))) << 4) + (sc & 7) * 2) = (bf16_t)pk2h(val[e] * f, 0.f); } }
            __builtin_amdgcn_sched_barrier(0);
            if (ty < 2) {
#pragma unroll
                for (int j = 0; j < 4; ++j)
#pragma unroll
                    for (int sub = 0; sub < 4; ++sub) raw[j][sub] = rawn[j][sub]; }
          }
#undef GDN_LOADRAW
        }
        __syncthreads(); PRB_E(21, PRB); PRB_B(22, PRB);
        { int tgf = tg; asm volatile("" : "+v"(tgf));
#pragma unroll
          for (int i = 0; i < 4; ++i) *(GAS v4u*)(blk + OFF_KDT + tgf * 16 + i * 4096) = *(const LAS v4u*)(gb + G_AM + tgf * 16 + i * 4096); }
        __syncthreads(); PRB_E(22, PRB); PRB_B(23, PRB);
        if (wg < 3) { const int ib = (wg + 1) >> 1, jb = wg >> 1; int ln3 = lane; asm volatile("" : "+v"(ln3)); const int r32 = ln3 & 31, hi = ln3 >> 5; const int rowA = ib * 32 + r32, rowB = jb * 32 + r32;
            f32x16 ckk, cqk;
#pragma unroll
            for (int r = 0; r < 16; ++r) { ckk[r] = 0.f; cqk[r] = 0.f; }
#pragma unroll
            for (int ks = 0; ks < 8; ++ks) {
                const bf16x8 ak = *(const LAS bf16x8*)(gb + G_KN + rowA * 256 + (((2 * ks + hi) ^ (rowA & 15)) << 4));
                const bf16x8 aq = *(const LAS bf16x8*)(gb + G_QN + rowA * 256 + (((2 * ks + hi) ^ (rowA & 15)) << 4));
                const bf16x8 bk = *(const LAS bf16x8*)(gb + G_KN + rowB * 256 + (((2 * ks + hi) ^ (rowB & 15)) << 4));
                ckk = __builtin_amdgcn_mfma_f32_32x32x16_bf16(ak, bk, ckk, 0, 0, 0); cqk = __builtin_amdgcn_mfma_f32_32x32x16_bf16(aq, bk, cqk, 0, 0, 0); }
            const int j = jb * 32 + r32; const float cgj = CG[j]; const int scj = kperm(j);
#pragma unroll
            for (int r = 0; r < 16; ++r) { const int i = ib * 32 + crow(r, hi); const float dec = __expf(fminf(CG[i] - cgj, 0.f));
                AM[i * 64 + j] = (j < i) ? BT[i] * ckk[r] * dec : 0.f;
                *(LAS bf16_t*)(gb + G_AQS + i * 128 + ((((scj >> 3) ^ ((i >> 1) & 7))) << 4) + (scj & 7) * 2) = (bf16_t)pk2h((j <= i) ? cqk[r] * dec : 0.f, 0.f); } }
        else { int l3 = lane; asm volatile("" : "+v"(l3));
#pragma unroll
            for (int i = 0; i < 8; ++i) { const int row = 4 * i + (l3 >> 4), c4 = (l3 & 15) >> 2, w = l3 & 3; *(LAS unsigned*)(gb + G_AQS + row * 128 + (((4 + c4) ^ ((row >> 1) & 7)) << 4) + w * 4) = 0u; } }
        __syncthreads(); PRB_E(23, PRB); PRB_B(24, PRB);
        { int tgf = tg; asm volatile("" : "+v"(tgf));
#pragma unroll
          for (int i = 0; i < 2; ++i) *(GAS v4u*)(blk + OFF_AQK + tgf * 16 + i * 4096) = *(const LAS v4u*)(gb + G_AQS + tgf * 16 + i * 4096); }
        if (it + G < 1024) GDN_S0LOAD(it + G);
        { const bool isw = wg >= 2; int tg5 = tg; asm volatile("" : "+v"(tg5)); const int cc = tg5 & 127; const LAS unsigned char* img = gb + (isw ? G_KN : G_VC); const LAS float* fac = isw ? FK : BT;
          float X[64];
#pragma unroll
          for (int jj = 0; jj < 64; ++jj) { const bf16_t raw = *(const LAS bf16_t*)(img + jj * 256 + ((((cc >> 3) ^ (jj & 15))) << 4) + (cc & 7) * 2); X[jj] = bf2f(raw) * fac[jj]; }
          f32x4 arow[2][16];
          arow[1][0] = *(const LAS f32x4*)(AM + 1 * 64);
#pragma unroll
          for (int i = 1; i < 64; ++i) {
              if (i + 1 < 64) {
#pragma unroll
                  for (int q = 0; q < (i + 1 + 3) / 4; ++q) arow[(i + 1) & 1][q] = *(const LAS f32x4*)(AM + (i + 1) * 64 + 4 * q); }
              __builtin_amdgcn_sched_barrier(0);
              float acc0 = X[i], acc1 = 0.f;
#pragma unroll
              for (int q = 0; q < (i + 3) / 4; ++q) { const f32x4 a4 = arow[i & 1][q]; const int j4 = 4 * q;
                  acc0 -= a4.x * X[j4]; if (j4 + 1 < i) acc1 -= a4.y * X[j4 + 1]; if (j4 + 2 < i) acc0 -= a4.z * X[j4 + 2]; if (j4 + 3 < i) acc1 -= a4.w * X[j4 + 3]; }
              X[i] = acc0 + acc1; __builtin_amdgcn_sched_barrier(0); }
          if (!isw) { const int slice = cc >> 5, c31 = cc & 31;
#pragma unroll
              for (int mt = 0; mt < 2; ++mt)
#pragma unroll
                  for (int rp = 0; rp < 8; ++rp)
#pragma unroll
                      for (int hi = 0; hi < 2; ++hi) *(GAS unsigned*)(blk + OFF_U + ((((slice * 2 + mt) * 8 + rp) * 64) + hi * 32 + c31) * 4) = pk2h(X[32 * mt + crow(2 * rp, hi)], X[32 * mt + crow(2 * rp + 1, hi)]);
          } else { const int sc = kperm(cc);
#pragma unroll
              for (int i = 0; i < 64; ++i) *(LAS bf16_t*)(gb + G_QN + i * 256 + ((((sc >> 3) ^ (i & 15))) << 4) + (sc & 7) * 2) = (bf16_t)pk2h(-X[i], 0.f); }
          if (tg5 == 0) *(GAS float*)(blk + OFF_HDR) = __expf(CG[63]);
        }
        __syncthreads(); PRB_E(24, PRB); PRB_B(25, PRB);
        { int tgf = tg; asm volatile("" : "+v"(tgf));
#pragma unroll
          for (int i = 0; i < 4; ++i) *(GAS v4u*)(blk + OFF_NEGW + tgf * 16 + i * 4096) = *(const LAS v4u*)(gb + G_QN + tgf * 16 + i * 4096); }
        __syncthreads(); PRB_E(25, PRB); PRB_E(26, PRB);
    }
#undef GDN_S0LOAD
}

__device__ __forceinline__ void glds16(const void* gsrc, unsigned lds_dst) { unsigned keep;
    asm volatile("s_mov_b32 %0, m0\n\ts_mov_b32 m0, %2\n\ts_nop 0\n\tglobal_load_lds_dwordx4 %1, off\n\ts_mov_b32 m0, %0" : "=&s"(keep) : "v"(gsrc), "s"(lds_dst) : "memory"); }
__device__ __forceinline__ bf16x8 pack8(const f32x16& v, int s) { v4u o; o.x = pk2h(v[8 * s], v[8 * s + 1]); o.y = pk2h(v[8 * s + 2], v[8 * s + 3]); o.z = pk2h(v[8 * s + 4], v[8 * s + 5]); o.w = pk2h(v[8 * s + 6], v[8 * s + 7]); return __builtin_bit_cast(bf16x8, o); }
#define GDN_WAITL(n) asm volatile("s_waitcnt lgkmcnt(" #n ")" ::: "memory")
#define GDN_SBAR() __builtin_amdgcn_sched_barrier(0)
__device__ __forceinline__ void scan(unsigned char* lds_generic, int tid, int bh, const unsigned char* r2, bf16_t* OB) {
    const int lane = tid & 63; const int wave = __builtin_amdgcn_readfirstlane(tid >> 6);
    const int h = bh & 7, b = bh >> 3;
    const unsigned char* blk0 = r2 + (size_t)bh * 128 * BLK;
    const unsigned lds0 = (unsigned)(uintptr_t)lds_generic;
    const LAS unsigned char* L = (const LAS unsigned char*)lds_generic;
#define GDN_DMA(n, buf) do { const unsigned char* gsrc_ = blk0 + (size_t)(n) * BLK + lane * 16; _Pragma("unroll") for (int i_ = 0; i_ < 10; ++i_) { const int p_ = wave + 8 * i_; if (p_ < 74) glds16(gsrc_ + p_ * 1024, (unsigned)__builtin_amdgcn_readfirstlane(lds0 + (buf) * BLK + p_ * 1024)); } } while (0)
    f32x16 S[4];
    { float zz; asm volatile("v_mov_b32 %0, 0" : "=v"(zz));
#pragma unroll
      for (int kt = 0; kt < 4; ++kt)
#pragma unroll
          for (int r = 0; r < 16; ++r) S[kt][r] = zz; }
    GDN_DMA(0, 0);
    asm volatile("s_waitcnt vmcnt(0) lgkmcnt(0)\n\ts_barrier" ::: "memory");
    for (int n = 0; n < 128; ++n) {
        const int buf = n & 1;
        if (n + 1 < 128) GDN_DMA(n + 1, buf ^ 1);
        if (wave < 4) {
            int lnc = lane; asm volatile("" : "+v"(lnc)); const int r32 = lnc & 31, hi = lnc >> 5;
            const int base = (int)(lds0 + buf * BLK);
            const float gl = *(const LAS float*)(L + buf * BLK + OFF_HDR);
            bf16x8 Sb[4][2];
#pragma unroll
            for (int kt = 0; kt < 4; ++kt) { Sb[kt][0] = pack8(S[kt], 0); Sb[kt][1] = pack8(S[kt], 1); }
            f32x16 av[2], ao[2];
#pragma unroll
            for (int mt = 0; mt < 2; ++mt) {
#pragma unroll
                for (int rp = 0; rp < 8; ++rp) { const unsigned w = *(const LAS unsigned*)(L + buf * BLK + OFF_U + ((((wave * 2 + mt) * 8 + rp) * 64) + lnc) * 4); av[mt][2 * rp] = __uint_as_float(w << 16); av[mt][2 * rp + 1] = __uint_as_float(w & 0xffff0000u); }
#pragma unroll
                for (int r = 0; r < 16; ++r) ao[mt][r] = 0.f; }
            const int a8_0 = base + r32 * 256 + (((0 + hi) ^ (r32 & 15)) << 4), a8_1 = base + r32 * 256 + (((2 + hi) ^ (r32 & 15)) << 4), a8_2 = base + r32 * 256 + (((4 + hi) ^ (r32 & 15)) << 4), a8_3 = base + r32 * 256 + (((6 + hi) ^ (r32 & 15)) << 4),
                      a8_4 = base + r32 * 256 + (((8 + hi) ^ (r32 & 15)) << 4), a8_5 = base + r32 * 256 + (((10 + hi) ^ (r32 & 15)) << 4), a8_6 = base + r32 * 256 + (((12 + hi) ^ (r32 & 15)) << 4), a8_7 = base + r32 * 256 + (((14 + hi) ^ (r32 & 15)) << 4);
            const int a4_0 = base + r32 * 128 + (((0 + hi) ^ ((r32 >> 1) & 7)) << 4), a4_1 = base + r32 * 128 + (((2 + hi) ^ ((r32 >> 1) & 7)) << 4), a4_2 = base + r32 * 128 + (((4 + hi) ^ ((r32 >> 1) & 7)) << 4), a4_3 = base + r32 * 128 + (((6 + hi) ^ ((r32 >> 1) & 7)) << 4);
            bf16x8 Vb[2][2]; bf16x8 f0, f1, f2, f3, f4;
            asm volatile("s_waitcnt lgkmcnt(0)" ::: "memory"); GDN_SBAR();
#define GDN_RDA(F, A, OFF) asm volatile("ds_read_b128 %0,%1 offset:%c2" : "=&v"(F) : "v"(A), "i"(OFF) : "memory")
            GDN_RDA(f0, a8_0, OFF_NEGW + 0); GDN_RDA(f1, a8_0, OFF_QDEC + 0); GDN_RDA(f2, a8_1, OFF_NEGW + 0); GDN_RDA(f3, a8_1, OFF_QDEC + 0);
            GDN_RDA(f4, a8_2, OFF_NEGW + 0); GDN_WAITL(4); GDN_SBAR(); av[0] = __builtin_amdgcn_mfma_f32_32x32x16_bf16(f0, Sb[0][0], av[0], 0, 0, 0);
            GDN_RDA(f0, a8_2, OFF_QDEC + 0); GDN_WAITL(4); GDN_SBAR(); ao[0] = __builtin_amdgcn_mfma_f32_32x32x16_bf16(f1, Sb[0][0], ao[0], 0, 0, 0);
            GDN_RDA(f1, a8_3, OFF_NEGW + 0); GDN_WAITL(4); GDN_SBAR(); av[0] = __builtin_amdgcn_mfma_f32_32x32x16_bf16(f2, Sb[0][1], av[0], 0, 0, 0);
            GDN_RDA(f2, a8_3, OFF_QDEC + 0); GDN_WAITL(4); GDN_SBAR(); ao[0] = __builtin_amdgcn_mfma_f32_32x32x16_bf16(f3, Sb[0][1], ao[0], 0, 0, 0);
            GDN_RDA(f3, a8_4, OFF_NEGW + 0); GDN_WAITL(4); GDN_SBAR(); av[0] = __builtin_amdgcn_mfma_f32_32x32x16_bf16(f4, Sb[1][0], av[0], 0, 0, 0);
            GDN_RDA(f4, a8_4, OFF_QDEC + 0); GDN_WAITL(4); GDN_SBAR(); ao[0] = __builtin_amdgcn_mfma_f32_32x32x16_bf16(f0, Sb[1][0], ao[0], 0, 0, 0);
            GDN_RDA(f0, a8_5, OFF_NEGW + 0); GDN_WAITL(4); GDN_SBAR(); av[0] = __builtin_amdgcn_mfma_f32_32x32x16_bf16(f1, Sb[1][1], av[0], 0, 0, 0);
            GDN_RDA(f1, a8_5, OFF_QDEC + 0); GDN_WAITL(4); GDN_SBAR(); ao[0] = __builtin_amdgcn_mfma_f32_32x32x16_bf16(f2, Sb[1][1], ao[0], 0, 0, 0);
            GDN_RDA(f2, a8_6, OFF_NEGW + 0); GDN_WAITL(4); GDN_SBAR(); av[0] = __builtin_amdgcn_mfma_f32_32x32x16_bf16(f3, Sb[2][0], av[0], 0, 0, 0);
            GDN_RDA(f3, a8_6, OFF_QDEC + 0); GDN_WAITL(4); GDN_SBAR(); ao[0] = __builtin_amdgcn_mfma_f32_32x32x16_bf16(f4, Sb[2][0], ao[0], 0, 0, 0);
            GDN_RDA(f4, a8_7, OFF_NEGW + 0); GDN_WAITL(4); GDN_SBAR(); av[0] = __builtin_amdgcn_mfma_f32_32x32x16_bf16(f0, Sb[2][1], av[0], 0, 0, 0);
            GDN_RDA(f0, a8_7, OFF_QDEC + 0); GDN_WAITL(4); GDN_SBAR(); ao[0] = __builtin_amdgcn_mfma_f32_32x32x16_bf16(f1, Sb[2][1], ao[0], 0, 0, 0);
            GDN_RDA(f1, a8_0, OFF_NEGW + 8192); GDN_WAITL(4); GDN_SBAR(); av[0] = __builtin_amdgcn_mfma_f32_32x32x16_bf16(f2, Sb[3][0], av[0], 0, 0, 0);
            GDN_RDA(f2, a8_0, OFF_QDEC + 8192); GDN_WAITL(4); GDN_SBAR(); ao[0] = __builtin_amdgcn_mfma_f32_32x32x16_bf16(f3, Sb[3][0], ao[0], 0, 0, 0);
            GDN_RDA(f3, a8_1, OFF_NEGW + 8192); GDN_WAITL(4); GDN_SBAR(); av[0] = __builtin_amdgcn_mfma_f32_32x32x16_bf16(f4, Sb[3][1], av[0], 0, 0, 0);
            GDN_RDA(f4, a8_1, OFF_QDEC + 8192); GDN_WAITL(4); GDN_SBAR(); ao[0] = __builtin_amdgcn_mfma_f32_32x32x16_bf16(f0, Sb[3][1], ao[0], 0, 0, 0);
            GDN_RDA(f0, a8_2, OFF_NEGW + 8192); GDN_WAITL(4); GDN_SBAR(); av[1] = __builtin_amdgcn_mfma_f32_32x32x16_bf16(f1, Sb[0][0], av[1], 0, 0, 0);
            GDN_RDA(f1, a8_2, OFF_QDEC + 8192); GDN_WAITL(4); GDN_SBAR(); ao[1] = __builtin_amdgcn_mfma_f32_32x32x16_bf16(f2, Sb[0][0], ao[1], 0, 0, 0);
            GDN_RDA(f2, a8_3, OFF_NEGW + 8192); GDN_WAITL(4); GDN_SBAR(); av[1] = __builtin_amdgcn_mfma_f32_32x32x16_bf16(f3, Sb[0][1], av[1], 0, 0, 0);
            GDN_RDA(f3, a8_3, OFF_QDEC + 8192); GDN_WAITL(4); GDN_SBAR(); ao[1] = __builtin_amdgcn_mfma_f32_32x32x16_bf16(f4, Sb[0][1], ao[1], 0, 0, 0);
            GDN_RDA(f4, a8_4, OFF_NEGW + 8192); GDN_WAITL(4); GDN_SBAR(); av[1] = __builtin_amdgcn_mfma_f32_32x32x16_bf16(f0, Sb[1][0], av[1], 0, 0, 0);
            GDN_RDA(f0, a8_4, OFF_QDEC + 8192); GDN_WAITL(4); GDN_SBAR(); ao[1] = __builtin_amdgcn_mfma_f32_32x32x16_bf16(f1, Sb[1][0], ao[1], 0, 0, 0);
            GDN_RDA(f1, a8_5, OFF_NEGW + 8192); GDN_WAITL(4); GDN_SBAR(); av[1] = __builtin_amdgcn_mfma_f32_32x32x16_bf16(f2, Sb[1][1], av[1], 0, 0, 0);
            GDN_RDA(f2, a8_5, OFF_QDEC + 8192); GDN_WAITL(4); GDN_SBAR(); ao[1] = __builtin_amdgcn_mfma_f32_32x32x16_bf16(f3, Sb[1][1], ao[1], 0, 0, 0);
            GDN_RDA(f3, a8_6, OFF_NEGW + 8192); GDN_WAITL(4); GDN_SBAR(); av[1] = __builtin_amdgcn_mfma_f32_32x32x16_bf16(f4, Sb[2][0], av[1], 0, 0, 0);
            GDN_RDA(f4, a8_6, OFF_QDEC + 8192); GDN_WAITL(4); GDN_SBAR(); ao[1] = __builtin_amdgcn_mfma_f32_32x32x16_bf16(f0, Sb[2][0], ao[1], 0, 0, 0);
            GDN_RDA(f0, a8_7, OFF_NEGW + 8192); GDN_WAITL(4); GDN_SBAR(); av[1] = __builtin_amdgcn_mfma_f32_32x32x16_bf16(f1, Sb[2][1], av[1], 0, 0, 0);
            GDN_RDA(f1, a8_7, OFF_QDEC + 8192); GDN_WAITL(4); GDN_SBAR(); ao[1] = __builtin_amdgcn_mfma_f32_32x32x16_bf16(f2, Sb[2][1], ao[1], 0, 0, 0);
            GDN_RDA(f2, a4_0, OFF_AQK + 0); GDN_WAITL(4); GDN_SBAR(); av[1] = __builtin_amdgcn_mfma_f32_32x32x16_bf16(f3, Sb[3][0], av[1], 0, 0, 0);
            GDN_RDA(f3, a4_1, OFF_AQK + 0); GDN_WAITL(4); GDN_SBAR(); ao[1] = __builtin_amdgcn_mfma_f32_32x32x16_bf16(f4, Sb[3][0], ao[1], 0, 0, 0);
            GDN_RDA(f4, a4_0, OFF_AQK + 4096); GDN_WAITL(4); GDN_SBAR(); av[1] = __builtin_amdgcn_mfma_f32_32x32x16_bf16(f0, Sb[3][1], av[1], 0, 0, 0);
            GDN_RDA(f0, a4_1, OFF_AQK + 4096); GDN_WAITL(4); GDN_SBAR(); ao[1] = __builtin_amdgcn_mfma_f32_32x32x16_bf16(f1, Sb[3][1], ao[1], 0, 0, 0);
            Vb[0][0] = pack8(av[0], 0); Vb[0][1] = pack8(av[0], 1); Vb[1][0] = pack8(av[1], 0); Vb[1][1] = pack8(av[1], 1);
            GDN_RDA(f1, a4_2, OFF_AQK + 4096); GDN_WAITL(4); GDN_SBAR(); ao[0] = __builtin_amdgcn_mfma_f32_32x32x16_bf16(f2, Vb[0][0], ao[0], 0, 0, 0);
            GDN_RDA(f2, a4_3, OFF_AQK + 4096); GDN_WAITL(4); GDN_SBAR(); ao[0] = __builtin_amdgcn_mfma_f32_32x32x16_bf16(f3, Vb[0][1], ao[0], 0, 0, 0);
            GDN_RDA(f3, a4_0, OFF_KDT + 0); GDN_WAITL(4); GDN_SBAR(); ao[1] = __builtin_amdgcn_mfma_f32_32x32x16_bf16(f4, Vb[0][0], ao[1], 0, 0, 0);
            GDN_RDA(f4, a4_1, OFF_KDT + 0); GDN_WAITL(4); GDN_SBAR(); ao[1] = __builtin_amdgcn_mfma_f32_32x32x16_bf16(f0, Vb[0][1], ao[1], 0, 0, 0);
            GDN_RDA(f0, a4_2, OFF_KDT + 0); GDN_WAITL(4); GDN_SBAR(); ao[1] = __builtin_amdgcn_mfma_f32_32x32x16_bf16(f1, Vb[1][0], ao[1], 0, 0, 0);
            GDN_RDA(f1, a4_3, OFF_KDT + 0); GDN_WAITL(4); GDN_SBAR(); ao[1] = __builtin_amdgcn_mfma_f32_32x32x16_bf16(f2, Vb[1][1], ao[1], 0, 0, 0);
            { bf16_t* op = OB + ((size_t)b * SEQ + 64 * n) * DM + h * 128 + 32 * wave + r32;
#pragma unroll
              for (int mt = 0; mt < 2; ++mt)
#pragma unroll
                  for (int r = 0; r < 16; ++r) *(GAS bf16_t*)(op + (size_t)(32 * mt + crow(r, hi)) * DM) = (bf16_t)pk2h(ao[mt][r], 0.f); }
            S[0] = S[0] * gl; S[1] = S[1] * gl; S[2] = S[2] * gl; S[3] = S[3] * gl;
            GDN_RDA(f2, a4_0, OFF_KDT + 4096); GDN_WAITL(4); GDN_SBAR(); S[0] = __builtin_amdgcn_mfma_f32_32x32x16_bf16(f3, Vb[0][0], S[0], 0, 0, 0);
            GDN_RDA(f3, a4_1, OFF_KDT + 4096); GDN_WAITL(4); GDN_SBAR(); S[0] = __builtin_amdgcn_mfma_f32_32x32x16_bf16(f4, Vb[0][1], S[0], 0, 0, 0);
            GDN_RDA(f4, a4_2, OFF_KDT + 4096); GDN_WAITL(4); GDN_SBAR(); S[0] = __builtin_amdgcn_mfma_f32_32x32x16_bf16(f0, Vb[1][0], S[0], 0, 0, 0);
            GDN_RDA(f0, a4_3, OFF_KDT + 4096); GDN_WAITL(4); GDN_SBAR(); S[0] = __builtin_amdgcn_mfma_f32_32x32x16_bf16(f1, Vb[1][1], S[0], 0, 0, 0);
            GDN_RDA(f1, a4_0, OFF_KDT + 8192); GDN_WAITL(4); GDN_SBAR(); S[1] = __builtin_amdgcn_mfma_f32_32x32x16_bf16(f2, Vb[0][0], S[1], 0, 0, 0);
            GDN_RDA(f2, a4_1, OFF_KDT + 8192); GDN_WAITL(4); GDN_SBAR(); S[1] = __builtin_amdgcn_mfma_f32_32x32x16_bf16(f3, Vb[0][1], S[1], 0, 0, 0);
            GDN_RDA(f3, a4_2, OFF_KDT + 8192); GDN_WAITL(4); GDN_SBAR(); S[1] = __builtin_amdgcn_mfma_f32_32x32x16_bf16(f4, Vb[1][0], S[1], 0, 0, 0);
            GDN_RDA(f4, a4_3, OFF_KDT + 8192); GDN_WAITL(4); GDN_SBAR(); S[1] = __builtin_amdgcn_mfma_f32_32x32x16_bf16(f0, Vb[1][1], S[1], 0, 0, 0);
            GDN_RDA(f0, a4_0, OFF_KDT + 12288); GDN_WAITL(4); GDN_SBAR(); S[2] = __builtin_amdgcn_mfma_f32_32x32x16_bf16(f1, Vb[0][0], S[2], 0, 0, 0);
            GDN_RDA(f1, a4_1, OFF_KDT + 12288); GDN_WAITL(4); GDN_SBAR(); S[2] = __builtin_amdgcn_mfma_f32_32x32x16_bf16(f2, Vb[0][1], S[2], 0, 0, 0);
            GDN_RDA(f2, a4_2, OFF_KDT + 12288); GDN_WAITL(4); GDN_SBAR(); S[2] = __builtin_amdgcn_mfma_f32_32x32x16_bf16(f3, Vb[1][0], S[2], 0, 0, 0);
            GDN_RDA(f3, a4_3, OFF_KDT + 12288); GDN_WAITL(4); GDN_SBAR(); S[2] = __builtin_amdgcn_mfma_f32_32x32x16_bf16(f4, Vb[1][1], S[2], 0, 0, 0);
            GDN_WAITL(3); GDN_SBAR(); S[3] = __builtin_amdgcn_mfma_f32_32x32x16_bf16(f0, Vb[0][0], S[3], 0, 0, 0);
            GDN_WAITL(2); GDN_SBAR(); S[3] = __builtin_amdgcn_mfma_f32_32x32x16_bf16(f1, Vb[0][1], S[3], 0, 0, 0);
            GDN_WAITL(1); GDN_SBAR(); S[3] = __builtin_amdgcn_mfma_f32_32x32x16_bf16(f2, Vb[1][0], S[3], 0, 0, 0);
            GDN_WAITL(0); GDN_SBAR(); S[3] = __builtin_amdgcn_mfma_f32_32x32x16_bf16(f3, Vb[1][1], S[3], 0, 0, 0);
#undef GDN_RDA
        }
        asm volatile("s_waitcnt vmcnt(0) lgkmcnt(0)\n\ts_barrier" ::: "memory");
    }
#undef GDN_DMA
}
}

constexpr int NWAVES = 8;
constexpr int RING_OFF = 0, RING_BYTES = 152576;
constexpr int LDSCTL_OFF = RING_BYTES, MISC_OFF = LDSCTL_OFF + 320;
constexpr int LDS_BYTES = 153600;
constexpr int NPHASE = 11;

#define FTID (tid_now((const void*)(uintptr_t)(unsigned)(uintptr_t)F.lds))
struct Frame {
    LAS unsigned char* lds;
    volatile LAS unsigned* MISC;
    gu32* ctl;
    int vcu, G;
    unsigned char* ws; float* out;
};
typedef unsigned v2u __attribute__((ext_vector_type(2)));

template <class ColMap>
__device__ __forceinline__ void transpose_item(const float* W, int ldw, bf16* WT, int dst_row0, int k0, const ColMap& cm, LAS float* scr, int lane) {
    const int n4 = (lane & 7) * 4, kr = lane >> 3; const int sc = cm(dst_row0 + n4);
    f32x4 v[8];
#pragma unroll
    for (int i = 0; i < 8; ++i) v[i] = *(const GAS f32x4*)(W + (size_t)(k0 + kr + 8 * i) * ldw + sc);
#pragma unroll
    for (int i = 0; i < 8; ++i) { const int kk = kr + 8 * i; scr[(n4 + 0) * 65 + kk] = v[i].x; scr[(n4 + 1) * 65 + kk] = v[i].y; scr[(n4 + 2) * 65 + kk] = v[i].z; scr[(n4 + 3) * 65 + kk] = v[i].w; }
    LDS_WAIT(); asm volatile("" ::: "memory");
    const int c = lane & 7;
#pragma unroll
    for (int j = 0; j < 4; ++j) { const int nn = (lane >> 3) + 8 * j; const LAS float* s = scr + nn * 65 + 8 * c;
        v4u o; o.x = pk2(s[0], s[1]); o.y = pk2(s[2], s[3]); o.z = pk2(s[4], s[5]); o.w = pk2(s[6], s[7]);
        *(GAS v4u*)(WT + (size_t)(dst_row0 + nn) * DM + k0 + 8 * c) = o; }
    LDS_WAIT(); asm volatile("" ::: "memory");
}
struct CmIdent { __device__ __forceinline__ int operator()(int r) const { return r; } };
struct CmWin {
    __device__ __forceinline__ int operator()(int R) const {
        const int pn = R >> 8, tc = R & 255;
        if (pn < 8) { const int bj = tc >> 7, wc = (tc >> 5) & 3, fq = (tc >> 3) & 3, n = (tc >> 2) & 1, e = tc & 3; return 256 * pn + 64 * (2 * bj + (wc >> 1)) + 32 * n + 16 * (wc & 1) + 4 * fq + e; }
        return (R < 7168) ? R : R + 16;
    }
};
struct CmOff { int off; __device__ __forceinline__ int operator()(int r) const { return r + off; } };

__device__ __forceinline__ void p0_prologue(Frame& F, const float* x, const float* mix_g, const float* w_in, const float* w_out, const float* a_log, const float* dt_bias) {
    int tid_ = FTID; asm volatile("" : "+v"(tid_)); const int lane_ = tid_ & 63; const int wave_ = __builtin_amdgcn_readfirstlane(tid_ >> 6); (void)lane_; (void)wave_;
    LAS float* scr = (LAS float*)(F.lds + RING_OFF + wave_ * 16384);
    const int gw = F.vcu * NWAVES + wave_, NGW = F.G * NWAVES;
    bf16* Win_t = (bf16*)((unsigned char*)F.out + 32 * MiB); bf16* Wout_t = (bf16*)(F.ws + WS_WOUT); bf16* XN = (bf16*)F.out;
    constexpr int I_IN = (9216 / 32) * 16, I_OUT = (1024 / 32) * 16;
    for (int it = gw; it < I_IN + I_OUT; it += NGW) {
        if (it < I_IN) transpose_item(w_in, IN_DIM, Win_t, 32 * (it >> 4), 64 * (it & 15), CmWin(), scr, lane_);
        else { const int r = it - I_IN; transpose_item(w_out, DM, Wout_t, 32 * (r >> 4), 64 * (r & 15), CmIdent(), scr, lane_); }
    }
    float* rope = (float*)(F.ws + WS_ROPE);
    for (int idx = (F.vcu * NWAVES + wave_) * 64 + lane_; idx < SEQ * 32; idx += NGW * 64) { const int pos = idx >> 5, i = idx & 31;
        const float inv_freq = 1.0f / powf(10000.0f, (float)(2 * i) / 64.0f); const float ang = (float)pos * inv_freq; rope[idx] = cosf(ang); rope[SEQ * 32 + idx] = sinf(ang); }
    __syncthreads();
    LAS float* w16 = (LAS float*)(F.lds + RING_OFF);
    { f32x4 t[8];
#pragma unroll
      for (int i = 0; i < 8; ++i) { const int i4 = tid_ + 512 * i; t[i] = *(const GAS f32x4*)(w_in + (size_t)(i4 >> 2) * IN_DIM + 7168 + (i4 & 3) * 4); }
#pragma unroll
      for (int i = 0; i < 8; ++i) { const int i4 = tid_ + 512 * i; const int k = i4 >> 2, e0 = (i4 & 3) * 4;
          w16[(e0 + 0) * 1028 + k] = t[i].x; w16[(e0 + 1) * 1028 + k] = t[i].y; w16[(e0 + 2) * 1028 + k] = t[i].z; w16[(e0 + 3) * 1028 + k] = t[i].w; } }
    __syncthreads();
    float* bg = (float*)(F.ws + WS_BG);
    const int me = (lane_ >> 2) & 15;
    const float mydt = dt_bias[me & 7], myal = a_log[me & 7];
    f32x4 vnext[4];
    if (gw < T_) { const GAS f32x4* x0 = (const GAS f32x4*)(x + (size_t)gw * DM) + lane_;
#pragma unroll
        for (int j = 0; j < 4; ++j) vnext[j] = x0[64 * j]; }
#pragma unroll 1
    for (int m = gw; m < T_; m += NGW) {
        f32x4 v[4]; float s = 0.f;
#pragma unroll
        for (int j = 0; j < 4; ++j) v[j] = vnext[j];
        { const int mn = (m + NGW < T_) ? m + NGW : m; const GAS f32x4* xn = (const GAS f32x4*)(x + (size_t)mn * DM) + lane_;
#pragma unroll
          for (int j = 0; j < 4; ++j) vnext[j] = xn[64 * j]; }
#pragma unroll
        for (int j = 0; j < 4; ++j) s += (v[j].x * v[j].x + v[j].y * v[j].y) + (v[j].z * v[j].z + v[j].w * v[j].w);
        s = wave_sum(s);
        const float rstd = 1.0f / sqrtf(s * (1.0f / DM) + NORM_EPS);
        GAS unsigned long long* o8 = (GAS unsigned long long*)(XN + (size_t)m * DM) + lane_;
#pragma unroll
        for (int j = 0; j < 4; ++j) { const f32x4 gg = ((const GAS f32x4*)mix_g)[lane_ + 64 * j]; v[j] = v[j] * rstd * gg;
            o8[64 * j] = (unsigned long long)pk2(v[j].x, v[j].y) | ((unsigned long long)pk2(v[j].z, v[j].w) << 32); }
        float a16[16];
#pragma unroll
        for (int e = 0; e < 16; ++e) { f32x2 a2 = {0.f, 0.f};
#pragma unroll
            for (int j = 0; j < 4; ++j) { const f32x4 w4 = *(const LAS f32x4*)(w16 + e * 1028 + 4 * (lane_ + 64 * j)); a2 += (f32x2){v[j].x, v[j].y} * (f32x2){w4.x, w4.y}; a2 += (f32x2){v[j].z, v[j].w} * (f32x2){w4.z, w4.w}; }
            a16[e] = a2.x + a2.y; if ((e & 3) == 3) __builtin_amdgcn_sched_barrier(0); }
        float r8[8], r4[4], r2[2];
        { const bool up = (lane_ & 32) != 0;
#pragma unroll
          for (int e = 0; e < 8; ++e) { const float send = up ? a16[e] : a16[e + 8], keep = up ? a16[e + 8] : a16[e]; r8[e] = keep + __shfl_xor(send, 32); } }
        { const bool up = (lane_ & 16) != 0;
#pragma unroll
          for (int e = 0; e < 4; ++e) { const float send = up ? r8[e] : r8[e + 4], keep = up ? r8[e + 4] : r8[e]; r4[e] = keep + __shfl_xor(send, 16); } }
        { const bool up = (lane_ & 8) != 0;
#pragma unroll
          for (int e = 0; e < 2; ++e) { const float send = up ? r4[e] : r4[e + 2], keep = up ? r4[e + 2] : r4[e]; r2[e] = keep + __shfl_xor(send, 8); } }
        float val; { const bool up = (lane_ & 4) != 0; const float send = up ? r2[0] : r2[1], keep = up ? r2[1] : r2[0]; val = keep + __shfl_xor(send, 4); }
        val += __shfl_xor(val, 2); val += __shfl_xor(val, 1);
        float res;
        if (me < 8) res = 1.0f / (1.0f + expf(-val));
        else { const float z = val + mydt; const float sp = (z > 20.f) ? z : log1pf(expf(z)); res = -expf(myal) * sp; }
        if ((lane_ & 3) == 0) bg[(size_t)m * 16 + me] = res;
    }
    __syncthreads();
}

__device__ __forceinline__ int dequeue(Frame& F, int qword) {
    if (FTID == 0) F.MISC[16] = __hip_atomic_fetch_add(F.ctl + qword, 1u, __ATOMIC_RELAXED, __HIP_MEMORY_SCOPE_AGENT);
    __syncthreads();
    const int idx = __builtin_amdgcn_readfirstlane((int)F.MISC[16]);
    __syncthreads();
    return idx;
}
__device__ __forceinline__ void p2_scans(Frame& F, unsigned char* lds_generic, int qbase) {
    bf16* OB = (bf16*)(F.ws + WS_SLAB) + 3 * (SLAB / 2);
    const int x = (int)(xb_xcc_id() & 7u);
    for (int qi = 0; qi < 8; ++qi) {
        const int q = (x + qi) & 7;
        for (;;) { const int idx = dequeue(F, qbase + 64 * (8 + q)); if (idx >= 2) break; gdn::scan(lds_generic + RING_OFF, FTID, 2 * q + idx, F.ws + WS_R2, OB); }
    }
}
__device__ __forceinline__ void p2_attention(Frame& F, unsigned char* lds_generic, int qbase) {
    const bf16* QA = (const bf16*)(F.ws + WS_SLAB); const bf16* KA = QA + (SLAB / 2); const bf16* VA = KA + (SLAB / 2);
    bf16* O1 = (bf16*)F.out;
    const int x = (int)(xb_xcc_id() & 7u);
    for (int qi = 0; qi < 8; ++qi) {
        const int q = (x + qi) & 7;
        for (;;) {
            const int u = dequeue(F, qbase + 64 * q);
            if (u >= 128) break;
            const int bh = 2 * q + (u >> 6), rem = u & 63; const int qb = 31 - (rem >> 1), c = rem & 1; const int b = bh >> 3, h = bh & 7;
            attn128::unit6<8>(b, 2 * h + c, 2 * h, qb, (const attn_body::bf16*)QA, (const attn_body::bf16*)KA, (const attn_body::bf16*)VA, (attn_body::bf16*)(O1 + (size_t)c * T_ * DM), (char*)lds_generic + RING_OFF);
        }
    }
}

__device__ __forceinline__ void p2b_merge(Frame& F, const float* lq1, const float* lk1, const float* lq2, const float* lk2, const float* subln_g, const float* gdn_g) {
    int tid_ = FTID; asm volatile("" : "+v"(tid_)); const int lane_ = tid_ & 63; const int wave_ = __builtin_amdgcn_readfirstlane(tid_ >> 6); (void)lane_; (void)wave_;
    const bf16* O1 = (const bf16*)F.out; const bf16* O2 = O1 + (size_t)T_ * DM;
    bf16* slab = (bf16*)(F.ws + WS_SLAB); bf16* MG = slab; const bf16* OB = slab + 3 * (SLAB / 2); const bf16* GZ = slab + 6 * (SLAB / 2); const bf16* GA = slab + 7 * (SLAB / 2); const bf16* GB = slab + 8 * (SLAB / 2);
    const int gw = F.vcu * NWAVES + wave_, NGW = F.G * NWAVES, lane = lane_;
    const float lam = expf(wave_sum(lq1[lane] * lk1[lane])) - expf(wave_sum(lq2[lane] * lk2[lane])) + 0.2f;
    const float sg0 = subln_g[2 * lane] * 0.8f, sg1 = subln_g[2 * lane + 1] * 0.8f, gg0 = gdn_g[2 * lane], gg1 = gdn_g[2 * lane + 1];
#pragma unroll 1
    for (int row = gw; row < T_; row += NGW) {
        unsigned u1[8], u2[8], ub[8], uz[8], ua[8], ugb[8];
#pragma unroll
        for (int h = 0; h < 8; ++h) { const size_t off = (size_t)row * DM + h * 128 + 2 * lane;
            u1[h] = *(const GAS unsigned*)(O1 + off); u2[h] = *(const GAS unsigned*)(O2 + off); ub[h] = *(const GAS unsigned*)(OB + off); uz[h] = *(const GAS unsigned*)(GZ + off); ua[h] = *(const GAS unsigned*)(GA + off); ugb[h] = *(const GAS unsigned*)(GB + off); }
#pragma unroll
        for (int h = 0; h < 8; ++h) { const size_t off = (size_t)row * DM + h * 128 + 2 * lane;
            const float d0 = __uint_as_float(u1[h] << 16) - lam * __uint_as_float(u2[h] << 16), d1 = __uint_as_float(u1[h] & 0xffff0000u) - lam * __uint_as_float(u2[h] & 0xffff0000u);
            const float ra = __builtin_amdgcn_rsqf(wave_sum(d0 * d0 + d1 * d1) * (1.0f / 128.0f) + NORM_EPS);
            const float ya0 = d0 * ra * sg0, ya1 = d1 * ra * sg1;
            const float b0 = __uint_as_float(ub[h] << 16), b1 = __uint_as_float(ub[h] & 0xffff0000u);
            const float rb = __builtin_amdgcn_rsqf(wave_sum(b0 * b0 + b1 * b1) * (1.0f / 128.0f) + NORM_EPS);
            const float z0 = __uint_as_float(uz[h] << 16), z1 = __uint_as_float(uz[h] & 0xffff0000u);
            const float yb0 = b0 * rb * gg0 * (z0 * sigmoidf_(z0)), yb1 = b1 * rb * gg1 * (z1 * sigmoidf_(z1));
            const float m0 = sigmoidf_(__uint_as_float(ua[h] << 16)) * ya0 + sigmoidf_(__uint_as_float(ugb[h] << 16)) * yb0;
            const float m1 = sigmoidf_(__uint_as_float(ua[h] & 0xffff0000u)) * ya1 + sigmoidf_(__uint_as_float(ugb[h] & 0xffff0000u)) * yb1;
            *(GAS unsigned*)(MG + off) = pk2(m0, m1); }
    }
}

__device__ __forceinline__ void p3b_router(Frame& F, const float* g2, const float* rw, const float* rb, bool lists) {
    int tid_ = FTID; asm volatile("" : "+v"(tid_)); const int lane = tid_ & 63; const int wave_ = __builtin_amdgcn_readfirstlane(tid_ >> 6);
    const float* x1 = F.out; bf16* H2 = (bf16*)(F.ws + WS_H2); int* tope = (int*)(F.ws + WS_TOPE); float* topw = (float*)(F.ws + WS_TOPW); int* cnt = (int*)(F.ws + WS_CTL) + CW_CNT; int* list = (int*)(F.ws + WS_LIST);
    LAS float* rwT = (LAS float*)(F.lds + RING_OFF);
    {
        const GAS f32x4* rw4 = (const GAS f32x4*)rw;
#pragma unroll 1
        for (int b0 = 0; b0 < 16; b0 += 8) { f32x4 t[8];
#pragma unroll
            for (int i = 0; i < 8; ++i) t[i] = rw4[tid_ + 512 * (b0 + i)];
#pragma unroll
            for (int i = 0; i < 8; ++i) { const int i4 = tid_ + 512 * (b0 + i); const int k = i4 >> 3, e0 = (i4 & 7) * 4;
                rwT[(e0 + 0) * 1028 + k] = t[i].x; rwT[(e0 + 1) * 1028 + k] = t[i].y; rwT[(e0 + 2) * 1028 + k] = t[i].z; rwT[(e0 + 3) * 1028 + k] = t[i].w; } } }
    __syncthreads();
    const int gw = F.vcu * NWAVES + wave_, NGW = F.G * NWAVES;
    const float myb = rb[(lane >> 1) & 31];
    LAS int* lcnt = (LAS int*)(F.lds + RING_OFF + 131584); LAS int* gbase = lcnt + 32; LAS int* rec = lcnt + 64;
    for (int rowb = gw; rowb < T_; rowb += 8 * NGW) {
        if (tid_ < 32) lcnt[tid_] = 0;
        __syncthreads();
        f32x4 vnA[4], vnB[4];
        { const GAS f32x4* x0 = (const GAS f32x4*)(x1 + (size_t)rowb * DM); const int rb1 = (rowb + NGW < T_) ? rowb + NGW : rowb; const GAS f32x4* x1p = (const GAS f32x4*)(x1 + (size_t)rb1 * DM);
#pragma unroll
          for (int j = 0; j < 4; ++j) { vnA[j] = x0[lane + 64 * j]; vnB[j] = x1p[lane + 64 * j]; } }
#pragma unroll 1
        for (int it = 0; it < 8; it += 2) { const int rowA = rowb + it * NGW; if (rowA >= T_) break;
        const bool hasB = rowA + NGW < T_; const int rowB = hasB ? rowA + NGW : rowA;
        f32x4 vA[4], vB[4]; float sA = 0.f, sB = 0.f;
#pragma unroll
        for (int j = 0; j < 4; ++j) { vA[j] = vnA[j]; vB[j] = vnB[j]; }
        { int ra = rowA + 2 * NGW, rb_ = rowA + 3 * NGW; if (!(ra < T_ && it + 2 < 8)) ra = rowA; if (!(rb_ < T_ && it + 2 < 8)) rb_ = ra;
          const GAS f32x4* xa = (const GAS f32x4*)(x1 + (size_t)ra * DM); const GAS f32x4* xb = (const GAS f32x4*)(x1 + (size_t)rb_ * DM);
#pragma unroll
          for (int j = 0; j < 4; ++j) { vnA[j] = xa[lane + 64 * j]; vnB[j] = xb[lane + 64 * j]; } }
#pragma unroll
        for (int j = 0; j < 4; ++j) { sA += (vA[j].x * vA[j].x + vA[j].y * vA[j].y) + (vA[j].z * vA[j].z + vA[j].w * vA[j].w); sB += (vB[j].x * vB[j].x + vB[j].y * vB[j].y) + (vB[j].z * vB[j].z + vB[j].w * vB[j].w); }
        sA = wave_sum(sA); sB = wave_sum(sB);
        const float rA = 1.0f / sqrtf(sA * (1.0f / DM) + NORM_EPS), rB = 1.0f / sqrtf(sB * (1.0f / DM) + NORM_EPS);
#pragma unroll
        for (int j = 0; j < 4; ++j) { const f32x4 gg = ((const GAS f32x4*)g2)[lane + 64 * j]; vA[j] = vA[j] * rA * gg; vB[j] = vB[j] * rB * gg;
            *(GAS unsigned long long*)(H2 + (size_t)rowA * DM + 4 * (lane + 64 * j)) = (unsigned long long)pk2(vA[j].x, vA[j].y) | ((unsigned long long)pk2(vA[j].z, vA[j].w) << 32);
            if (hasB) *(GAS unsigned long long*)(H2 + (size_t)rowB * DM + 4 * (lane + 64 * j)) = (unsigned long long)pk2(vB[j].x, vB[j].y) | ((unsigned long long)pk2(vB[j].z, vB[j].w) << 32); }
        float lgA[32], lgB[32];
#pragma unroll
        for (int e = 0; e < 32; ++e) { f32x2 a2 = {0.f, 0.f}, b2 = {0.f, 0.f};
#pragma unroll
            for (int j = 0; j < 4; ++j) { const f32x4 w4 = *(const LAS f32x4*)(rwT + e * 1028 + 4 * (lane + 64 * j)); const f32x2 wl = {w4.x, w4.y}, wh = {w4.z, w4.w};
                a2 += (f32x2){vA[j].x, vA[j].y} * wl; a2 += (f32x2){vA[j].z, vA[j].w} * wh; b2 += (f32x2){vB[j].x, vB[j].y} * wl; b2 += (f32x2){vB[j].z, vB[j].w} * wh; }
            lgA[e] = a2.x + a2.y; lgB[e] = b2.x + b2.y; if ((e & 3) == 3) __builtin_amdgcn_sched_barrier(0); }
        float r32_[32], r16[16], r8[8], r4[4], r2[2];
        { const bool odd = (lane & 1) != 0;
#pragma unroll
          for (int e = 0; e < 32; ++e) { const float send = odd ? lgA[e] : lgB[e], keep = odd ? lgB[e] : lgA[e]; r32_[e] = keep + __shfl_xor(send, 1); } }
        { const bool up = (lane & 32) != 0;
#pragma unroll
          for (int e = 0; e < 16; ++e) { const float send = up ? r32_[e] : r32_[e + 16], keep = up ? r32_[e + 16] : r32_[e]; r16[e] = keep + __shfl_xor(send, 32); } }
        { const bool up = (lane & 16) != 0;
#pragma unroll
          for (int e = 0; e < 8; ++e) { const float send = up ? r16[e] : r16[e + 8], keep = up ? r16[e + 8] : r16[e]; r8[e] = keep + __shfl_xor(send, 16); } }
        { const bool up = (lane & 8) != 0;
#pragma unroll
          for (int e = 0; e < 4; ++e) { const float send = up ? r8[e] : r8[e + 4], keep = up ? r8[e + 4] : r8[e]; r4[e] = keep + __shfl_xor(send, 8); } }
        { const bool up = (lane & 4) != 0;
#pragma unroll
          for (int e = 0; e < 2; ++e) { const float send = up ? r4[e] : r4[e + 2], keep = up ? r4[e + 2] : r4[e]; r2[e] = keep + __shfl_xor(send, 4); } }
        float val; { const bool up = (lane & 2) != 0; const float send = up ? r2[0] : r2[1], keep = up ? r2[1] : r2[0]; val = keep + __shfl_xor(send, 2); }
        val += myb;
        const unsigned long long par = (lane & 1) ? 0xAAAAAAAAAAAAAAAAull : 0x5555555555555555ull;
        int sel[4]; float sv[4];
#pragma unroll
        for (int k = 0; k < 4; ++k) { float m = val;
#pragma unroll
            for (int o = 2; o < 64; o <<= 1) m = fmaxf(m, __shfl_xor(m, o));
            const unsigned long long mk = __ballot(val == m) & par; const int e = (int)(__builtin_ctzll(mk) >> 1); sel[k] = e; sv[k] = m; if (((lane >> 1) & 31) == e) val = -INFINITY; }
        const float e0 = 1.0f, e1 = expf(sv[1] - sv[0]), e2 = expf(sv[2] - sv[0]), e3 = expf(sv[3] - sv[0]); const float inv = 1.0f / (e0 + e1 + e2 + e3);
        if (lane < 8 && (hasB || !(lane & 1))) { const int k = lane >> 1; const int row = (lane & 1) ? rowB : rowA; const int ex = (k == 0) ? sel[0] : (k == 1) ? sel[1] : (k == 2) ? sel[2] : sel[3]; const float wv = ((k == 0) ? e0 : (k == 1) ? e1 : (k == 2) ? e2 : e3) * inv;
            tope[row * 4 + k] = ex; topw[row * 4 + k] = wv;
            if (lists) { const int lp = atomicAdd((int*)(lcnt + ex), 1); rec[(wave_ * 8 + it + (lane & 1)) * 4 + k] = ex | (lp << 8); } }
        }
        __syncthreads();
        if (lists) {
            if (tid_ < 32) { const int c = lcnt[tid_]; gbase[tid_] = c ? atomicAdd(cnt + 64 * tid_, c) : 0; }
            __syncthreads();
            if (lane < 32) { const int it = lane >> 2, k = lane & 3; const int row = rowb + it * NGW;
                if (row < T_) { const int rc = rec[(wave_ * 8 + it) * 4 + k]; const int ex = rc & 255, lp = rc >> 8; list[ex * 16384 + gbase[ex] + lp] = row * 4 + k; } }
            __syncthreads();
        }
    }
    __syncthreads();
}

constexpr size_t WS_W1T = WS_R2, WS_W2T = WS_R2 + 128 * MiB;
__device__ __forceinline__ void p_expert_weights(Frame& F, const float* wg, const float* wu, const float* wd) {
    int tid_ = FTID; asm volatile("" : "+v"(tid_)); const int lane_ = tid_ & 63; const int wave_ = __builtin_amdgcn_readfirstlane(tid_ >> 6); (void)lane_; (void)wave_;
    LAS float* scr = (LAS float*)(F.lds + RING_OFF + wave_ * 16384);
    const int gw = F.vcu * NWAVES + wave_, NGW = F.G * NWAVES;
    bf16* W1t = (bf16*)(F.ws + WS_W1T); bf16* W2t = (bf16*)(F.ws + WS_W2T);
    (void)gw; (void)NGW;
    for (;;) {
        int ck = 0; if (lane_ == 0) ck = (int)__hip_atomic_fetch_add(F.ctl + CW_Q + 64 * 40, 1u, __ATOMIC_RELAXED, __HIP_MEMORY_SCOPE_AGENT);
        ck = __builtin_amdgcn_readfirstlane(ck);
        if (ck >= NEXP * 1536 / 16) break;
#pragma unroll 1
      for (int ki = 0; ki < 16; ++ki) { const int it = ck * 16 + ki;
        const int e = it / 1536, r = it % 1536;
        if (r < 1024) { const int rbk = r >> 4, kb = r & 15; const int pn = rbk >> 3, tcb = rbk & 7; const int srccol0 = 128 * pn + 32 * (tcb & 3);
            const float* W = ((tcb >> 2) ? wu : wg) + (size_t)e * DM * DM;
            transpose_item(W, DM, W1t + (size_t)e * 2048 * DM, 32 * rbk, 64 * kb, CmOff{srccol0 - 32 * rbk}, scr, lane_); }
        else { const int r2 = r - 1024; transpose_item(wd + (size_t)e * DM * DM, DM, W2t + (size_t)e * DM * DM, 32 * (r2 >> 4), 64 * (r2 & 15), CmIdent(), scr, lane_); }
      }
    }
}
constexpr size_t TBL_NMT = WS_SLOT, TBL_TILEE = WS_SLOT + 1024, TBL_SLOTOF = WS_SLOT + 64 * 1024, TBL_WSLOT = WS_SLOT + 320 * 1024;
constexpr int MOE_LDS_TILEE = 131072, MOE_LDS_START = 131072 + 2048, MOE_LDS_CNT = 131072 + 2048 + 128;
__device__ __forceinline__ int p3c_gather(Frame& F) {
    int tid_ = FTID; asm volatile("" : "+v"(tid_)); const int lane_ = tid_ & 63; const int wave_ = __builtin_amdgcn_readfirstlane(tid_ >> 6); (void)lane_; (void)wave_;
    const int* cnt = (const int*)(F.ws + WS_CTL) + CW_CNT; const int* list = (const int*)(F.ws + WS_LIST); const float* topw = (const float*)(F.ws + WS_TOPW);
    int* nmt = (int*)(F.ws + TBL_NMT); int* tile_e = (int*)(F.ws + TBL_TILEE); int* slot_of = (int*)(F.ws + TBL_SLOTOF); float* wslot = (float*)(F.ws + TBL_WSLOT);
    const int lane = lane_, gw = F.vcu * NWAVES + wave_, NGW = F.G * NWAVES;
    const int c = (lane < 32) ? __hip_atomic_load(cnt + 64 * lane, __ATOMIC_RELAXED, __HIP_MEMORY_SCOPE_AGENT) : 0;
    const int pc = ((c + 255) >> 8) << 8;
    int incl = pc;
#pragma unroll
    for (int o = 1; o < 32; o <<= 1) { const int t = __shfl_up(incl, o); if (lane >= o) incl += t; }
    const int start = incl - pc; const int total = __shfl(incl, 31);
    if (wave_ == 0 && lane < 32) { LAS int* lt = (LAS int*)(F.lds + RING_OFF + MOE_LDS_TILEE); for (int t = start >> 8; t < (start + pc) >> 8; ++t) lt[t] = lane;
        ((LAS int*)(F.lds + RING_OFF + MOE_LDS_START))[lane] = start; ((LAS int*)(F.lds + RING_OFF + MOE_LDS_CNT))[lane] = c; }
    if (gw == 0) { if (lane == 0) nmt[0] = total >> 8; if (lane < 32) for (int t = start >> 8; t < (start + pc) >> 8; ++t) tile_e[t] = lane; }
    for (int g0 = gw * 64; g0 < total; g0 += NGW * 64) {
        const unsigned long long mk = __ballot(lane < 32 && g0 >= start && g0 < start + pc);
        const int e = __builtin_ctzll(mk); const int g = g0 + lane; const int pos = g - __shfl(start, e); const int ce = __shfl(c, e);
        float w = 0.f;
        if (pos < ce) { const int aid = __hip_atomic_load(list + e * 16384 + pos, __ATOMIC_RELAXED, __HIP_MEMORY_SCOPE_AGENT);
            slot_of[aid] = g; w = __hip_atomic_load(topw + aid, __ATOMIC_RELAXED, __HIP_MEMORY_SCOPE_AGENT); }
        wslot[g] = w;
    }
    __syncthreads();
    return __builtin_amdgcn_readfirstlane(total >> 8);
}

__device__ __forceinline__ void p6_final(Frame& F, const bf16* y, const int* slot_of, const float* g, float* dst) {
    int tid_ = FTID; asm volatile("" : "+v"(tid_)); const int lane_ = tid_ & 63; const int wave_ = __builtin_amdgcn_readfirstlane(tid_ >> 6); (void)lane_; (void)wave_;
    const int gw = F.vcu * NWAVES + wave_, NGW = F.G * NWAVES, lane = lane_;
    for (int row = gw; row < T_; row += NGW) {
        GAS f32x4* xr = (GAS f32x4*)(F.out + (size_t)row * DM);
        int sl[4];
#pragma unroll
        for (int k = 0; k < 4; ++k) sl[k] = slot_of ? __hip_atomic_load(slot_of + row * 4 + k, __ATOMIC_RELAXED, __HIP_MEMORY_SCOPE_AGENT) : row * 4 + k;
        f32x4 v[4]; float s = 0.f;
#pragma unroll
        for (int j = 0; j < 4; ++j) { v[j] = xr[lane + 64 * j];
#pragma unroll
            for (int k = 0; k < 4; ++k) { const v2u u = *(const GAS v2u*)(y + (size_t)sl[k] * DM + 4 * (lane + 64 * j));
                v[j].x += __uint_as_float(u.x << 16); v[j].y += __uint_as_float(u.x & 0xffff0000u); v[j].z += __uint_as_float(u.y << 16); v[j].w += __uint_as_float(u.y & 0xffff0000u); }
            s += (v[j].x * v[j].x + v[j].y * v[j].y) + (v[j].z * v[j].z + v[j].w * v[j].w); }
        s = wave_sum(s);
        const float r = 1.0f / sqrtf(s * (1.0f / DM) + NORM_EPS);
        GAS f32x4* dr = (GAS f32x4*)(dst + (size_t)row * DM);
#pragma unroll
        for (int j = 0; j < 4; ++j) { const f32x4 gg = ((const GAS f32x4*)g)[lane + 64 * j]; dr[lane + 64 * j] = v[j] * r * gg; }
    }
}

__device__ __forceinline__ const float* argp(int i) { const unsigned char* kp = (const unsigned char*)__builtin_amdgcn_kernarg_segment_ptr(); asm volatile("" : "+s"(kp)); return *(const float* const*)(kp + 8 * i); }
struct Args { const float* in[23]; float* out; unsigned char* ws; int ph_lo, ph_hi, li, pad; };
__global__ void __launch_bounds__(NWAVES * 64, 2) mega(Args args) {
    extern __shared__ __attribute__((aligned(16))) unsigned char lds[];
    Frame F;
    F.lds = (LAS unsigned char*)lds;
    F.MISC = (volatile LAS unsigned*)(F.lds + MISC_OFF);
    F.G = gridDim.x; { const int bx = blockIdx.x; F.vcu = (F.G % 8 == 0) ? (bx % 8) * (F.G / 8) + bx / 8 : bx; }
    F.ws = args.ws; F.out = args.out; F.ctl = (gu32*)(args.ws + WS_CTL);
    for (int u = threadIdx.x; u < (LDS_BYTES - LDSCTL_OFF) / 4; u += NWAVES * 64) ((LAS unsigned*)(F.lds + LDSCTL_OFF))[u] = 0u;
    __syncthreads();
    if ((threadIdx.x & 63) == 0) ((LAS unsigned*)(F.lds + TID_TBL_OFF))[hw_slot()] = threadIdx.x >> 6;
    __syncthreads();

    XcdBarrier bar = xcd_barrier_post((unsigned*)(F.ctl + CW_BAR) + args.li * XCD_BAR_WORDS, F.MISC + 8);
    const int lo = args.ph_lo, hi = args.ph_hi;
#define IN(k) (lo <= (k) && (k) < hi)
#define SEAM(k) do { PRB_E(k, F.MISC + 24); if (IN(k) && IN((k) + 1)) { PRB_B(100 + (k), F.MISC + 24); xcd_barrier(bar); PRB_E(100 + (k), F.MISC + 24); } PRB_B((k) + 1, F.MISC + 24); } while (0)
#ifndef REP_PHASE
#define REP_PHASE -1
#endif

    PRB_B(0, F.MISC + 24);
    if (IN(0)) { { const int rep_ = 0; (void)rep_;  p0_prologue(F, argp(0), argp(1), argp(2), argp(12), argp(9), argp(10));  }
        if (REP_PHASE == 0) { xcd_barrier(bar); const int rep_ = 1; (void)rep_;  p0_prologue(F, argp(0), argp(1), argp(2), argp(12), argp(9), argp(10));  } }
    SEAM(0);
    if (IN(1)) { { const int rep_ = 0; (void)rep_;
        pg8::Gemm g{(const pg8::bf16_t*)F.out, (const pg8::bf16_t*)((unsigned char*)F.out + 32 * MiB), T_, 9216, DM}; pg8::StaticOrder S; S.init(T_, 9216, F.G, (int)blockIdx.x);
        pg8::EpiProj E{((bf16*)(F.ws + WS_SLAB)), (const float*)(F.ws + WS_ROPE)};
        pg8::gemm_phase<pg8::EpiProj, pg8::StaticOrder, true, true>(F.lds + RING_OFF, g, S, E);
     }
        if (REP_PHASE == 1) { xcd_barrier(bar); const int rep_ = 1; (void)rep_;
        pg8::Gemm g{(const pg8::bf16_t*)F.out, (const pg8::bf16_t*)((unsigned char*)F.out + 32 * MiB), T_, 9216, DM}; pg8::StaticOrder S; S.init(T_, 9216, F.G, (int)blockIdx.x);
        pg8::EpiProj E{((bf16*)(F.ws + WS_SLAB)), (const float*)(F.ws + WS_ROPE)};
        pg8::gemm_phase<pg8::EpiProj, pg8::StaticOrder, true, true>(F.lds + RING_OFF, g, S, E);
     } }
    SEAM(1);
    if (IN(2)) { { const int rep_ = 0; (void)rep_;  gdn::stageA(F.lds + RING_OFF, FTID, F.vcu, F.G, ((bf16*)(F.ws + WS_SLAB)), argp(8), (const float*)(F.ws + WS_BG), F.ws + WS_R2, F.MISC + 24);  }
        if (REP_PHASE == 2) { xcd_barrier(bar); const int rep_ = 1; (void)rep_;  gdn::stageA(F.lds + RING_OFF, FTID, F.vcu, F.G, ((bf16*)(F.ws + WS_SLAB)), argp(8), (const float*)(F.ws + WS_BG), F.ws + WS_R2, F.MISC + 24);  } }
    SEAM(2);
    if (IN(3)) { { const int rep_ = 0; (void)rep_;  p2_scans(F, lds, CW_Q + 64 * 16 * rep_); p2_attention(F, lds, CW_Q + 64 * 16 * rep_);  }
        if (REP_PHASE == 3) { xcd_barrier(bar); const int rep_ = 1; (void)rep_;  p2_scans(F, lds, CW_Q + 64 * 16 * rep_); p2_attention(F, lds, CW_Q + 64 * 16 * rep_);  } }
    SEAM(3);
    if (IN(4)) { { const int rep_ = 0; (void)rep_;  p2b_merge(F, argp(3), argp(4), argp(5), argp(6), argp(7), argp(11)); p_expert_weights(F, argp(16), argp(18), argp(20));  }
        if (REP_PHASE == 4) { xcd_barrier(bar); const int rep_ = 1; (void)rep_;  p2b_merge(F, argp(3), argp(4), argp(5), argp(6), argp(7), argp(11)); p_expert_weights(F, argp(16), argp(18), argp(20));  } }
    SEAM(4);
    if (IN(5)) { { const int rep_ = 0; (void)rep_;
        pg8::Gemm g{(const pg8::bf16_t*)((bf16*)(F.ws + WS_SLAB)), (const pg8::bf16_t*)(F.ws + WS_WOUT), T_, DM, DM}; pg8::StaticOrder S; S.init(T_, DM, F.G, (int)blockIdx.x);
        pg8::EpiOutRes E{argp(0), F.out};
        pg8::gemm_phase<pg8::EpiOutRes, pg8::StaticOrder, true, true>(F.lds + RING_OFF, g, S, E);
     }
        if (REP_PHASE == 5) { xcd_barrier(bar); const int rep_ = 1; (void)rep_;
        pg8::Gemm g{(const pg8::bf16_t*)((bf16*)(F.ws + WS_SLAB)), (const pg8::bf16_t*)(F.ws + WS_WOUT), T_, DM, DM}; pg8::StaticOrder S; S.init(T_, DM, F.G, (int)blockIdx.x);
        pg8::EpiOutRes E{argp(0), F.out};
        pg8::gemm_phase<pg8::EpiOutRes, pg8::StaticOrder, true, true>(F.lds + RING_OFF, g, S, E);
     } }
    SEAM(5);
    if (IN(6)) { if (REP_PHASE == 6) { p3b_router(F, argp(13), argp(14), argp(15), false); xcd_barrier(bar); } p3b_router(F, argp(13), argp(14), argp(15), true); }
    SEAM(6);
    PRB_E(7, F.MISC + 24); PRB_B(8, F.MISC + 24);
    if (IN(8)) {
        const int nMt = p3c_gather(F);
        const unsigned lb = (unsigned)(uintptr_t)(F.lds + RING_OFF);
        pg8::Gemm g{(const pg8::bf16_t*)(F.ws + WS_H2), (const pg8::bf16_t*)(F.ws + WS_W1T), nMt * 256, 2048, DM, (const int*)(F.ws + WS_LIST), lb + MOE_LDS_START, lb + MOE_LDS_CNT};
        pg8::MoeOrderT<true> S; S.init(nMt, 2048, F.G, (int)blockIdx.x, (const int*)(uintptr_t)(lb + MOE_LDS_TILEE), (long)2048 * DM * 2);
        pg8::EpiAct E{(bf16*)(F.ws + WS_SLAB + 144 * MiB), argp(17), argp(19), (const int*)(F.ws + TBL_TILEE)};
        pg8::gemm_phase<pg8::EpiAct, pg8::MoeOrderT<true>, true, true, true>(F.lds + RING_OFF, g, S, E);
    }
    SEAM(8);
    if (IN(9)) { { const int rep_ = 0; (void)rep_;
        const int nMt = __hip_atomic_load((const int*)(F.ws + TBL_NMT), __ATOMIC_RELAXED, __HIP_MEMORY_SCOPE_AGENT);
        pg8::Gemm g{(const pg8::bf16_t*)(F.ws + WS_SLAB + 144 * MiB), (const pg8::bf16_t*)(F.ws + WS_W2T), nMt * 256, DM, DM}; pg8::MoeOrder S; S.init(nMt, DM, F.G, (int)blockIdx.x, (const int*)(F.ws + TBL_TILEE), (long)DM * DM * 2); S.rev = 1;
        pg8::EpiDown E{(bf16*)(F.ws + WS_SLAB), argp(21), (const float*)(F.ws + TBL_WSLOT), (const int*)(F.ws + TBL_TILEE)};
        pg8::gemm_phase<pg8::EpiDown, pg8::MoeOrder, true, true>(F.lds + RING_OFF, g, S, E);
     }
        if (REP_PHASE == 9) { xcd_barrier(bar); const int rep_ = 1; (void)rep_;
        const int nMt = __hip_atomic_load((const int*)(F.ws + TBL_NMT), __ATOMIC_RELAXED, __HIP_MEMORY_SCOPE_AGENT);
        pg8::Gemm g{(const pg8::bf16_t*)(F.ws + WS_SLAB + 144 * MiB), (const pg8::bf16_t*)(F.ws + WS_W2T), nMt * 256, DM, DM}; pg8::MoeOrder S; S.init(nMt, DM, F.G, (int)blockIdx.x, (const int*)(F.ws + TBL_TILEE), (long)DM * DM * 2); S.rev = 1;
        pg8::EpiDown E{(bf16*)(F.ws + WS_SLAB), argp(21), (const float*)(F.ws + TBL_WSLOT), (const int*)(F.ws + TBL_TILEE)};
        pg8::gemm_phase<pg8::EpiDown, pg8::MoeOrder, true, true>(F.lds + RING_OFF, g, S, E);
     } }
    SEAM(9);
    if (IN(10)) { if (REP_PHASE == 10) { p6_final(F, (const bf16*)(F.ws + WS_SLAB), (const int*)(F.ws + TBL_SLOTOF), argp(22), (float*)(F.ws + WS_SLAB + 144 * MiB)); xcd_barrier(bar); } p6_final(F, (const bf16*)(F.ws + WS_SLAB), (const int*)(F.ws + TBL_SLOTOF), argp(22), F.out); }
    PRB_E(10, F.MISC + 24);
    if (PROBE_ID >= 0 && IN(10) && blockIdx.x == 0 && FTID == 0) { asm volatile("s_waitcnt vmcnt(0)" ::: "memory"); F.out[0] += (float)F.MISC[24] * 0.0003f; }
#undef IN
#undef SEAM
}


static void launch_mega(Args a, int lo, int hi, int li, int grid, hipStream_t stream) { a.ph_lo = lo; a.ph_hi = hi; a.li = li; a.pad = 0; hipLaunchKernelGGL(mega, dim3(grid), dim3(NWAVES * 64), LDS_BYTES, stream, a);
    const hipError_t le = hipPeekAtLastError(); if (le != hipSuccess) fprintf(stderr, "kernel_launch: mega launch [%d,%d) failed: %s\n", lo, hi, hipGetErrorName(le)); }
extern "C" void kernel_launch(void* const* d_in, const int* in_sizes, int n_in, void* d_out, int out_size, void* d_ws, size_t ws_size, hipStream_t stream) {
    static int grid = 0;
    if (grid == 0) {
        if (n_in != 23 || ws_size < WS_END || out_size != T_ * DM) { fprintf(stderr, "kernel_launch: unexpected shapes n_in %d ws %zu out %d\n", n_in, ws_size, out_size); grid = -1; return; }
        int dev = 0, cus = 0;
        if (hipGetDevice(&dev) != hipSuccess || hipDeviceGetAttribute(&cus, hipDeviceAttributeMultiprocessorCount, dev) != hipSuccess) { grid = -1; return; }
        if (hipFuncSetAttribute((const void*)mega, hipFuncAttributeMaxDynamicSharedMemorySize, LDS_BYTES) != hipSuccess) { fprintf(stderr, "kernel_launch: hipFuncSetAttribute failed\n"); grid = -1; return; }
        (void)hipGetLastError();
        grid = cus;
        fprintf(stderr, "kernel_launch: grid %d ws_size %zu MiB\n", grid, ws_size >> 20);
    }
    if (grid < 0) return;
    const float* conv_w = (const float*)d_in[8];
    const float *wg = (const float*)d_in[16], *bgate = (const float*)d_in[17], *wu = (const float*)d_in[18], *bup = (const float*)d_in[19], *wd = (const float*)d_in[20], *bdown = (const float*)d_in[21];
    unsigned char* ws = (unsigned char*)d_ws;
    int* cnt = (int*)(ws + WS_CTL); float* bg = (float*)(ws + WS_BG); float* topw = (float*)(ws + WS_TOPW); int* list = (int*)(ws + WS_LIST);
    bf16_t* slab = (bf16_t*)(ws + WS_SLAB);
    bf16_t *VA = slab + 2 * (SLAB / 2), *GQ = slab + 3 * (SLAB / 2);
    float *cq = (float*)(ws + WS_R2), *ck = (float*)(ws + WS_R2 + 64 * MiB), *cv = (float*)(ws + WS_R2 + 128 * MiB);
    bf16_t* act = (bf16_t*)(ws + WS_R2); bf16_t* ybuf = VA; bf16_t* H2 = (bf16_t*)(ws + WS_H2);
    (void)hipMemsetAsync(ws + WS_CTL, 0, CTL_ZERO_BYTES, stream);
    Args a; memset(&a, 0, sizeof a);
    for (int i = 0; i < 23; ++i) a.in[i] = (const float*)d_in[i];
    a.out = (float*)d_out; a.ws = ws;
    launch_mega(a, 0, 11, 0, grid, stream);
}
```
